# Optimizing an MI355X kernel written in HIP

```python
import jax, jax.numpy as jnp
from jax import lax
import numpy as np

D_MODEL = 1024
BATCH = 4
SEQ = 4096
DEPTH = 1

CHUNK = 64
Q_BLOCK = 128
DSA_HEADS = 8
DSA_HEAD_DIM = D_MODEL // DSA_HEADS
IDX_HEADS = 8
IDX_DIM = 64
IDX_TOPK_MAX = 256
GLA_HEADS = 4
GLA_DK = D_MODEL // 2 // GLA_HEADS
GLA_DV = D_MODEL // GLA_HEADS
GATE_RANK = 16
GATE_TAU = 16.0
N_EXPERTS = 32
TOP_K = 4
D_FF = D_MODEL
SWIGLU_LIMIT = 7.0
SWIGLU_ALPHA = 1.702
EXPERT_BLOCK = 128
EPS = 1e-6

IN_SIZES = (DSA_HEADS * DSA_HEAD_DIM, DSA_HEADS * DSA_HEAD_DIM, DSA_HEADS * DSA_HEAD_DIM,
            IDX_HEADS * IDX_DIM, IDX_DIM, IDX_HEADS,
            GLA_HEADS * GLA_DK, GLA_HEADS * GLA_DK, GLA_HEADS * GLA_DV, GLA_HEADS * GLA_DV,
            GATE_RANK, D_MODEL, D_MODEL)
IN_WIDTH = sum(IN_SIZES)

kernel_name = 'hybrid_dsa_gla_moe_adaln_block'


def _rmsnorm(x, g):
    xf = x.astype(jnp.float32)
    y = xf * lax.rsqrt(jnp.mean(xf * xf, axis=-1, keepdims=True) + EPS)
    return (y * g.astype(jnp.float32)).astype(x.dtype)


def _dsa(q, k, v, qi, ki, wi):
    B, T, H, dh = q.shape
    topk = min(IDX_TOPK_MAX, T // 4)
    nb = T // Q_BLOCK
    kchunk = jnp.arange(T) // CHUNK
    qi = qi * (IDX_DIM ** -0.5)
    wi = wi * (IDX_HEADS ** -0.5)
    gather = jax.vmap(lambda t, i: t[i])

    def blocks(t):
        return t.reshape((B, nb, Q_BLOCK) + t.shape[2:]).swapaxes(0, 1)

    def one_block(args):
        qb, qib, wb, blk = args
        qchunk = (blk * Q_BLOCK + jnp.arange(Q_BLOCK)) // CHUNK
        vis = kchunk[None, :] <= qchunk[:, None]
        rel = jax.nn.relu(jnp.einsum('bqhd,bsd->bqhs', qib, ki).astype(jnp.float32))
        score = jnp.einsum('bqhs,bqh->bqs', rel, wb.astype(jnp.float32))
        score = jnp.where(vis[None], score, -jnp.inf)
        _, sel = lax.top_k(score, topk)
        sel_vis = kchunk[sel] <= qchunk[None, :, None]
        ks = gather(k, sel)
        vs = gather(v, sel)
        logits = jnp.einsum('bqhd,bqkhd->bqhk', qb, ks).astype(jnp.float32) * (dh ** -0.5)
        logits = jnp.where(sel_vis[:, :, None, :], logits, -jnp.inf)
        p = jax.nn.softmax(logits, axis=-1).astype(vs.dtype)
        return jnp.einsum('bqhk,bqkhd->bqhd', p, vs)

    out = lax.map(one_block, (blocks(q), blocks(qi), blocks(wi), jnp.arange(nb)))
    return out.swapaxes(0, 1).reshape(B, T, H * dh)


def _gla(q, k, v, log_a):
    dtype = v.dtype
    B, T, H, DK = q.shape
    DV = v.shape[-1]
    n = T // CHUNK

    def chunks(t):
        return t.astype(jnp.float32).reshape(B, n, CHUNK, H, t.shape[-1]).transpose(1, 0, 3, 2, 4)

    qc = chunks(q) * (DK ** -0.5)
    kc = chunks(k)
    vc = chunks(v)
    G = jnp.cumsum(chunks(log_a), axis=-2)
    causal = jnp.tril(jnp.ones((CHUNK, CHUNK), dtype=bool))

    def step(S, inp):
        qn, kn, vn, gn = inp
        g_last = gn[:, :, -1:, :]
        qe = qn * jnp.exp(gn)
        A = jnp.einsum('bhid,bhjd->bhij', qe, kn * jnp.exp(-gn))
        A = jnp.where(causal, A, 0.0)
        o = jnp.einsum('bhij,bhjv->bhiv', A, vn) + jnp.einsum('bhid,bhdv->bhiv', qe, S)
        S = S * jnp.exp(g_last).swapaxes(-1, -2) + jnp.einsum('bhjd,bhjv->bhdv', kn * jnp.exp(g_last - gn), vn)
        return S, o

    S0 = jnp.zeros((B, H, DK, DV), jnp.float32)
    _, o = lax.scan(step, S0, (qc, kc, vc, G))
    return o.transpose(1, 0, 3, 2, 4).reshape(B, T, H, DV).astype(dtype)


def _moe(h, router_w, router_b, w_gate_up, b_gate_up, w_down, b_down):
    B, T, D = h.shape
    N = B * T
    xt = h.reshape(N, D)
    logits = (xt @ router_w + router_b).astype(jnp.float32)
    top_v, top_e = lax.top_k(logits, TOP_K)
    wts = jax.nn.softmax(top_v, axis=-1)
    n_assign = N * TOP_K
    flat_e = top_e.reshape(-1)
    order = jnp.argsort(flat_e)
    sorted_e = flat_e[order]
    tok = (order // TOP_K).astype(jnp.int32)
    sorted_w = wts.reshape(-1)[order]
    gs = jnp.bincount(flat_e, length=N_EXPERTS).astype(jnp.int32)
    ps = ((gs + EXPERT_BLOCK - 1) // EXPERT_BLOCK) * EXPERT_BLOCK
    off = jnp.cumsum(gs) - gs
    poff = jnp.cumsum(ps) - ps
    pad_pos = poff[sorted_e] + (jnp.arange(n_assign, dtype=jnp.int32) - off[sorted_e])
    n_blocks = -(-n_assign // EXPERT_BLOCK) + N_EXPERTS
    P = n_blocks * EXPERT_BLOCK
    ptok = jnp.full((P,), N, jnp.int32).at[pad_pos].set(tok)
    pw = jnp.zeros((P,), jnp.float32).at[pad_pos].set(sorted_w)
    blk_e = jnp.minimum(jnp.searchsorted(jnp.cumsum(ps), jnp.arange(n_blocks) * EXPERT_BLOCK, side='right'),
                        N_EXPERTS - 1)
    xpad = jnp.concatenate([xt, jnp.zeros((1, D), xt.dtype)], axis=0)
    xs = xpad[ptok].reshape(n_blocks, EXPERT_BLOCK, D)

    def expert_block(args):
        xb, e = args
        hgu = xb @ w_gate_up[e] + b_gate_up[e]
        gate, up = jnp.split(hgu, 2, axis=-1)
        gate = jnp.minimum(gate, SWIGLU_LIMIT)
        up = jnp.clip(up, -SWIGLU_LIMIT, SWIGLU_LIMIT)
        act = (up + 1.0) * (gate * jax.nn.sigmoid(SWIGLU_ALPHA * gate))
        return act @ w_down[e] + b_down[e]

    ys = lax.map(expert_block, (xs, blk_e)).reshape(P, D)
    out = jax.ops.segment_sum(ys * pw[:, None].astype(ys.dtype), ptok, num_segments=N + 1)[:N]
    return out.reshape(B, T, D)


def _layer(x, c, w_ada, b_ada, norm1_g, w_in, w_gate_lr, b_gate, gla_norm_g, w_branch_a, w_branch_b,
           w_out, norm2_g, router_w, router_b, w_gate_up, b_gate_up, w_down, b_down):
    B, T, _ = x.shape
    mod = (jax.nn.silu(c) @ w_ada + b_ada)[:, None, :]
    sh1, sc1, gt1, sh2, sc2, gt2 = jnp.split(mod, 6, axis=-1)
    h = _rmsnorm(x, norm1_g) * (1.0 + sc1) + sh1
    proj = h @ w_in
    split_pts = np.cumsum(IN_SIZES)[:-1].tolist()
    qa, ka, va, qi, ki, wi, qb, kb, vb, gb, lr, ga, gbm = jnp.split(proj, split_pts, axis=-1)

    def heads(t, nh):
        return t.reshape(B, T, nh, -1)

    ya = _dsa(heads(qa, DSA_HEADS), heads(ka, DSA_HEADS), heads(va, DSA_HEADS),
              heads(qi, IDX_HEADS), ki, wi)
    log_a = jax.nn.log_sigmoid((lr @ w_gate_lr + b_gate).astype(jnp.float32)) / GATE_TAU
    ob = _gla(heads(qb, GLA_HEADS), heads(kb, GLA_HEADS), heads(vb, GLA_HEADS), heads(log_a, GLA_HEADS))
    yb = (_rmsnorm(ob, gla_norm_g) * jax.nn.silu(heads(gb, GLA_HEADS))).reshape(B, T, -1)
    merged = jax.nn.sigmoid(ga) * (ya @ w_branch_a) + jax.nn.sigmoid(gbm) * (yb @ w_branch_b)
    x = x + gt1 * (merged @ w_out)
    h2 = _rmsnorm(x, norm2_g) * (1.0 + sc2) + sh2
    x = x + gt2 * _moe(h2, router_w, router_b, w_gate_up, b_gate_up, w_down, b_down)
    return x


def setup_inputs(seed: int = 0) -> dict:
    key = jax.random.key(seed)
    ks = jax.random.split(key, 24)
    D = D_MODEL

    def nrm(k, shape, scale):
        return jax.random.normal(k, shape, jnp.float32) * scale

    return {
        'x': nrm(ks[0], (BATCH, SEQ, D), 1.0),
        'c': nrm(ks[1], (BATCH, D), 1.0),
        'w_ada': nrm(ks[2], (DEPTH, D, 6 * D), D ** -0.5),
        'b_ada': nrm(ks[3], (DEPTH, 6 * D), 0.02),
        'norm1_g': 1.0 + nrm(ks[4], (DEPTH, D), 0.02),
        'w_in': nrm(ks[5], (DEPTH, D, IN_WIDTH), D ** -0.5),
        'w_gate_lr': nrm(ks[6], (DEPTH, GATE_RANK, GLA_HEADS * GLA_DK), GATE_RANK ** -0.5),
        'b_gate': nrm(ks[7], (DEPTH, GLA_HEADS * GLA_DK), 0.1),
        'gla_norm_g': 1.0 + nrm(ks[8], (DEPTH, GLA_DV), 0.02),
        'w_branch_a': nrm(ks[9], (DEPTH, DSA_HEADS * DSA_HEAD_DIM, D), (DSA_HEADS * DSA_HEAD_DIM) ** -0.5),
        'w_branch_b': nrm(ks[10], (DEPTH, GLA_HEADS * GLA_DV, D), (GLA_HEADS * GLA_DV) ** -0.5),
        'w_out': nrm(ks[11], (DEPTH, D, D), D ** -0.5),
        'norm2_g': 1.0 + nrm(ks[12], (DEPTH, D), 0.02),
        'router_w': nrm(ks[13], (DEPTH, D, N_EXPERTS), D ** -0.5),
        'router_b': nrm(ks[14], (DEPTH, N_EXPERTS), 0.01),
        'w_gate_up': nrm(ks[15], (DEPTH, N_EXPERTS, D, 2 * D_FF), D ** -0.5),
        'b_gate_up': nrm(ks[16], (DEPTH, N_EXPERTS, 2 * D_FF), 0.02),
        'w_down': nrm(ks[17], (DEPTH, N_EXPERTS, D_FF, D), D_FF ** -0.5),
        'b_down': nrm(ks[18], (DEPTH, N_EXPERTS, D), 0.02),
        'final_g': 1.0 + nrm(ks[19], (D,), 0.02),
    }


def reference(x, c, w_ada, b_ada, norm1_g, w_in, w_gate_lr, b_gate, gla_norm_g, w_branch_a, w_branch_b,
              w_out, norm2_g, router_w, router_b, w_gate_up, b_gate_up, w_down, b_down, final_g):
    for l in range(DEPTH):
        x = _layer(x, c, w_ada[l], b_ada[l], norm1_g[l], w_in[l], w_gate_lr[l], b_gate[l], gla_norm_g[l],
                   w_branch_a[l], w_branch_b[l], w_out[l], norm2_g[l], router_w[l], router_b[l],
                   w_gate_up[l], b_gate_up[l], w_down[l], b_down[l])
    return _rmsnorm(x, final_g)
```

```cpp
#include <hip/hip_runtime.h>
#include <cstdio>
#include <cstdint>
namespace pg8 {
#define PG8_LAS __attribute__((address_space(3)))
typedef unsigned short bf16_t;
typedef short bf16x8 __attribute__((ext_vector_type(8)));
typedef float f32x4 __attribute__((ext_vector_type(4)));
typedef unsigned u32x4 __attribute__((ext_vector_type(4)));
typedef unsigned u32x2 __attribute__((ext_vector_type(2)));
constexpr int BM = 256, BK = 64, HALF = 128, HTB = HALF * BK * 2  , STAGE_BYTES = 8 * HTB, NXCD = 8, WGM = 8;

__host__ __device__ __forceinline__ int lds_byte(int r, int c) { const int st = (r >> 4) * 2 + (c >> 5), rr = r & 15, cc = c & 31, ob = rr * 64 + cc * 2; return st * 1024 + (ob ^ (((ob >> 9) & 1) << 5)); }
__host__ __device__ __forceinline__ void stage_rc(int b, int& R, int& C) { const int st = b / 1024, sb = b % 1024, swz = sb ^ (((sb >> 9) & 1) << 5); R = (st >> 1) * 16 + swz / 64; C = (st & 1) * 32 + (swz % 64) / 2; }
__host__ __device__ __forceinline__ int perm32(int rho) { const int n = rho >> 4, i = rho & 15; return 8 * (i >> 2) + 4 * n + (i & 3); }

struct Unit { int pm, pn, e, boff; };
struct Gemm { const bf16_t* A; const bf16_t* Bt; int M, N, K; };

struct StaticOrder {
    int nM, nN, nwg, G, c;
    __host__ __device__ void init(int M, int N, int G_, int c_) { nM = M / BM; nN = N / BM; nwg = nM * nN; G = G_; c = c_; }
    __host__ __device__ bool next(int i, Unit& u) const {
        const long L = (long)i * G + c; if (L >= nwg) return false;
        int wgid = (int)L; { const int q = nwg / NXCD, r = nwg % NXCD, xcd = wgid % NXCD, off = wgid / NXCD; wgid = (xcd < r ? xcd * (q + 1) : r * (q + 1) + (xcd - r) * q) + off; }
        const int nig = WGM * nN, gid = wgid / nig, fm = gid * WGM, gsz = (nM - fm) < WGM ? (nM - fm) : WGM;
        u.pm = fm + ((wgid % nig) % gsz); u.pn = (wgid % nig) / gsz; u.e = 0; u.boff = 0; return true;
    }
    __device__ __forceinline__ void a_ready(const Unit&) const {}
    __device__ __forceinline__ void done(const Unit&) const {}
};
__device__ __forceinline__ unsigned cvt_pk_bf16(float lo, float hi) { unsigned r; asm volatile("v_cvt_pk_bf16_f32 %0, %1, %2" : "=v"(r) : "v"(lo), "v"(hi)); return r; }

template <class Epi, class Sched, bool ALIGN_EPI = false, bool SP2 = false>
__device__ __forceinline__ void gemm_phase(PG8_LAS unsigned char* lds, const Gemm g, const Sched& S, const Epi& E) {
    const int tid = threadIdx.x, wid = __builtin_amdgcn_readfirstlane(tid >> 6), lane = tid & 63, wr = wid >> 2, wc = wid & 3, fr = lane & 15, fq = lane >> 4;
    const int K = g.K, nt = K / BK;
    unsigned voffA[2], voffB[2];
#pragma unroll
    for (int i = 0; i < 2; ++i) { int R, C; stage_rc(tid * 16 + i * 8192, R, C); const int Rb = Epi::PERM ? ((R & ~31) + perm32(R & 31)) : R;
        voffA[i] = (unsigned)(R * K + C) * 2u; voffB[i] = (unsigned)(Rb * K + C) * 2u; }
    const size_t kstep = (size_t)(BK * 2);
    const size_t hstep = (size_t)HALF * K * 2;
    const size_t tstep = 2 * hstep;
    const unsigned ldsw = (unsigned)wid * 1024u;
    const int aoff = lds_byte(wr * 64 + fr, fq * 8), boff = lds_byte(wc * 32 + fr, fq * 8);
#define PG8_SA(b, h) (((b) * 2 + (h)) * HTB)
#define PG8_SB(b, h) ((4 + (b) * 2 + (h)) * HTB)
#define PG8_STAGE(bufoff, gbase, voff) do { _Pragma("unroll") for (int _i = 0; _i < 2; ++_i) \
        __builtin_amdgcn_global_load_lds((const unsigned*)((const char*)(gbase) + (voff)[_i]), (PG8_LAS unsigned*)(lds + (bufoff) + ldsw + _i * 8192), 16, 0, 0); } while (0)
#define PG8_LDA(dst, b, h) do { _Pragma("unroll") for (int m = 0; m < 4; ++m) _Pragma("unroll") for (int k = 0; k < 2; ++k) dst[m][k] = *(const PG8_LAS bf16x8*)(lds + PG8_SA(b, h) + aoff + m * 2048 + k * 1024); } while (0)
#define PG8_LDB(dst, b, h) do { _Pragma("unroll") for (int n = 0; n < 2; ++n) _Pragma("unroll") for (int k = 0; k < 2; ++k) dst[n][k] = *(const PG8_LAS bf16x8*)(lds + PG8_SB(b, h) + boff + n * 2048 + k * 1024); } while (0)
#define PG8_MMA(ai, bj, At, Bt) do { __builtin_amdgcn_s_setprio(1); _Pragma("unroll") for (int m = 0; m < 4; ++m) _Pragma("unroll") for (int n = 0; n < 2; ++n) _Pragma("unroll") for (int k = 0; k < 2; ++k) \
        acc[ai][bj][m][n] = __builtin_amdgcn_mfma_f32_16x16x32_bf16(Bt[n][k], At[m][k], acc[ai][bj][m][n], 0, 0, 0); __builtin_amdgcn_s_setprio(0); } while (0)
#define PG8_WAIT_V(n) asm volatile("s_waitcnt vmcnt(" #n ")" ::: "memory")
#define PG8_WAIT_L(n) asm volatile("s_waitcnt lgkmcnt(" #n ")" ::: "memory")
#define PG8_BAR __builtin_amdgcn_s_barrier()
#define PG8_SCHED __builtin_amdgcn_sched_barrier(0)
    Unit cur, nxt; int ui = 0;
    if (!S.next(0, cur)) return;
    f32x4 acc[2][2][4][2];
#pragma unroll
    for (int a = 0; a < 2; ++a)
#pragma unroll
        for (int b = 0; b < 2; ++b)
#pragma unroll
            for (int m = 0; m < 4; ++m)
#pragma unroll
                for (int n = 0; n < 2; ++n) acc[a][b][m][n] = (f32x4){0.f, 0.f, 0.f, 0.f};
    bf16x8 At[4][2], B0[2][2], B1[2][2];
    const char* cA = (const char*)g.A + (size_t)cur.pm * tstep; const char* cB = (const char*)g.Bt + (size_t)cur.boff * 2 + (size_t)cur.pn * tstep;
    S.a_ready(cur);
    if constexpr (SP2) {
        PG8_STAGE(PG8_SB(0, 0), cB, voffB); PG8_STAGE(PG8_SB(0, 1), cB + hstep, voffB); PG8_STAGE(PG8_SA(0, 0), cA, voffA); PG8_STAGE(PG8_SA(0, 1), cA + hstep, voffA);
        if (wr == 1) PG8_BAR;
        PG8_WAIT_V(2); PG8_BAR;
        PG8_STAGE(PG8_SB(1, 0), cB + kstep, voffB); PG8_STAGE(PG8_SA(1, 0), cA + kstep, voffA); PG8_STAGE(PG8_SB(1, 1), cB + hstep + kstep, voffB);
        PG8_WAIT_V(6); PG8_BAR;
    } else {
        PG8_STAGE(PG8_SB(0, 0), cB, voffB); PG8_STAGE(PG8_SA(0, 0), cA, voffA); PG8_STAGE(PG8_SB(0, 1), cB + hstep, voffB); PG8_STAGE(PG8_SA(0, 1), cA + hstep, voffA);
        if (wr == 1) PG8_BAR;
        PG8_WAIT_V(4); PG8_BAR;
        PG8_STAGE(PG8_SB(1, 0), cB + kstep, voffB); PG8_STAGE(PG8_SA(1, 0), cA + kstep, voffA); PG8_STAGE(PG8_SB(1, 1), cB + hstep + kstep, voffB);
        PG8_WAIT_V(6); PG8_BAR;
    }
    for (;;) {
        const bool has_next = S.next(ui + 1, nxt);
        const char* nA = has_next ? (const char*)g.A + (size_t)nxt.pm * tstep : cA; const char* nB = has_next ? (const char*)g.Bt + (size_t)nxt.boff * 2 + (size_t)nxt.pn * tstep : cB;
        for (int t = 0; t < nt; t += 2) {
            const bool last = (t == nt - 2);
            const char* a1 = cA + (size_t)(t + 1) * kstep;
            const char* a2 = last ? nA : cA + (size_t)(t + 2) * kstep; const char* b2 = last ? nB : cB + (size_t)(t + 2) * kstep;
            const char* a3 = a2 + kstep; const char* b3 = b2 + kstep;
            if (last && has_next) S.a_ready(nxt);
            if constexpr (SP2) {
            PG8_LDB(B0, 0, 0); PG8_LDB(B1, 0, 1); PG8_SCHED; PG8_LDA(At, 0, 0); PG8_STAGE(PG8_SA(1, 1), a1 + hstep, voffA);
            PG8_WAIT_V(8); PG8_WAIT_L(0); PG8_BAR; PG8_MMA(0, 0, At, B0); PG8_MMA(0, 1, At, B1); PG8_BAR; PG8_SCHED;
            PG8_LDA(At, 0, 1); PG8_STAGE(PG8_SB(0, 0), b2, voffB); PG8_STAGE(PG8_SB(0, 1), b2 + hstep, voffB); PG8_STAGE(PG8_SA(0, 0), a2, voffA);
            PG8_WAIT_V(8); PG8_WAIT_L(0); PG8_BAR; PG8_MMA(1, 0, At, B0); PG8_MMA(1, 1, At, B1); PG8_BAR; PG8_SCHED;
            PG8_LDB(B0, 1, 0); PG8_LDB(B1, 1, 1); PG8_SCHED; PG8_LDA(At, 1, 0); PG8_STAGE(PG8_SA(0, 1), a2 + hstep, voffA);
            PG8_WAIT_V(8); PG8_WAIT_L(0); PG8_BAR; PG8_MMA(0, 0, At, B0); PG8_MMA(0, 1, At, B1); PG8_BAR; PG8_SCHED;
            PG8_LDA(At, 1, 1); PG8_STAGE(PG8_SB(1, 0), b3, voffB); PG8_STAGE(PG8_SB(1, 1), b3 + hstep, voffB); PG8_STAGE(PG8_SA(1, 0), a3, voffA);
            PG8_WAIT_V(8); PG8_WAIT_L(0); PG8_BAR; PG8_MMA(1, 0, At, B0); PG8_MMA(1, 1, At, B1); PG8_BAR; PG8_SCHED;
            } else {
            PG8_LDB(B0, 0, 0); PG8_SCHED; PG8_LDA(At, 0, 0); PG8_STAGE(PG8_SA(1, 1), a1 + hstep, voffA);
            PG8_WAIT_L(8); PG8_BAR; PG8_WAIT_L(0); PG8_MMA(0, 0, At, B0); PG8_BAR; PG8_SCHED;
            PG8_LDB(B1, 0, 1); PG8_STAGE(PG8_SB(0, 0), b2, voffB);
            PG8_BAR; PG8_WAIT_L(0); PG8_MMA(0, 1, At, B1); PG8_BAR;
            PG8_LDA(At, 0, 1); PG8_STAGE(PG8_SA(0, 0), a2, voffA);
            PG8_BAR; PG8_WAIT_L(0); PG8_MMA(1, 0, At, B0); PG8_BAR; PG8_SCHED;
            PG8_STAGE(PG8_SB(0, 1), b2 + hstep, voffB);
            PG8_WAIT_V(6); PG8_BAR; PG8_MMA(1, 1, At, B1); PG8_BAR;
            PG8_LDB(B0, 1, 0); PG8_SCHED; PG8_LDA(At, 1, 0); PG8_STAGE(PG8_SA(0, 1), a2 + hstep, voffA);
            PG8_WAIT_L(8); PG8_BAR; PG8_WAIT_L(0); PG8_MMA(0, 0, At, B0); PG8_BAR; PG8_SCHED;
            PG8_LDB(B1, 1, 1); PG8_STAGE(PG8_SB(1, 0), b3, voffB);
            PG8_BAR; PG8_WAIT_L(0); PG8_MMA(0, 1, At, B1); PG8_BAR;
            PG8_LDA(At, 1, 1); PG8_STAGE(PG8_SA(1, 0), a3, voffA);
            PG8_BAR; PG8_WAIT_L(0); PG8_MMA(1, 0, At, B0); PG8_BAR; PG8_SCHED;
            PG8_STAGE(PG8_SB(1, 1), b3 + hstep, voffB);
            PG8_WAIT_V(6); PG8_BAR; PG8_MMA(1, 1, At, B1); PG8_BAR;
            }
        }
        if constexpr (ALIGN_EPI) { if (wr == 0) PG8_BAR; }
        if constexpr (!Epi::AFTER_DRAIN) { E(acc, cur, wr, wc, fr, fq); S.done(cur); }
        if (!has_next) break;
#pragma unroll
        for (int a = 0; a < 2; ++a)
#pragma unroll
            for (int b = 0; b < 2; ++b)
#pragma unroll
                for (int m = 0; m < 4; ++m)
#pragma unroll
                    for (int n = 0; n < 2; ++n) acc[a][b][m][n] = (f32x4){0.f, 0.f, 0.f, 0.f};
        cur = nxt; cA = nA; cB = nB; ++ui;
        if constexpr (ALIGN_EPI) { if (wr == 1) PG8_BAR; }
    }
    PG8_WAIT_V(0);
    if constexpr (!ALIGN_EPI) { if (wr == 0) PG8_BAR; }
    PG8_BAR;
    if constexpr (Epi::AFTER_DRAIN) { E.fused(acc, cur, wr, wc, fr, fq, lds, wid, lane); S.done(cur); }
#undef PG8_SA
#undef PG8_SB
#undef PG8_STAGE
#undef PG8_LDA
#undef PG8_LDB
#undef PG8_MMA
#undef PG8_WAIT_V
#undef PG8_WAIT_L
#undef PG8_BAR
#undef PG8_SCHED
}
}

constexpr int NB = 4, T = 4096, D = 1024, NTOK = NB * T;
constexpr int NEXP = 32, TOPK = 4, DFF = 1024;
constexpr int INW = 8792, NPROJ = 8960;
constexpr int NT_MAX = NTOK * TOPK / 256 + NEXP;
constexpr int PMAX = NT_MAX * 256;
constexpr float EPS = 1e-6f;
constexpr float QA_SCALE = 0.08838834764831845f * 1.4426950408889634f;
constexpr float QB_SCALE = 0.08838834764831845f;
constexpr int NWAVES = 8;

constexpr size_t MiB = 1u << 20;
constexpr size_t WS_CTL = 0, CTL_ZERO_BYTES = 1 * MiB;
constexpr size_t WS_MOD = 1 * MiB;
constexpr size_t WS_TOKE = 2 * MiB, WS_TOKR = WS_TOKE + 256 * 1024, WS_TOKW = WS_TOKR + 256 * 1024, WS_TOKP = WS_TOKW + 256 * 1024;
constexpr size_t WS_TILEE = 3 * MiB;
constexpr size_t WS_DEC = 3 * MiB + 256 * 1024;
constexpr size_t WS_WINT = 4 * MiB, WS_WAT = 22 * MiB, WS_WBT = 24 * MiB, WS_WOT = 26 * MiB, WS_WGUT = 28 * MiB, WS_WDT = 156 * MiB;
constexpr size_t WS_XN = 220 * MiB;
constexpr size_t WS_QA = 252 * MiB, WS_KA = 284 * MiB, WS_VA = 316 * MiB;
constexpr size_t WS_QI = 348 * MiB, WS_QB = 364 * MiB, WS_KB = 380 * MiB;
constexpr size_t WS_VB = 396 * MiB, WS_GB = 428 * MiB, WS_GA = 460 * MiB, WS_GBM = 492 * MiB;
constexpr size_t WS_KI = 524 * MiB;
constexpr size_t WS_SMALL = 526 * MiB;
constexpr size_t WS_MASK = 528 * MiB;
constexpr size_t WS_KVC = 536 * MiB;
constexpr size_t WS_SC = 664 * MiB;
constexpr size_t WS_YA = 728 * MiB, WS_YB = 760 * MiB;
constexpr size_t WS_X1 = 792 * MiB;
constexpr size_t WS_YS = 856 * MiB;
constexpr size_t WS_END = 1000 * MiB;
constexpr size_t WS_MERGED = WS_XN, WS_TMPA = WS_QA  , WS_H2 = WS_QA, WS_XS = WS_VA  , WS_ACT = WS_KVC;
static_assert(WS_XS + (size_t)PMAX * 1024 * 2 <= WS_GA && WS_ACT + (size_t)PMAX * 1024 * 2 <= WS_YA && WS_YS + (size_t)PMAX * 1024 * 2 <= WS_END, "overlays");
constexpr int CW_BAR = 4096;
constexpr int CW_ECNT = 8192;

constexpr int LDS_BYTES = 155648;
constexpr int LDSCTL_OFF = 154624;

#define GAS __attribute__((address_space(1)))
#define LAS __attribute__((address_space(3)))
typedef unsigned short bf16;
typedef unsigned v4u __attribute__((ext_vector_type(4)));
typedef unsigned v2u __attribute__((ext_vector_type(2)));
typedef float f32x4 __attribute__((ext_vector_type(4)));
typedef float f32x16 __attribute__((ext_vector_type(16)));
typedef short bf16x8 __attribute__((ext_vector_type(8)));
typedef short s16x4 __attribute__((ext_vector_type(4)));
typedef GAS unsigned gu32;
typedef unsigned long long u64;
#define LDS_WAIT() asm volatile("s_waitcnt lgkmcnt(0)" ::: "memory")
#define VM_WAIT() asm volatile("s_waitcnt vmcnt(0)" ::: "memory")
#define SBAR() __builtin_amdgcn_sched_barrier(0)
__device__ __forceinline__ unsigned f2bf(float f) { unsigned u = __builtin_bit_cast(unsigned, f); return (u + 0x7fffu + ((u >> 16) & 1u)) >> 16; }
__device__ __forceinline__ unsigned pk2(float lo, float hi) { return f2bf(lo) | (f2bf(hi) << 16); }
__device__ __forceinline__ float bf2f(unsigned short h) { return __builtin_bit_cast(float, (unsigned)h << 16); }
__device__ __forceinline__ float bflo(unsigned w) { return __builtin_bit_cast(float, w << 16); }
__device__ __forceinline__ float bfhi(unsigned w) { return __builtin_bit_cast(float, w & 0xffff0000u); }
__device__ __forceinline__ unsigned cvtpk(float lo, float hi) { unsigned r; asm volatile("v_cvt_pk_bf16_f32 %0, %1, %2" : "=v"(r) : "v"(lo), "v"(hi)); return r; }
__device__ __forceinline__ float wave_sum(float v) {
#pragma unroll
    for (int o = 1; o < 64; o <<= 1) v += __shfl_xor(v, o);
    return v;
}
__device__ __forceinline__ float sigmoidf_(float x) { return 1.f / (1.f + __expf(-x)); }

#define XB_TMO      128
#define XB_XCNT(j)  (256  + 64 * (j))
#define XB_XSUB(j)  (1280 + 64 * (j))
#define XB_XGEN(j)  (2304 + 64 * (j))
#define XB_TOP      3328
#define XB_TOPGEN   3392
#define XCD_BAR_WORDS 3456
#define XB_SPIN_CAP (1u << 18)

__device__ __forceinline__ unsigned xb_ld(unsigned* p)              { return __hip_atomic_load(p, __ATOMIC_RELAXED, __HIP_MEMORY_SCOPE_AGENT); }
__device__ __forceinline__ unsigned xb_add(unsigned* p, unsigned v) { return __hip_atomic_fetch_add(p, v, __ATOMIC_RELAXED, __HIP_MEMORY_SCOPE_AGENT); }
__device__ __forceinline__ unsigned xb_xcc_id() { return (unsigned)__builtin_amdgcn_s_getreg((3 << 11) | 20) & 0xFu; }
#define XB_SPIN(cond, bar) do { unsigned _sp = 0; while (cond) { __builtin_amdgcn_s_sleep(1); \
    if ((++_sp & 255u) == 0u) { if (xb_ld(&(bar)[XB_TMO])) break; if (_sp > XB_SPIN_CAP) { atomicAdd(&(bar)[XB_TMO], 1u); break; } } } } while (0)

struct XcdBarrier {
    unsigned* bar; unsigned x;
    volatile LAS unsigned* st;
};

__device__ __forceinline__ XcdBarrier xcd_barrier_post(unsigned* bar, volatile LAS unsigned* st) {
    XcdBarrier b; b.bar = bar; b.x = xb_xcc_id(); b.st = st;
    if (threadIdx.x == 0) (void)xb_add(&bar[XB_XCNT(b.x)], 1u);
    return b;
}
__device__ __forceinline__ void xcd_barrier_complete(unsigned* bar, unsigned x, unsigned& nloc, unsigned& nx) {
    const unsigned G = gridDim.x * gridDim.y * gridDim.z;
    unsigned sum, cnt, mine, sp = 0u;
    for (;;) {
        sum = 0u; cnt = 0u; mine = 0u;
#pragma unroll
        for (unsigned j = 0; j < 16; ++j) { const unsigned c = xb_ld(&bar[XB_XCNT(j)]); sum += c; cnt += (c > 0u) ? 1u : 0u; mine = (j == x) ? c : mine; }
        if (sum == G) break;
        __builtin_amdgcn_s_sleep(1);
        if ((++sp & 255u) == 0u) { if (xb_ld(&bar[XB_TMO])) break; if (sp > XB_SPIN_CAP) { atomicAdd(&bar[XB_TMO], 1u); break; } }
    }
    nloc = mine > 0u ? mine : 1u; nx = cnt > 0u ? cnt : 1u;
}

__device__ __forceinline__ void xcd_barrier(const XcdBarrier& b) {
    asm volatile("s_waitcnt vmcnt(0)" ::: "memory");
    __syncthreads();
    if (threadIdx.x == 0) {
        unsigned* bar = b.bar;
        __builtin_amdgcn_s_waitcnt(0);
        unsigned nloc = b.st[0], nx = b.st[1];
        if (nloc == 0u) { xcd_barrier_complete(bar, b.x, nloc, nx); b.st[0] = nloc; b.st[1] = nx; }
        const unsigned old = xb_add(&bar[XB_XSUB(b.x)], 1u);
        const unsigned gen = old / nloc;
        if (old + 1u == (gen + 1u) * nloc) {
            __builtin_amdgcn_fence(__ATOMIC_RELEASE, "agent");
            asm volatile("s_waitcnt vmcnt(0)" ::: "memory");
            const unsigned og = xb_add(&bar[XB_TOP], 1u);
            const unsigned tg = og / nx;
            if (og + 1u == (tg + 1u) * nx) xb_add(&bar[XB_TOPGEN], 1u);
            else XB_SPIN(xb_ld(&bar[XB_TOPGEN]) == tg, bar);
            __builtin_amdgcn_fence(__ATOMIC_ACQUIRE, "agent");
            xb_add(&bar[XB_XGEN(b.x)], 1u);
            asm volatile("s_waitcnt vmcnt(0)" ::: "memory");
        } else {
            XB_SPIN(xb_ld(&bar[XB_XGEN(b.x)]) == gen, bar);
            __builtin_amdgcn_fence(__ATOMIC_ACQUIRE, "agent");
            asm volatile("s_waitcnt vmcnt(0)" ::: "memory");
        }
    }
    __syncthreads();
}

struct Ctx {
    LAS unsigned char* lds;
    unsigned char* ws;
    int tid, lane, wave;
    int bid, G;
    int gw, NGW;
};

__device__ __forceinline__ int win_src_col(int n) {
    if (n < 3584) return n;
    if (n < 6656) return n - 3584 + 3656;
    if (n < 8704) return n - 6656 + 6744;
    if (n < 8768) return n - 8704 + 3584;
    if (n < 8776) return n - 8768 + 3648;
    if (n < 8792) return n - 8776 + 6728;
    return -1;
}
__device__ __forceinline__ void tr_item(const float* Wcol, size_t ldw, int K, bf16* WT0, LAS float* scr, int lane) {
#pragma unroll 8
    for (int i = 0; i < 32; ++i) { const int kk = 2 * i + (lane >> 5); scr[kk * 33 + (lane & 31)] = Wcol ? Wcol[(size_t)kk * ldw] : 0.f; }
    LDS_WAIT(); asm volatile("" ::: "memory");
    const int c = lane & 7;
#pragma unroll
    for (int j = 0; j < 4; ++j) { const int n = (lane >> 3) + 8 * j; const LAS float* s = scr + (8 * c) * 33 + n;
        v4u o; o.x = pk2(s[0 * 33], s[1 * 33]); o.y = pk2(s[2 * 33], s[3 * 33]); o.z = pk2(s[4 * 33], s[5 * 33]); o.w = pk2(s[6 * 33], s[7 * 33]);
        *(GAS v4u*)(WT0 + (size_t)n * K + 8 * c) = o; }
    LDS_WAIT(); asm volatile("" ::: "memory");
}
__device__ __forceinline__ void p0_prologue(const Ctx& F, const float* c_in, const float* w_ada, const float* b_ada, const float* w_in, const float* w_a, const float* w_b, const float* w_o,
                                            const float* w_gu, const float* w_dn) {
    LAS float* scr = (LAS float*)(F.lds + F.wave * 16384);
    LAS float* sil = (LAS float*)(F.lds + 131072);
    for (int i = F.tid; i < 4096; i += 512) { const float v = c_in[i]; sil[i] = v / (1.f + __expf(-v)); }
    __syncthreads();
    for (int it = F.gw; it < 384; it += F.NGW) {
        const int col = 16 * it + (F.lane & 15), rg = F.lane >> 4;
        float a0 = 0.f, a1 = 0.f, a2 = 0.f, a3 = 0.f;
        const float* wp = w_ada + (size_t)rg * 6144 + col;
#pragma unroll 8
        for (int i = 0; i < 256; ++i) { const int k = 4 * i + rg; const float w = wp[(size_t)i * 4 * 6144];
            a0 = fmaf(sil[k], w, a0); a1 = fmaf(sil[1024 + k], w, a1); a2 = fmaf(sil[2048 + k], w, a2); a3 = fmaf(sil[3072 + k], w, a3); }
        a0 += __shfl_xor(a0, 16); a0 += __shfl_xor(a0, 32); a1 += __shfl_xor(a1, 16); a1 += __shfl_xor(a1, 32);
        a2 += __shfl_xor(a2, 16); a2 += __shfl_xor(a2, 32); a3 += __shfl_xor(a3, 16); a3 += __shfl_xor(a3, 32);
        if (F.lane < 16) { float* mod = (float*)(F.ws + WS_MOD); const float bb = b_ada[col];
            mod[col] = a0 + bb; mod[6144 + col] = a1 + bb; mod[2 * 6144 + col] = a2 + bb; mod[3 * 6144 + col] = a3 + bb; }
    }
    constexpr int I_IN = 16 * (NPROJ / 32), I_SQ = 16 * 32, I_GU = NEXP * 16 * 64, I_DN = NEXP * 16 * 32;
    constexpr int NITEMS = I_IN + 3 * I_SQ + I_GU + I_DN;
    for (int it = F.gw; it < NITEMS; it += F.NGW) {
        int r = it; const int l31 = F.lane & 31;
        if (r < I_IN) { const int kb = r / (NPROJ / 32), nb = r % (NPROJ / 32); const int sc = win_src_col(32 * nb + l31);
            tr_item(sc >= 0 ? w_in + (size_t)(64 * kb) * INW + sc : nullptr, INW, D, (bf16*)(F.ws + WS_WINT) + (size_t)(32 * nb) * D + 64 * kb, scr, F.lane); continue; }
        r -= I_IN;
        if (r < 3 * I_SQ) { const int which = r / I_SQ; r -= which * I_SQ; const int kb = r / 32, nb = r % 32;
            const float* W = which == 0 ? w_a : (which == 1 ? w_b : w_o); bf16* WT = (bf16*)(F.ws + (which == 0 ? WS_WAT : (which == 1 ? WS_WBT : WS_WOT)));
            tr_item(W + (size_t)(64 * kb) * D + 32 * nb + l31, D, D, WT + (size_t)(32 * nb) * D + 64 * kb, scr, F.lane); continue; }
        r -= 3 * I_SQ;
        if (r < I_GU) { const int e = r / 1024; r -= e * 1024; const int kb = r / 64, nb = r % 64;
            const int n0 = 32 * nb, pn = n0 >> 8, i0 = n0 & 255, sc0 = i0 < 128 ? 128 * pn + i0 : 1024 + 128 * pn + (i0 - 128);
            tr_item(w_gu + (size_t)e * D * 2048 + (size_t)(64 * kb) * 2048 + sc0 + l31, 2048, D, (bf16*)(F.ws + WS_WGUT) + (size_t)e * 2048 * D + (size_t)n0 * D + 64 * kb, scr, F.lane); continue; }
        r -= I_GU;
        { const int e = r / 512; r -= e * 512; const int kb = r / 32, nb = r % 32;
            tr_item(w_dn + (size_t)e * DFF * D + (size_t)(64 * kb) * D + 32 * nb + l31, D, DFF, (bf16*)(F.ws + WS_WDT) + (size_t)e * D * DFF + (size_t)(32 * nb) * DFF + 64 * kb, scr, F.lane); }
    }
}
__device__ __forceinline__ void p1_xn(const Ctx& F, const float* x, const float* g1) {
    const float* mod = (const float*)(F.ws + WS_MOD);
    bf16* XN = (bf16*)(F.ws + WS_XN);
    for (int r0 = 8 * F.gw; r0 < NTOK; r0 += 8 * F.NGW) {
        const int b = r0 / T; const float* mb = mod + b * 6144;
        f32x4 ga[4], sh[4];
#pragma unroll
        for (int j = 0; j < 4; ++j) { const int c = 4 * F.lane + 256 * j; const f32x4 g = *(const f32x4*)(g1 + c), s = *(const f32x4*)(mb + 1024 + c); ga[j] = g * (s + 1.0f); sh[j] = *(const f32x4*)(mb + c); }
        for (int rr = 0; rr < 8; ++rr) { const int m = r0 + rr;
            const GAS f32x4* xr = (const GAS f32x4*)(x + (size_t)m * D) + F.lane;
            f32x4 v[4]; float s = 0.f;
#pragma unroll
            for (int j = 0; j < 4; ++j) { v[j] = xr[64 * j]; s += (v[j].x * v[j].x + v[j].y * v[j].y) + (v[j].z * v[j].z + v[j].w * v[j].w); }
            const float rstd = 1.f / sqrtf(wave_sum(s) * (1.f / D) + EPS);
            GAS u64* o8 = (GAS u64*)(XN + (size_t)m * D) + F.lane;
#pragma unroll
            for (int j = 0; j < 4; ++j) { const f32x4 h = v[j] * rstd * ga[j] + sh[j]; o8[64 * j] = (u64)pk2(h.x, h.y) | ((u64)pk2(h.z, h.w) << 32); }
        }
    }
}
struct EpiProj {
    static constexpr bool PERM = true, AFTER_DRAIN = false;
    unsigned char* ws;
    __device__ __forceinline__ void operator()(const pg8::f32x4 (&acc)[2][2][4][2], const pg8::Unit& u, int wr, int wc, int fr, int fq) const {
        const int pn = u.pn, row0 = u.pm * 256 + wr * 64 + fr;
        if (pn < 34) {
            size_t off; int ld, ct; float sc = 1.f;
            if (pn < 12) { const int t = pn >> 2; off = WS_QA + (size_t)t * 32 * MiB; ld = 1024; ct = (pn & 3) * 256; if (t == 0) sc = QA_SCALE; }
            else if (pn < 18) { const int t = (pn - 12) >> 1; off = WS_QI + (size_t)t * 16 * MiB; ld = 512; ct = ((pn - 12) & 1) * 256; sc = t == 0 ? 0.125f : (t == 1 ? QB_SCALE : 1.f); }
            else { const int t = (pn - 18) >> 2; off = WS_VB + (size_t)t * 32 * MiB; ld = 1024; ct = ((pn - 18) & 3) * 256; }
            bf16* base = (bf16*)(ws + off); const int col0 = ct + wc * 32 + 8 * fq;
#pragma unroll
            for (int ai = 0; ai < 2; ++ai)
#pragma unroll
                for (int m = 0; m < 4; ++m) { bf16* rowp = base + (size_t)(row0 + ai * 128 + m * 16) * ld + col0;
#pragma unroll
                    for (int bj = 0; bj < 2; ++bj) { const pg8::f32x4 v0 = acc[ai][bj][m][0] * sc, v1 = acc[ai][bj][m][1] * sc;
                        v4u w; w.x = cvtpk(v0[0], v0[1]); w.y = cvtpk(v0[2], v0[3]); w.z = cvtpk(v1[0], v1[1]); w.w = cvtpk(v1[2], v1[3]);
                        *(v4u*)(rowp + bj * 128) = w; } }
        } else {
            if (wc < 2) { bf16* KI = (bf16*)(ws + WS_KI);
#pragma unroll
                for (int ai = 0; ai < 2; ++ai)
#pragma unroll
                    for (int m = 0; m < 4; ++m) { const pg8::f32x4 v0 = acc[ai][0][m][0], v1 = acc[ai][0][m][1];
                        v4u w; w.x = cvtpk(v0[0], v0[1]); w.y = cvtpk(v0[2], v0[3]); w.z = cvtpk(v1[0], v1[1]); w.w = cvtpk(v1[2], v1[3]);
                        *(v4u*)(KI + (size_t)(row0 + ai * 128 + m * 16) * 64 + wc * 32 + 8 * fq) = w; } }
            else if (wc == 2) { float* SM = (float*)(ws + WS_SMALL);
#pragma unroll
                for (int ai = 0; ai < 2; ++ai)
#pragma unroll
                    for (int m = 0; m < 4; ++m) { float* p = SM + (size_t)(row0 + ai * 128 + m * 16) * 32 + 8 * fq;
                        *(f32x4*)p = acc[ai][0][m][0]; *(f32x4*)(p + 4) = acc[ai][0][m][1]; } }
        }
    }
};

constexpr int IDX_ROWB = 8192 + 16, IDX_HIST_OFF = 16 * IDX_ROWB  , IDX_MW_OFF = IDX_HIST_OFF + 8 * 1024  ;
static_assert(IDX_MW_OFF + 16 * 64 * 8 <= LDSCTL_OFF, "indexer LDS map");
__device__ __forceinline__ unsigned quant16(float f) {
    const float a = fminf(fabsf(f), 127.f);
    const unsigned code = (__builtin_bit_cast(unsigned, a + 0.00390625f) - 0x3B800000u) >> 12;
    return (f >= 0.f) ? (0x8000u | code) : (0x7FFFu - code);
}
#define WSYNC() do { asm volatile("s_waitcnt lgkmcnt(0)" ::: "memory"); __builtin_amdgcn_wave_barrier(); } while (0)
__device__ __forceinline__ void radix_scan(LAS unsigned* hist, int lane, unsigned need, unsigned& bin, unsigned& cgt) {
    const v4u hv = *(LAS v4u*)(hist + 4 * lane); const unsigned s = hv.x + hv.y + hv.z + hv.w;
    unsigned suf = s;
#pragma unroll
    for (int o = 1; o < 64; o <<= 1) { const unsigned t = __shfl_down(suf, o); if (lane + o < 64) suf += t; }
    const u64 bal = __ballot(suf >= need); const int L = bal ? 63 - __builtin_clzll(bal) : 0;
    const unsigned above = suf - s, c3 = above + hv.w, c2 = c3 + hv.z, c1 = c2 + hv.y;
    unsigned bsel, cg;
    if (c3 >= need) { bsel = 3; cg = above; } else if (c2 >= need) { bsel = 2; cg = c3; } else if (c1 >= need) { bsel = 1; cg = c2; } else { bsel = 0; cg = c1; }
    bin = __shfl(4 * lane + bsel, L); cgt = __shfl(cg, L);
}
__device__ __forceinline__ void p3_indexer(const Ctx& F) {
    const bf16* QI = (const bf16*)(F.ws + WS_QI); const bf16* KI = (const bf16*)(F.ws + WS_KI); const float* SM = (const float*)(F.ws + WS_SMALL);
    u64* MASKT = (u64*)(F.ws + WS_MASK);
    const int lane = F.lane, l15 = lane & 15, g = lane >> 4;
    for (int it = F.bid; it < 1024; it += F.G) {
        int lz = 0; asm volatile("" : "+v"(lz));
        LAS unsigned char* L = F.lds + lz;
        LAS u64* mw = (LAS u64*)(L + IDX_MW_OFF);
        LAS unsigned* hist = (LAS unsigned*)(L + IDX_HIST_OFF + F.wave * 1024);
        const int r = it >> 8, cc = it & 255, b = r, u = (r & 1) ? 255 - cc : cc;
        const int q0 = 16 * u, nvis = ((q0 >> 6) + 1) * 64; const size_t tb = (size_t)b * T;
        if (nvis <= 256) {
            for (int idx = F.tid; idx < 1024; idx += 512) mw[idx] = ((idx & 63) < (nvis >> 6)) ? ~0ull : 0ull;
        } else {
            bf16x8 bq[8][2]; float wq[8];
            { const bf16* qp = QI + (tb + q0 + l15) * 512 + 8 * g; const float* wp = SM + (tb + q0 + l15) * 32;
#pragma unroll
              for (int h = 0; h < 8; ++h) { bq[h][0] = *(const bf16x8*)(qp + h * 64); bq[h][1] = *(const bf16x8*)(qp + h * 64 + 32); wq[h] = wp[h] * 0.35355339059327373f; } }
            for (int j = F.wave; j < (nvis >> 4); j += 8) {
                const int key0 = 16 * j; const bf16* kp = KI + (tb + key0 + l15) * 64 + 8 * g;
                const bf16x8 a0 = *(const bf16x8*)kp, a1 = *(const bf16x8*)(kp + 32);
                float s0 = 0.f, s1 = 0.f, s2 = 0.f, s3 = 0.f;
#pragma unroll
                for (int h = 0; h < 8; ++h) { f32x4 c = {0.f, 0.f, 0.f, 0.f};
                    c = __builtin_amdgcn_mfma_f32_16x16x32_bf16(a0, bq[h][0], c, 0, 0, 0); c = __builtin_amdgcn_mfma_f32_16x16x32_bf16(a1, bq[h][1], c, 0, 0, 0);
                    s0 = fmaf(wq[h], fmaxf(c[0], 0.f), s0); s1 = fmaf(wq[h], fmaxf(c[1], 0.f), s1); s2 = fmaf(wq[h], fmaxf(c[2], 0.f), s2); s3 = fmaf(wq[h], fmaxf(c[3], 0.f), s3); }
                v2u w; w.x = quant16(s0) | (quant16(s1) << 16); w.y = quant16(s2) | (quant16(s3) << 16);
                *(LAS v2u*)(L + l15 * IDX_ROWB + (key0 + 4 * g) * 2) = w;
            }
            __syncthreads();
            for (int qq = 0; qq < 2; ++qq) {
                const int q = 2 * F.wave + qq; LAS unsigned char* rowp = L + q * IDX_ROWB;
                *(LAS v4u*)(hist + 4 * lane) = (v4u){0u, 0u, 0u, 0u}; WSYNC();
                for (int i = 0; i < (nvis >> 7); ++i) { const unsigned v = *(LAS unsigned*)(rowp + (i * 128 + 2 * lane) * 2);
                    __hip_atomic_fetch_add(hist + ((v >> 8) & 255u), 1u, __ATOMIC_RELAXED, __HIP_MEMORY_SCOPE_WORKGROUP); __hip_atomic_fetch_add(hist + (v >> 24), 1u, __ATOMIC_RELAXED, __HIP_MEMORY_SCOPE_WORKGROUP); }
                WSYNC();
                unsigned b1, cgt1; radix_scan(hist, lane, 256u, b1, cgt1); WSYNC();
                const unsigned r1 = 256u - cgt1;
                *(LAS v4u*)(hist + 4 * lane) = (v4u){0u, 0u, 0u, 0u}; WSYNC();
                for (int i = 0; i < (nvis >> 7); ++i) { const unsigned v = *(LAS unsigned*)(rowp + (i * 128 + 2 * lane) * 2);
                    if (((v >> 8) & 255u) == b1) __hip_atomic_fetch_add(hist + (v & 255u), 1u, __ATOMIC_RELAXED, __HIP_MEMORY_SCOPE_WORKGROUP);
                    if ((v >> 24) == b1) __hip_atomic_fetch_add(hist + ((v >> 16) & 255u), 1u, __ATOMIC_RELAXED, __HIP_MEMORY_SCOPE_WORKGROUP); }
                WSYNC();
                unsigned b2, cgt2; radix_scan(hist, lane, r1, b2, cgt2); WSYNC();
                const unsigned thr = (b1 << 8) | b2, rr = r1 - cgt2;
                unsigned eqrun = 0u; u64 mword = 0ull;
                for (int i = 0; i < (nvis >> 6); ++i) { const unsigned code = *(LAS unsigned short*)(rowp + (i * 64 + lane) * 2);
                    const bool eq = code == thr; const u64 em = __ballot(eq);
                    const unsigned pre = __builtin_amdgcn_mbcnt_hi((unsigned)(em >> 32), __builtin_amdgcn_mbcnt_lo((unsigned)em, 0u));
                    const bool sel = code > thr || (eq && (eqrun + pre) < rr); eqrun += (unsigned)__popcll(em);
                    const u64 m = __ballot(sel); if (lane == i) mword = m; }
                mw[q * 64 + lane] = mword;
            }
        }
        __syncthreads();
        for (int idx = F.tid; idx < 1024; idx += 512) { const int t = idx >> 4, q = idx & 15; MASKT[((size_t)b * 64 + t) * T + q0 + q] = mw[q * 64 + t]; }
        __syncthreads();
    }
}

typedef short v4i16_t __attribute__((ext_vector_type(4)));
__device__ __forceinline__ s16x4 trrd(const LAS unsigned char* p) { return __builtin_bit_cast(s16x4, __builtin_amdgcn_ds_read_tr16_b64_v4i16((LAS v4i16_t*)p)); }
__device__ __forceinline__ bf16x8 cat8(s16x4 lo, s16x4 hi) { return (bf16x8){lo[0], lo[1], lo[2], lo[3], hi[0], hi[1], hi[2], hi[3]}; }
constexpr int G1_LR = 0, G1_TOT = 4096, G1_KD = 8192, G1_KDP = 272, G1_V = G1_KD + 64 * G1_KDP, G1_VP = 528;
__device__ __forceinline__ void p3_gla1(const Ctx& F, const float* w_gate_lr, const float* b_gate) {
    bf16* QB = (bf16*)(F.ws + WS_QB); bf16* KB = (bf16*)(F.ws + WS_KB); const bf16* VB = (const bf16*)(F.ws + WS_VB); const float* SM = (const float*)(F.ws + WS_SMALL);
    float* KVC = (float*)(F.ws + WS_KVC); float* DEC = (float*)(F.ws + WS_DEC);
    const int d = F.tid & 127, tq = F.tid >> 7, lane = F.lane, l15 = lane & 15, g = lane >> 4, q4 = l15 >> 2, p4 = lane & 3;
    LAS float* lrs = (LAS float*)(F.lds + G1_LR); LAS float* tot = (LAS float*)(F.lds + G1_TOT);
    for (int it = F.bid; it < 1024; it += F.G) {
        const int bh = it >> 6, c = it & 63, b = bh >> 2, h = bh & 3; const size_t tok0 = (size_t)b * T + 64 * c;
        for (int idx = F.tid; idx < 1024; idx += 512) lrs[idx] = SM[(tok0 + (idx >> 4)) * 32 + 8 + (idx & 15)];
        for (int idx = F.tid; idx < 2048; idx += 512) { const int t = idx >> 5, p = idx & 31; *(LAS v4u*)(F.lds + G1_V + t * G1_VP + 16 * p) = *(const v4u*)(VB + (tok0 + t) * 1024 + h * 256 + 8 * p); }
        float wg[16];
#pragma unroll
        for (int r = 0; r < 16; ++r) wg[r] = w_gate_lr[r * 512 + h * 128 + d];
        const float bg = b_gate[h * 128 + d];
        __syncthreads();
        float Gl[16]; float run = 0.f;
#pragma unroll
        for (int i = 0; i < 16; ++i) { const int t = 16 * tq + i; float z = bg;
#pragma unroll
            for (int r4 = 0; r4 < 4; ++r4) { const f32x4 l = *(LAS f32x4*)(lrs + t * 16 + 4 * r4); z = fmaf(l.x, wg[4 * r4], z); z = fmaf(l.y, wg[4 * r4 + 1], z); z = fmaf(l.z, wg[4 * r4 + 2], z); z = fmaf(l.w, wg[4 * r4 + 3], z); }
            const float la = (fminf(z, 0.f) - log1pf(__expf(-fabsf(z)))) * 0.0625f; run += la; Gl[i] = run; }
        tot[tq * 128 + d] = run;
        __syncthreads();
        float offs = 0.f, glast = 0.f;
#pragma unroll
        for (int qd = 0; qd < 4; ++qd) { const float v = tot[qd * 128 + d]; if (qd < tq) offs += v; glast += v; }
#pragma unroll
        for (int i = 0; i < 16; ++i) { const int t = 16 * tq + i; const float G = Gl[i] + offs; const size_t o = (tok0 + t) * 512 + h * 128 + d;
            const float q = bf2f(QB[o]), k = bf2f(KB[o]);
            QB[o] = (bf16)f2bf(q * __expf(G)); KB[o] = (bf16)f2bf(k * __expf(-G));
            *(LAS unsigned short*)(F.lds + G1_KD + t * G1_KDP + d * 2) = (unsigned short)f2bf(k * __expf(glast - G)); }
        if (tq == 0) DEC[(size_t)(bh * 64 + c) * 128 + d] = __expf(glast);
        __syncthreads();
        const int m0 = 16 * F.wave; bf16x8 a[2];
#pragma unroll
        for (int s = 0; s < 2; ++s) { const LAS unsigned char* ap = F.lds + G1_KD + (32 * s + 8 * g + q4) * G1_KDP + (m0 + 4 * p4) * 2; a[s] = cat8(trrd(ap), trrd(ap + 4 * G1_KDP)); }
        float* out = KVC + (size_t)(bh * 64 + c) * 256 * 128;
#pragma unroll 4
        for (int nt = 0; nt < 16; ++nt) { f32x4 acc = {0.f, 0.f, 0.f, 0.f};
#pragma unroll
            for (int s = 0; s < 2; ++s) { const LAS unsigned char* bp = F.lds + G1_V + (32 * s + 8 * g + q4) * G1_VP + (16 * nt + 4 * p4) * 2; const bf16x8 bv = cat8(trrd(bp), trrd(bp + 4 * G1_VP));
                acc = __builtin_amdgcn_mfma_f32_16x16x32_bf16(a[s], bv, acc, 0, 0, 0); }
            *(f32x4*)(out + (size_t)(16 * nt + l15) * 128 + m0 + 4 * g) = acc; }
        __syncthreads();
    }
}
__device__ __forceinline__ void p4_scan(const Ctx& F) {
    const float* KVC = (const float*)(F.ws + WS_KVC); const float* DEC = (const float*)(F.ws + WS_DEC); bf16* SC = (bf16*)(F.ws + WS_SC);
    for (int e = F.bid * 512 + F.tid; e < 16 * 256 * 32; e += F.G * 512) {
        const int d4 = e & 31, v = (e >> 5) & 255, bh = e >> 13; f32x4 S = {0.f, 0.f, 0.f, 0.f};
#pragma unroll 8
        for (int c = 0; c < 64; ++c) { const size_t o = ((size_t)(bh * 64 + c) * 256 + v) * 128 + 4 * d4;
            const f32x4 kv = *(const f32x4*)(KVC + o), dc = *(const f32x4*)(DEC + (size_t)(bh * 64 + c) * 128 + 4 * d4);
            v2u w; w.x = pk2(S.x, S.y); w.y = pk2(S.z, S.w); *(v2u*)(SC + o) = w;
            S = S * dc + kv; }
    }
}
constexpr int G3_QE = 0, G3_KE = 17408, G3_V = 34816, G3_AM = 68608, G3_AMP = 144, G3_SS = 77824;
__device__ __forceinline__ void p5_gla3(const Ctx& F, const float* gnorm_g) {
    const bf16* QB = (const bf16*)(F.ws + WS_QB); const bf16* KB = (const bf16*)(F.ws + WS_KB); const bf16* VB = (const bf16*)(F.ws + WS_VB); const bf16* GB = (const bf16*)(F.ws + WS_GB);
    const bf16* SC = (const bf16*)(F.ws + WS_SC); bf16* YB = (bf16*)(F.ws + WS_YB);
    const int lane = F.lane, l15 = lane & 15, g = lane >> 4, q4 = l15 >> 2, p4 = lane & 3, w = F.wave;
    LAS float* SS = (LAS float*)(F.lds + G3_SS);
    for (int it = F.bid; it < 1024; it += F.G) {
        const int bh = it >> 6, c = it & 63, b = bh >> 2, h = bh & 3; const size_t tok0 = (size_t)b * T + 64 * c;
        for (int idx = F.tid; idx < 1024; idx += 512) { const int t = idx >> 4, p = idx & 15; const size_t o = (tok0 + t) * 512 + h * 128 + 8 * p;
            *(LAS v4u*)(F.lds + G3_QE + t * 272 + 16 * p) = *(const v4u*)(QB + o); *(LAS v4u*)(F.lds + G3_KE + t * 272 + 16 * p) = *(const v4u*)(KB + o); }
        for (int idx = F.tid; idx < 2048; idx += 512) { const int t = idx >> 5, p = idx & 31; *(LAS v4u*)(F.lds + G3_V + t * G1_VP + 16 * p) = *(const v4u*)(VB + (tok0 + t) * 1024 + h * 256 + 8 * p); }
        bf16x8 bS[2][4];
#pragma unroll
        for (int n = 0; n < 2; ++n)
#pragma unroll
            for (int s = 0; s < 4; ++s) bS[n][s] = *(const bf16x8*)(SC + ((size_t)(bh * 64 + c) * 256 + 32 * w + 16 * n + l15) * 128 + 32 * s + 8 * g);
        __syncthreads();
        { const int mi = w >> 1, mj0 = 2 * (w & 1);
#pragma unroll
          for (int jj = 0; jj < 2; ++jj) { const int mj = mj0 + jj; f32x4 c4 = {0.f, 0.f, 0.f, 0.f};
              if (mj <= mi) {
#pragma unroll
                  for (int s = 0; s < 4; ++s) { const bf16x8 av = *(LAS bf16x8*)(F.lds + G3_QE + (16 * mi + l15) * 272 + (32 * s + 8 * g) * 2), bv = *(LAS bf16x8*)(F.lds + G3_KE + (16 * mj + l15) * 272 + (32 * s + 8 * g) * 2);
                      c4 = __builtin_amdgcn_mfma_f32_16x16x32_bf16(av, bv, c4, 0, 0, 0); } }
#pragma unroll
              for (int r = 0; r < 4; ++r) { const int i = 16 * mi + 4 * g + r, j = 16 * mj + l15; *(LAS unsigned short*)(F.lds + G3_AM + i * G3_AMP + j * 2) = (unsigned short)f2bf(j <= i ? c4[r] : 0.f); } } }
        __syncthreads();
        f32x4 acc[4][2];
#pragma unroll
        for (int m = 0; m < 4; ++m) { acc[m][0] = (f32x4){0.f, 0.f, 0.f, 0.f}; acc[m][1] = (f32x4){0.f, 0.f, 0.f, 0.f}; }
#pragma unroll
        for (int s = 0; s < 4; ++s)
#pragma unroll
            for (int m = 0; m < 4; ++m) { const bf16x8 av = *(LAS bf16x8*)(F.lds + G3_QE + (16 * m + l15) * 272 + (32 * s + 8 * g) * 2);
                acc[m][0] = __builtin_amdgcn_mfma_f32_16x16x32_bf16(av, bS[0][s], acc[m][0], 0, 0, 0); acc[m][1] = __builtin_amdgcn_mfma_f32_16x16x32_bf16(av, bS[1][s], acc[m][1], 0, 0, 0); }
#pragma unroll
        for (int s = 0; s < 2; ++s)
#pragma unroll
            for (int n = 0; n < 2; ++n) { const LAS unsigned char* bp = F.lds + G3_V + (32 * s + 8 * g + q4) * G1_VP + (32 * w + 16 * n + 4 * p4) * 2; const bf16x8 bv = cat8(trrd(bp), trrd(bp + 4 * G1_VP));
#pragma unroll
                for (int m = 0; m < 4; ++m) { const bf16x8 av = *(LAS bf16x8*)(F.lds + G3_AM + (16 * m + l15) * G3_AMP + (32 * s + 8 * g) * 2); acc[m][n] = __builtin_amdgcn_mfma_f32_16x16x32_bf16(av, bv, acc[m][n], 0, 0, 0); } }
#pragma unroll
        for (int m = 0; m < 4; ++m)
#pragma unroll
            for (int r = 0; r < 4; ++r) { float ss = acc[m][0][r] * acc[m][0][r] + acc[m][1][r] * acc[m][1][r];
                ss += __shfl_xor(ss, 1); ss += __shfl_xor(ss, 2); ss += __shfl_xor(ss, 4); ss += __shfl_xor(ss, 8);
                if (l15 == 0) SS[(16 * m + 4 * g + r) * 8 + w] = ss; }
        __syncthreads();
#pragma unroll
        for (int m = 0; m < 4; ++m)
#pragma unroll
            for (int r = 0; r < 4; ++r) { const int row = 16 * m + 4 * g + r; const f32x4 s0 = *(LAS f32x4*)(SS + row * 8), s1 = *(LAS f32x4*)(SS + row * 8 + 4);
                const float rstd = 1.f / sqrtf(((s0.x + s0.y) + (s0.z + s0.w) + (s1.x + s1.y) + (s1.z + s1.w)) * (1.f / 256.f) + EPS);
#pragma unroll
                for (int n = 0; n < 2; ++n) { const int v = 32 * w + 16 * n + l15; const size_t o = (tok0 + row) * 1024 + h * 256 + v;
                    const float gt = bf2f(GB[o]); YB[o] = (bf16)f2bf(acc[m][n][r] * rstd * gnorm_g[v] * (gt * sigmoidf_(gt))); } }
        __syncthreads();
    }
}

namespace att {
constexpr int SHM_K = 16384, SHM_V = 16384, PITCH = 1024;
constexpr float THR = 8.f;
#define KSWZ(row, colB) ((row) * 256 + ((colB) ^ (((row) & 7) << 4)))
__device__ __forceinline__ int v_st(int k, int c) { const int kk = (k & ~0xC) | ((k & 4) << 1) | ((k & 8) >> 1); return ((kk >> 3) * 4 + (c >> 5)) * 512 + ((kk & 7) * 32 + (c & 31)) * 2; }
__device__ __forceinline__ int v_rd_base(int lane) { return ((lane & 3) << 3) | (((lane >> 2) & 3) << 6) | (((lane >> 4) & 1) << 5) | (((lane >> 5) & 1) << 8); }
constexpr int v_rd_off(int d0, int ks, int half) { return d0 * 512 + ks * 4096 + half * 2048; }
__device__ __forceinline__ int crow(int r, int hi) { return (r & 3) + 8 * (r >> 2) + 4 * hi; }
__device__ __forceinline__ void mask_bits(f32x16& p0, f32x16& p1, unsigned lo, unsigned hi32) {
    const float NEG = -__builtin_inff();
#pragma unroll
    for (int r = 0; r < 16; ++r) { const int c = (r & 3) + 8 * (r >> 2);
        if (!((lo >> c) & 1u)) p0[r] = NEG;
        if (!((hi32 >> c) & 1u)) p1[r] = NEG; }
}
__device__ __forceinline__ void partialSM(f32x16& p0, f32x16& p1, float& m_reg, float& mn, float& alpha) {
    float pmax = p0[0];
#pragma unroll
    for (int r = 1; r < 16; ++r) pmax = fmaxf(pmax, p0[r]);
#pragma unroll
    for (int r = 0; r < 16; ++r) pmax = fmaxf(pmax, p1[r]);
    { auto rr = __builtin_amdgcn_permlane32_swap(__float_as_uint(pmax), __float_as_uint(pmax), false, false);
      pmax = fmaxf(__uint_as_float(rr[0]), __uint_as_float(rr[1])); }
    if (__builtin_expect(__all((pmax - m_reg) <= THR), 1)) { mn = m_reg; alpha = 1.f; }
    else { mn = fmaxf(m_reg, pmax); alpha = __builtin_amdgcn_exp2f(m_reg - mn); m_reg = mn; }
#pragma unroll
    for (int r = 0; r < 16; ++r) p0[r] = __builtin_amdgcn_exp2f(p0[r] - mn);
#pragma unroll
    for (int r = 0; r < 16; ++r) p1[r] = __builtin_amdgcn_exp2f(p1[r] - mn);
}
__device__ __forceinline__ void finishSM(f32x16& p0, f32x16& p1, float alpha, float& l_reg, bf16x8& pa0, bf16x8& pa1, bf16x8& pa2, bf16x8& pa3) {
    float ps = 0.f;
#pragma unroll
    for (int r = 0; r < 16; ++r) ps += p0[r];
#pragma unroll
    for (int r = 0; r < 16; ++r) ps += p1[r];
    { auto rr = __builtin_amdgcn_permlane32_swap(__float_as_uint(ps), __float_as_uint(ps), false, false);
      ps = __uint_as_float(rr[0]) + __uint_as_float(rr[1]); }
    l_reg = l_reg * alpha + ps;
#define PK4(P, B_, OUT) do { unsigned a0 = cvtpk(P[B_+0], P[B_+1]), a1 = cvtpk(P[B_+2], P[B_+3]);                          \
        unsigned b0 = cvtpk(P[B_+4], P[B_+5]), b1 = cvtpk(P[B_+6], P[B_+7]);                                             \
        auto r0 = __builtin_amdgcn_permlane32_swap(a0, b0, false, false); auto r1 = __builtin_amdgcn_permlane32_swap(a1, b1, false, false); \
        v4u w_ = {r0[0], r1[0], r0[1], r1[1]}; OUT = __builtin_bit_cast(bf16x8, w_); } while (0)
    PK4(p0, 0, pa0); PK4(p0, 8, pa1); PK4(p1, 0, pa2); PK4(p1, 8, pa3);
#undef PK4
}
template <int KB>
__device__ __forceinline__ void qkt(f32x16& p0, f32x16& p1, const LAS unsigned char* K_lds, int r32, int hi, const bf16x8* qr) {
    p0 = f32x16{}; p1 = f32x16{};
    const LAS unsigned char* kb[4];
#pragma unroll
    for (int dd = 0; dd < 4; ++dd) kb[dd] = K_lds + KB * SHM_K + KSWZ(r32, (dd * 16 + hi * 8) * 2);
#pragma unroll
    for (int d0 = 0; d0 < 8; ++d0) { const LAS unsigned char* a = kb[d0 & 3] + (d0 >> 2) * 128;
        const bf16x8 b0 = *(const LAS bf16x8*)a, b1 = *(const LAS bf16x8*)(a + 32 * 256);
        p0 = __builtin_amdgcn_mfma_f32_32x32x16_bf16(b0, qr[d0], p0, 0, 0, 0);
        p1 = __builtin_amdgcn_mfma_f32_32x32x16_bf16(b1, qr[d0], p1, 0, 0, 0); }
}
template <int VB>
__device__ __forceinline__ void pv_tile(f32x16* o, int vb0, bf16x8 pa0, bf16x8 pa1, bf16x8 pa2, bf16x8 pa3) {
#define TRRD(dst, off) asm volatile("ds_read_b64_tr_b16 %0, %1 offset:%2" : "=&v"(dst) : "v"(vb0), "i"(off) : "memory")
#define PV_D0(d0) do { s16x4 l0, l1, l2, l3, h0, h1, h2, h3; constexpr int b_ = VB * SHM_V + v_rd_off(d0, 0, 0); \
        TRRD(l0, b_); TRRD(h0, b_ + 2048); TRRD(l1, b_ + 4096); TRRD(h1, b_ + 6144); TRRD(l2, b_ + 8192); TRRD(h2, b_ + 10240); TRRD(l3, b_ + 12288); TRRD(h3, b_ + 14336); \
        asm volatile("s_waitcnt lgkmcnt(0)" ::: "memory"); SBAR(); \
        o[d0] = __builtin_amdgcn_mfma_f32_32x32x16_bf16(pa0, (bf16x8){l0[0], l0[1], l0[2], l0[3], h0[0], h0[1], h0[2], h0[3]}, o[d0], 0, 0, 0);   \
        o[d0] = __builtin_amdgcn_mfma_f32_32x32x16_bf16(pa1, (bf16x8){l1[0], l1[1], l1[2], l1[3], h1[0], h1[1], h1[2], h1[3]}, o[d0], 0, 0, 0);   \
        o[d0] = __builtin_amdgcn_mfma_f32_32x32x16_bf16(pa2, (bf16x8){l2[0], l2[1], l2[2], l2[3], h2[0], h2[1], h2[2], h2[3]}, o[d0], 0, 0, 0);   \
        o[d0] = __builtin_amdgcn_mfma_f32_32x32x16_bf16(pa3, (bf16x8){l3[0], l3[1], l3[2], l3[3], h3[0], h3[1], h3[2], h3[3]}, o[d0], 0, 0, 0); } while (0)
    PV_D0(0); PV_D0(1); PV_D0(2); PV_D0(3);
#undef PV_D0
#undef TRRD
}
__device__ __forceinline__ void unit(const Ctx& F, int b, int h, int qb) {
    const bf16* Q = (const bf16*)(F.ws + WS_QA); const bf16* K = (const bf16*)(F.ws + WS_KA); const bf16* V = (const bf16*)(F.ws + WS_VA); bf16* O = (bf16*)(F.ws + WS_YA);
    const u64* MASKT = (const u64*)(F.ws + WS_MASK);
    const int tid = F.tid, wid = F.wave, lane = F.lane, r32 = lane & 31, hi = lane >> 5;
    LAS unsigned char* V_lds = F.lds; LAS unsigned char* K_lds = F.lds + 2 * SHM_V;
    LAS float* wsf = (LAS float*)(F.lds + 2 * SHM_V + 2 * SHM_K) + wid * 64; LAS float* li_l = wsf; LAS float* al_l = wsf + 32;
    const size_t tb = (size_t)b * T; const int NT = 4 * (qb + 1);
    const int sr = tid >> 4, sc = (tid & 15) * 8, vst0 = v_st(sr, sc), vst1 = v_st(32 + sr, sc), kws = KSWZ(sr, sc * 2);
    const int vb0 = (int)(uintptr_t)V_lds + v_rd_base(lane);
    const unsigned kvo = (unsigned)((tb + sr) * PITCH + h * 128 + sc);
    const int qrow = qb * 256 + wid * 32 + r32;
    bf16x8 qr[8];
    { const unsigned qo = (unsigned)((tb + qrow) * PITCH + h * 128 + hi * 8);
#pragma unroll
      for (int d0 = 0; d0 < 8; ++d0) qr[d0] = *(const bf16x8*)(Q + qo + d0 * 16); }
    const unsigned mo = (unsigned)(b * 64 * T + qrow);
    float m_reg = -1e30f, l_reg = 0.f; f32x16 o[4] = {};
    bf16x8 st_k0, st_k1, st_v0, st_v1;
#define SLOAD(t) do { const unsigned r0_ = kvo + (unsigned)((t) * 64 * PITCH); st_k0 = *(const bf16x8*)(K + r0_); st_k1 = *(const bf16x8*)(K + r0_ + 32 * PITCH); st_v0 = *(const bf16x8*)(V + r0_); st_v1 = *(const bf16x8*)(V + r0_ + 32 * PITCH); } while (0)
#define SWRITE(bf) do { *(LAS bf16x8*)(K_lds + (bf) * SHM_K + kws) = st_k0; *(LAS bf16x8*)(K_lds + (bf) * SHM_K + kws + 32 * 256) = st_k1; \
                        *(LAS bf16x8*)(V_lds + (bf) * SHM_V + vst0) = st_v0; *(LAS bf16x8*)(V_lds + (bf) * SHM_V + vst1) = st_v1; } while (0)
#define STEP(t, BUF) do { \
        if ((t) + 1 < NT) SLOAD((t) + 1); \
        const u64 mwd = MASKT[mo + (unsigned)((t) * T)]; \
        f32x16 p0, p1; float mn, alpha; bf16x8 pa0, pa1, pa2, pa3; \
        SBAR(); qkt<BUF>(p0, p1, K_lds, r32, hi, qr); \
        mask_bits(p0, p1, (unsigned)mwd >> (4 * hi), (unsigned)(mwd >> 32) >> (4 * hi)); \
        partialSM(p0, p1, m_reg, mn, alpha); finishSM(p0, p1, alpha, l_reg, pa0, pa1, pa2, pa3); \
        if (__any(alpha < 1.f)) { if (hi == 0) al_l[r32] = alpha; LDS_WAIT(); \
            _Pragma("unroll") for (int d_ = 0; d_ < 4; ++d_) _Pragma("unroll") for (int r = 0; r < 16; ++r) o[d_][r] *= al_l[crow(r, hi)]; } \
        SBAR(); pv_tile<BUF>(o, vb0, pa0, pa1, pa2, pa3); \
        if ((t) + 1 < NT) { VM_WAIT(); SWRITE(1 - (BUF)); } \
        __syncthreads(); } while (0)
    SLOAD(0); VM_WAIT(); SWRITE(0); __syncthreads();
    for (int t = 0; t < NT; t += 2) { STEP(t, 0); STEP(t + 1, 1); }
#undef STEP
#undef SLOAD
#undef SWRITE
    if (hi == 0) li_l[r32] = l_reg; LDS_WAIT();
    const unsigned oo = (unsigned)((tb + qb * 256 + wid * 32) * PITCH + h * 128 + r32);
#pragma unroll
    for (int r = 0; r < 16; ++r) { const int orow = crow(r, hi); const float rl = __builtin_amdgcn_rcpf(li_l[orow]);
#pragma unroll
        for (int d0 = 0; d0 < 4; ++d0) { const float v = o[d0][r] * rl; const float vn = __shfl_xor(v, 1);
            if ((r32 & 1) == 0) *(unsigned*)(O + oo + (unsigned)(orow * PITCH + d0 * 32)) = cvtpk(v, vn); } }
    __syncthreads();
}
}
__device__ __forceinline__ void p4_attention(const Ctx& F) {
    for (int it = F.bid; it < 256; it += F.G) { const int bh = it >> 3, p = it & 7;
        att::unit(F, bh >> 3, bh & 7, 15 - p); att::unit(F, bh >> 3, bh & 7, p); }
}

struct EpiBrA {
    static constexpr bool PERM = false, AFTER_DRAIN = false;
    const bf16* G; float* TMP;
    __device__ __forceinline__ void operator()(const pg8::f32x4 (&acc)[2][2][4][2], const pg8::Unit& u, int wr, int wc, int fr, int fq) const {
        const int row0 = u.pm * 256 + wr * 64 + fr, col0 = u.pn * 256 + wc * 32 + 4 * fq;
#pragma unroll
        for (int ai = 0; ai < 2; ++ai)
#pragma unroll
            for (int m = 0; m < 4; ++m) { const size_t ro = (size_t)(row0 + ai * 128 + m * 16) * 1024 + col0;
#pragma unroll
                for (int bj = 0; bj < 2; ++bj)
#pragma unroll
                    for (int n = 0; n < 2; ++n) { const size_t o = ro + bj * 128 + n * 16; const v2u gw = *(const v2u*)(G + o); const pg8::f32x4 a = acc[ai][bj][m][n];
                        pg8::f32x4 r; r[0] = a[0] * sigmoidf_(bflo(gw.x)); r[1] = a[1] * sigmoidf_(bfhi(gw.x)); r[2] = a[2] * sigmoidf_(bflo(gw.y)); r[3] = a[3] * sigmoidf_(bfhi(gw.y));
                        *(pg8::f32x4*)(TMP + o) = r; } }
    }
};
struct EpiBrB {
    static constexpr bool PERM = false, AFTER_DRAIN = false;
    const bf16* G; const float* TMP; bf16* OUT;
    __device__ __forceinline__ void operator()(const pg8::f32x4 (&acc)[2][2][4][2], const pg8::Unit& u, int wr, int wc, int fr, int fq) const {
        const int row0 = u.pm * 256 + wr * 64 + fr, col0 = u.pn * 256 + wc * 32 + 4 * fq;
#pragma unroll
        for (int ai = 0; ai < 2; ++ai)
#pragma unroll
            for (int m = 0; m < 4; ++m) { const size_t ro = (size_t)(row0 + ai * 128 + m * 16) * 1024 + col0;
#pragma unroll
                for (int bj = 0; bj < 2; ++bj)
#pragma unroll
                    for (int n = 0; n < 2; ++n) { const size_t o = ro + bj * 128 + n * 16; const v2u gw = *(const v2u*)(G + o); const pg8::f32x4 a = acc[ai][bj][m][n], t = *(const pg8::f32x4*)(TMP + o);
                        v2u w; w.x = cvtpk(t[0] + a[0] * sigmoidf_(bflo(gw.x)), t[1] + a[1] * sigmoidf_(bfhi(gw.x))); w.y = cvtpk(t[2] + a[2] * sigmoidf_(bflo(gw.y)), t[3] + a[3] * sigmoidf_(bfhi(gw.y)));
                        *(v2u*)(OUT + o) = w; } }
    }
};
struct EpiOut {
    static constexpr bool PERM = false, AFTER_DRAIN = false;
    const float* X; const float* MOD; float* X1;
    __device__ __forceinline__ void operator()(const pg8::f32x4 (&acc)[2][2][4][2], const pg8::Unit& u, int wr, int wc, int fr, int fq) const {
        const int row0 = u.pm * 256 + wr * 64 + fr, col0 = u.pn * 256 + wc * 32 + 4 * fq; const float* gt = MOD + (u.pm * 256 / T) * 6144 + 2048;
        pg8::f32x4 gv[2][2];
#pragma unroll
        for (int bj = 0; bj < 2; ++bj)
#pragma unroll
            for (int n = 0; n < 2; ++n) gv[bj][n] = *(const pg8::f32x4*)(gt + col0 + bj * 128 + n * 16);
#pragma unroll
        for (int ai = 0; ai < 2; ++ai)
#pragma unroll
            for (int m = 0; m < 4; ++m) { const size_t ro = (size_t)(row0 + ai * 128 + m * 16) * 1024 + col0;
#pragma unroll
                for (int bj = 0; bj < 2; ++bj)
#pragma unroll
                    for (int n = 0; n < 2; ++n) { const size_t o = ro + bj * 128 + n * 16; *(pg8::f32x4*)(X1 + o) = *(const pg8::f32x4*)(X + o) + gv[bj][n] * acc[ai][bj][m][n]; } }
    }
};
constexpr int RW_PITCH = 36, R_CNT = 1024 * RW_PITCH * 4  , R_BASE = R_CNT + 128, R_LE = R_CNT + 256, R_LR = R_LE + 1024;
static_assert(R_LR + 1024 <= LDSCTL_OFF, "router LDS map");
__device__ __forceinline__ float wave_max(float v) {
#pragma unroll
    for (int o = 1; o < 64; o <<= 1) v = fmaxf(v, __shfl_xor(v, o));
    return v;
}
__device__ __forceinline__ void p8_router(const Ctx& F, const float* g2, const float* router_w, const float* router_b) {
    const float* X1 = (const float*)(F.ws + WS_X1); const float* mod = (const float*)(F.ws + WS_MOD); bf16* H2 = (bf16*)(F.ws + WS_H2);
    int* TOKE = (int*)(F.ws + WS_TOKE); int* TOKR = (int*)(F.ws + WS_TOKR); float* TOKW = (float*)(F.ws + WS_TOKW); unsigned* gcnt = (unsigned*)(F.ws + WS_CTL) + CW_ECNT;
    LAS float* rw = (LAS float*)F.lds; LAS unsigned* lcnt = (LAS unsigned*)(F.lds + R_CNT); LAS unsigned* lbase = (LAS unsigned*)(F.lds + R_BASE);
    LAS int* le = (LAS int*)(F.lds + R_LE); LAS int* lrk = (LAS int*)(F.lds + R_LR);
    const int lane = F.lane;
    for (int i = F.tid; i < 8192; i += 512) { const int k = i >> 3, c4 = i & 7; *(LAS f32x4*)(rw + k * RW_PITCH + 4 * c4) = *(const f32x4*)(router_w + k * 32 + 4 * c4); }
    if (F.tid < 32) lcnt[F.tid] = 0u;
    __syncthreads();
    const float rb = router_b[(lane >> 1) & 31];
    for (int it = F.bid; it < NTOK / 64; it += F.G) {
        const int b = (it * 64) / T; const float* mb = mod + b * 6144;
        float ga[16], sh[16];
#pragma unroll
        for (int jj = 0; jj < 16; ++jj) { const int k = lane + 64 * jj; ga[jj] = g2[k] * (1.f + mb[4096 + k]); sh[jj] = mb[3072 + k]; }
        for (int tt = 0; tt < 8; ++tt) { const int lt = F.wave * 8 + tt, m = it * 64 + lt;
            const float* xr = X1 + (size_t)m * D; float hv[16]; float ss = 0.f;
#pragma unroll
            for (int jj = 0; jj < 16; ++jj) { hv[jj] = xr[lane + 64 * jj]; ss = fmaf(hv[jj], hv[jj], ss); }
            const float rstd = 1.f / sqrtf(wave_sum(ss) * (1.f / D) + EPS);
            float pe[32];
#pragma unroll
            for (int e = 0; e < 32; ++e) pe[e] = 0.f;
#pragma unroll
            for (int jj = 0; jj < 16; ++jj) { const int k = lane + 64 * jj; const float h = hv[jj] * rstd * ga[jj] + sh[jj]; H2[(size_t)m * D + k] = (bf16)f2bf(h);
#pragma unroll
                for (int c4 = 0; c4 < 8; ++c4) { const f32x4 w = *(LAS f32x4*)(rw + k * RW_PITCH + 4 * c4);
                    pe[4 * c4] = fmaf(h, w.x, pe[4 * c4]); pe[4 * c4 + 1] = fmaf(h, w.y, pe[4 * c4 + 1]); pe[4 * c4 + 2] = fmaf(h, w.z, pe[4 * c4 + 2]); pe[4 * c4 + 3] = fmaf(h, w.w, pe[4 * c4 + 3]); } }
#define RSTEP(NH, BIT) _Pragma("unroll") for (int e = 0; e < NH; ++e) { const bool up = (lane & BIT) != 0; const float send = up ? pe[e] : pe[e + NH]; const float keep = up ? pe[e + NH] : pe[e]; pe[e] = keep + __shfl_xor(send, BIT); }
            RSTEP(16, 32) RSTEP(8, 16) RSTEP(4, 8) RSTEP(2, 4) RSTEP(1, 2)
#undef RSTEP
            float lg = pe[0] + __shfl_xor(pe[0], 1) + rb;
            int e0, e1, e2, e3; float v0, v1, v2, v3;
#define TOP1(EK, VK) { const float mx = wave_max(lg); const u64 bm = __ballot(lg == mx); const int L = __ffsll((long long)bm) - 1; EK = (L >> 1) & 31; VK = mx; if (((lane >> 1) & 31) == EK) lg = -__builtin_inff(); }
            TOP1(e0, v0) TOP1(e1, v1) TOP1(e2, v2) TOP1(e3, v3)
#undef TOP1
            const float x1_ = __expf(v1 - v0), x2_ = __expf(v2 - v0), x3_ = __expf(v3 - v0), inv = 1.f / (1.f + x1_ + x2_ + x3_);
            if (lane < 4) { const int ek = lane == 0 ? e0 : (lane == 1 ? e1 : (lane == 2 ? e2 : e3)); const float wk = (lane == 0 ? 1.f : (lane == 1 ? x1_ : (lane == 2 ? x2_ : x3_))) * inv;
                const unsigned rk = __hip_atomic_fetch_add(lcnt + ek, 1u, __ATOMIC_RELAXED, __HIP_MEMORY_SCOPE_WORKGROUP);
                TOKE[m * 4 + lane] = ek; TOKW[m * 4 + lane] = wk; le[lt * 4 + lane] = ek; lrk[lt * 4 + lane] = (int)rk; }
        }
        __syncthreads();
        if (F.tid < 32) { lbase[F.tid] = __hip_atomic_fetch_add(gcnt + 64 * F.tid, lcnt[F.tid], __ATOMIC_RELAXED, __HIP_MEMORY_SCOPE_AGENT); lcnt[F.tid] = 0u; }
        __syncthreads();
        if (F.tid < 256) TOKR[it * 256 + F.tid] = lrk[F.tid] + (int)lbase[le[F.tid]];
        __syncthreads();
    }
}
__device__ __forceinline__ void p9_scatter(const Ctx& F) {
    const unsigned* gcnt = (const unsigned*)(F.ws + WS_CTL) + CW_ECNT; int* TILEE = (int*)(F.ws + WS_TILEE);
    const int* TOKE = (const int*)(F.ws + WS_TOKE); const int* TOKR = (const int*)(F.ws + WS_TOKR); int* TOKP = (int*)(F.ws + WS_TOKP);
    const bf16* H2 = (const bf16*)(F.ws + WS_H2); bf16* XS = (bf16*)(F.ws + WS_XS);
    LAS int* poff = (LAS int*)F.lds;
    if (F.tid == 0) { int acc = 0, nt = 0;
        for (int e = 0; e < NEXP; ++e) { const int cnt = (int)__hip_atomic_load(gcnt + 64 * e, __ATOMIC_RELAXED, __HIP_MEMORY_SCOPE_AGENT); poff[e] = acc; const int tiles = (cnt + 255) >> 8;
            if (F.bid == 0) for (int i = 0; i < tiles; ++i) TILEE[nt + i] = e;
            nt += tiles; acc += tiles * 256; }
        if (F.bid == 0) TILEE[NT_MAX] = nt; }
    __syncthreads();
    for (int m = F.gw; m < NTOK; m += F.NGW) {
        const v4u a0 = *(const v4u*)(H2 + (size_t)m * D + 16 * F.lane), a1 = *(const v4u*)(H2 + (size_t)m * D + 16 * F.lane + 8);
#pragma unroll
        for (int k = 0; k < 4; ++k) { const int pos = poff[TOKE[m * 4 + k]] + TOKR[m * 4 + k]; if (F.lane == 0) TOKP[m * 4 + k] = pos;
            *(v4u*)(XS + (size_t)pos * D + 16 * F.lane) = a0; *(v4u*)(XS + (size_t)pos * D + 16 * F.lane + 8) = a1; }
    }
}
struct MoeOrder {
    const int* tile_e; int ntiles, nN, G, c, wsz;
    __device__ __forceinline__ bool next(int i, pg8::Unit& u) const { const long L = (long)i * G + c; if (L >= (long)ntiles * nN) return false;
        u.pm = (int)(L / nN); u.pn = (int)(L % nN); u.e = tile_e[u.pm]; u.boff = u.e * wsz; return true; }
    __device__ __forceinline__ void a_ready(const pg8::Unit&) const {}
    __device__ __forceinline__ void done(const pg8::Unit&) const {}
};
struct EpiSwiglu {
    static constexpr bool PERM = true, AFTER_DRAIN = false;
    const float* bgu; bf16* ACT;
    __device__ __forceinline__ void operator()(const pg8::f32x4 (&acc)[2][2][4][2], const pg8::Unit& u, int wr, int wc, int fr, int fq) const {
        const int row0 = u.pm * 256 + wr * 64 + fr, oc = u.pn * 128 + wc * 32 + 8 * fq; const float* bp = bgu + (size_t)u.e * 2048 + oc;
        const pg8::f32x4 bg0 = *(const pg8::f32x4*)bp, bg1 = *(const pg8::f32x4*)(bp + 4), bu0 = *(const pg8::f32x4*)(bp + 1024), bu1 = *(const pg8::f32x4*)(bp + 1028);
#pragma unroll
        for (int ai = 0; ai < 2; ++ai)
#pragma unroll
            for (int m = 0; m < 4; ++m) { float r[8];
#pragma unroll
                for (int n = 0; n < 2; ++n)
#pragma unroll
                    for (int j = 0; j < 4; ++j) { const float gte = fminf(acc[ai][0][m][n][j] + (n ? bg1[j] : bg0[j]), 7.f), up = fminf(fmaxf(acc[ai][1][m][n][j] + (n ? bu1[j] : bu0[j]), -7.f), 7.f);
                        r[4 * n + j] = (up + 1.f) * (gte * sigmoidf_(1.702f * gte)); }
                v4u w; w.x = cvtpk(r[0], r[1]); w.y = cvtpk(r[2], r[3]); w.z = cvtpk(r[4], r[5]); w.w = cvtpk(r[6], r[7]);
                *(v4u*)(ACT + (size_t)(row0 + ai * 128 + m * 16) * 1024 + oc) = w; }
    }
};
struct EpiDown {
    static constexpr bool PERM = true, AFTER_DRAIN = false;
    const float* bd; bf16* YS;
    __device__ __forceinline__ void operator()(const pg8::f32x4 (&acc)[2][2][4][2], const pg8::Unit& u, int wr, int wc, int fr, int fq) const {
        const int row0 = u.pm * 256 + wr * 64 + fr, col0 = u.pn * 256 + wc * 32 + 8 * fq; const float* bp = bd + (size_t)u.e * 1024 + col0;
        pg8::f32x4 bv[2][2];
#pragma unroll
        for (int bj = 0; bj < 2; ++bj)
#pragma unroll
            for (int n = 0; n < 2; ++n) bv[bj][n] = *(const pg8::f32x4*)(bp + bj * 128 + 4 * n);
#pragma unroll
        for (int ai = 0; ai < 2; ++ai)
#pragma unroll
            for (int m = 0; m < 4; ++m) { bf16* rowp = YS + (size_t)(row0 + ai * 128 + m * 16) * 1024 + col0;
#pragma unroll
                for (int bj = 0; bj < 2; ++bj) { const pg8::f32x4 v0 = acc[ai][bj][m][0] + bv[bj][0], v1 = acc[ai][bj][m][1] + bv[bj][1];
                    v4u w; w.x = cvtpk(v0[0], v0[1]); w.y = cvtpk(v0[2], v0[3]); w.z = cvtpk(v1[0], v1[1]); w.w = cvtpk(v1[2], v1[3]);
                    *(v4u*)(rowp + bj * 128) = w; } }
    }
};
__device__ __forceinline__ void p12_combine(const Ctx& F, const float* final_g, float* out) {
    const float* X1 = (const float*)(F.ws + WS_X1); const float* mod = (const float*)(F.ws + WS_MOD); const bf16* YS = (const bf16*)(F.ws + WS_YS);
    const int* TOKP = (const int*)(F.ws + WS_TOKP); const float* TOKW = (const float*)(F.ws + WS_TOKW);
    for (int m = F.gw; m < NTOK; m += F.NGW) {
        const int b = m / T; const float* gt = mod + b * 6144 + 5120;
        f32x4 a[4];
#pragma unroll
        for (int j = 0; j < 4; ++j) a[j] = (f32x4){0.f, 0.f, 0.f, 0.f};
#pragma unroll
        for (int k = 0; k < 4; ++k) { const int pos = TOKP[m * 4 + k]; const float w = TOKW[m * 4 + k];
#pragma unroll
            for (int j = 0; j < 4; ++j) { const v2u y = *(const v2u*)(YS + (size_t)pos * D + 4 * F.lane + 256 * j);
                a[j][0] = fmaf(w, bflo(y.x), a[j][0]); a[j][1] = fmaf(w, bfhi(y.x), a[j][1]); a[j][2] = fmaf(w, bflo(y.y), a[j][2]); a[j][3] = fmaf(w, bfhi(y.y), a[j][3]); } }
        float ss = 0.f;
#pragma unroll
        for (int j = 0; j < 4; ++j) { const int c = 4 * F.lane + 256 * j; a[j] = *(const f32x4*)(X1 + (size_t)m * D + c) + *(const f32x4*)(gt + c) * a[j];
            ss += (a[j].x * a[j].x + a[j].y * a[j].y) + (a[j].z * a[j].z + a[j].w * a[j].w); }
        const float rstd = 1.f / sqrtf(wave_sum(ss) * (1.f / D) + EPS);
#pragma unroll
        for (int j = 0; j < 4; ++j) { const int c = 4 * F.lane + 256 * j; *(f32x4*)(out + (size_t)m * D + c) = a[j] * rstd * *(const f32x4*)(final_g + c); }
    }
}

constexpr int NPH = 13;
struct Args { const float* in[20]; float* out; unsigned char* ws; int ph_lo, ph_hi; };
__global__ void __launch_bounds__(NWAVES * 64, 2) mk_fwd(Args args) {
    extern __shared__ __attribute__((aligned(16))) unsigned char lds_raw[];
    LAS unsigned char* const lds_ = (LAS unsigned char*)lds_raw;
#define MKCTX() Ctx F; { int t_ = threadIdx.x; asm volatile("" : "+v"(t_)); F.lds = lds_; F.ws = args.ws; F.tid = t_; F.lane = t_ & 63; F.wave = __builtin_amdgcn_readfirstlane(t_ >> 6); \
        F.bid = blockIdx.x; F.G = gridDim.x; F.gw = F.bid * NWAVES + F.wave; F.NGW = F.G * NWAVES; }
    const float* x = args.in[0]; const float* c_in = args.in[1]; const float* w_ada = args.in[2]; const float* b_ada = args.in[3]; const float* norm1_g = args.in[4];
    const float* w_in = args.in[5]; const float* w_gate_lr = args.in[6]; const float* b_gate = args.in[7]; const float* gla_norm_g = args.in[8];
    const float* w_br_a = args.in[9]; const float* w_br_b = args.in[10]; const float* w_out = args.in[11]; const float* norm2_g = args.in[12];
    const float* router_w = args.in[13]; const float* router_b = args.in[14]; const float* w_gu = args.in[15]; const float* b_gu = args.in[16];
    const float* w_dn = args.in[17]; const float* b_dn = args.in[18]; const float* final_g = args.in[19];
    unsigned char* ws = args.ws;
    for (int u = threadIdx.x; u < (LDS_BYTES - LDSCTL_OFF) / 4; u += NWAVES * 64) ((LAS unsigned*)(lds_ + LDSCTL_OFF))[u] = 0u;
    __syncthreads();
    const int lo = args.ph_lo, hi = args.ph_hi;
    const bool multi = (hi - lo) > 1;
    XcdBarrier bar; bar.bar = (unsigned*)(ws + WS_CTL) + CW_BAR; bar.x = 0; bar.st = (volatile LAS unsigned*)(lds_ + LDSCTL_OFF + 32);
    if (multi) bar = xcd_barrier_post((unsigned*)(ws + WS_CTL) + CW_BAR, (volatile LAS unsigned*)(lds_ + LDSCTL_OFF + 32));
#define IN(k) (lo <= (k) && (k) < hi)
#define SEAM(k) do { if (IN(k) && IN((k) + 1)) xcd_barrier(bar); } while (0)

    if (IN(0)) { MKCTX(); p0_prologue(F, c_in, w_ada, b_ada, w_in, w_br_a, w_br_b, w_out, w_gu, w_dn); }
    SEAM(0);
    if (IN(1)) { MKCTX(); p1_xn(F, x, norm1_g); }
    SEAM(1);
    if (IN(2)) { MKCTX(); pg8::Gemm g{(const bf16*)(ws + WS_XN), (const bf16*)(ws + WS_WINT), NTOK, NPROJ, D}; pg8::StaticOrder S; S.init(NTOK, NPROJ, F.G, F.bid);
        EpiProj E{ws}; pg8::gemm_phase<EpiProj, pg8::StaticOrder, true, true>(F.lds, g, S, E); }
    SEAM(2);
    if (IN(3)) { { MKCTX(); p3_indexer(F); } { MKCTX(); p3_gla1(F, w_gate_lr, b_gate); } }
    SEAM(3);
    if (IN(4)) { { MKCTX(); p4_attention(F); } { MKCTX(); p4_scan(F); } }
    SEAM(4);
    if (IN(5)) { MKCTX(); p5_gla3(F, gla_norm_g); }
    SEAM(5);
    if (IN(6)) { MKCTX();
        { pg8::Gemm g{(const bf16*)(ws + WS_YA), (const bf16*)(ws + WS_WAT), NTOK, D, D}; pg8::StaticOrder S; S.init(NTOK, D, F.G, F.bid);
          EpiBrA E{(const bf16*)(ws + WS_GA), (float*)(ws + WS_TMPA)}; pg8::gemm_phase<EpiBrA, pg8::StaticOrder, true, true>(F.lds, g, S, E); }
        { pg8::Gemm g{(const bf16*)(ws + WS_YB), (const bf16*)(ws + WS_WBT), NTOK, D, D}; pg8::StaticOrder S; S.init(NTOK, D, F.G, F.bid);
          EpiBrB E{(const bf16*)(ws + WS_GBM), (const float*)(ws + WS_TMPA), (bf16*)(ws + WS_MERGED)}; pg8::gemm_phase<EpiBrB, pg8::StaticOrder, true, true>(F.lds, g, S, E); }
    }
    SEAM(6);
    if (IN(7)) { MKCTX(); pg8::Gemm g{(const bf16*)(ws + WS_MERGED), (const bf16*)(ws + WS_WOT), NTOK, D, D}; pg8::StaticOrder S; S.init(NTOK, D, F.G, F.bid);
        EpiOut E{x, (const float*)(ws + WS_MOD), (float*)(ws + WS_X1)}; pg8::gemm_phase<EpiOut, pg8::StaticOrder, true, true>(F.lds, g, S, E); }
    SEAM(7);
    if (IN(8)) { MKCTX(); p8_router(F, norm2_g, router_w, router_b); }
    SEAM(8);
    if (IN(9)) { MKCTX(); p9_scatter(F); }
    SEAM(9);
    if (IN(10)) { MKCTX(); const int* tile_e = (const int*)(ws + WS_TILEE); const int ntiles = tile_e[NT_MAX];
        pg8::Gemm g{(const bf16*)(ws + WS_XS), (const bf16*)(ws + WS_WGUT), PMAX, 2048, D}; MoeOrder S{tile_e, ntiles, 8, F.G, F.bid, 2048 * D};
        EpiSwiglu E{b_gu, (bf16*)(ws + WS_ACT)}; pg8::gemm_phase<EpiSwiglu, MoeOrder, true, true>(F.lds, g, S, E); }
    SEAM(10);
    if (IN(11)) { MKCTX(); const int* tile_e = (const int*)(ws + WS_TILEE); const int ntiles = tile_e[NT_MAX];
        pg8::Gemm g{(const bf16*)(ws + WS_ACT), (const bf16*)(ws + WS_WDT), PMAX, D, DFF}; MoeOrder S{tile_e, ntiles, 4, F.G, F.bid, D * DFF};
        EpiDown E{b_dn, (bf16*)(ws + WS_YS)}; pg8::gemm_phase<EpiDown, MoeOrder, true, true>(F.lds, g, S, E); }
    SEAM(11);
    if (IN(12)) { MKCTX(); p12_combine(F, final_g, args.out); }
#undef IN
#undef SEAM
}

#ifndef MK_N_LAUNCHES
#define MK_N_LAUNCHES 1
#endif
extern "C" void kernel_launch(void* const* d_in, const int* in_sizes, int n_in, void* d_out, int out_size, void* d_ws, size_t ws_size, hipStream_t stream) {
    static int grid = 0;
    if (grid == 0) {
        if (n_in != 20 || out_size != NTOK * D || ws_size < WS_END) { fprintf(stderr, "kernel_launch: unexpected shapes (n_in %d out %d ws %zu)\n", n_in, out_size, ws_size); grid = -1; return; }
        int dev = 0, cus = 0, per_cu = 0;
        if (hipGetDevice(&dev) != hipSuccess || hipDeviceGetAttribute(&cus, hipDeviceAttributeMultiprocessorCount, dev) != hipSuccess) { grid = -1; return; }
        if (hipFuncSetAttribute((const void*)mk_fwd, hipFuncAttributeMaxDynamicSharedMemorySize, LDS_BYTES) != hipSuccess) { fprintf(stderr, "kernel_launch: hipFuncSetAttribute failed\n"); grid = -1; return; }
        if (hipOccupancyMaxActiveBlocksPerMultiprocessor(&per_cu, (const void*)mk_fwd, NWAVES * 64, LDS_BYTES) != hipSuccess || per_cu < 1) { fprintf(stderr, "kernel_launch: occupancy query says %d\n", per_cu); }
        (void)hipGetLastError();
        grid = cus;
    }
    if (grid < 0) return;
    if (hipMemsetAsync((char*)d_ws + WS_CTL, 0, CTL_ZERO_BYTES, stream) != hipSuccess) return;
    Args a{};
    for (int i = 0; i < 20; ++i) a.in[i] = (const float*)d_in[i];
    a.out = (float*)d_out; a.ws = (unsigned char*)d_ws;
#if MK_N_LAUNCHES == 1
    a.ph_lo = 0; a.ph_hi = NPH;
    hipLaunchKernelGGL(mk_fwd, dim3(grid), dim3(NWAVES * 64), LDS_BYTES, stream, a);
#else
    for (int p = 0; p < NPH; ++p) { a.ph_lo = p; a.ph_hi = p + 1; hipLaunchKernelGGL(mk_fwd, dim3(grid), dim3(NWAVES * 64), LDS_BYTES, stream, a); }
#endif
}
```

```cpp
#include <hip/hip_runtime.h>
#include <cstdio>
#include <cstdint>
namespace pg8 {
#define PG8_LAS __attribute__((address_space(3)))
typedef unsigned short bf16_t;
typedef short bf16x8 __attribute__((ext_vector_type(8)));
typedef float f32x4 __attribute__((ext_vector_type(4)));
typedef unsigned u32x4 __attribute__((ext_vector_type(4)));
typedef unsigned u32x2 __attribute__((ext_vector_type(2)));
constexpr int BM = 256, BK = 64, HALF = 128, HTB = HALF * BK * 2  , STAGE_BYTES = 8 * HTB, NXCD = 8, WGM = 8;

__host__ __device__ __forceinline__ int lds_byte(int r, int c) { const int st = (r >> 4) * 2 + (c >> 5), rr = r & 15, cc = c & 31, ob = rr * 64 + cc * 2; return st * 1024 + (ob ^ (((ob >> 9) & 1) << 5)); }
__host__ __device__ __forceinline__ void stage_rc(int b, int& R, int& C) { const int st = b / 1024, sb = b % 1024, swz = sb ^ (((sb >> 9) & 1) << 5); R = (st >> 1) * 16 + swz / 64; C = (st & 1) * 32 + (swz % 64) / 2; }
__host__ __device__ __forceinline__ int perm32(int rho) { const int n = rho >> 4, i = rho & 15; return 8 * (i >> 2) + 4 * n + (i & 3); }

struct Unit { int pm, pn, e, boff; };
struct Gemm { const bf16_t* A; const bf16_t* Bt; int M, N, K; };

struct StaticOrder {
    int nM, nN, nwg, G, c;
    __host__ __device__ void init(int M, int N, int G_, int c_) { nM = M / BM; nN = N / BM; nwg = nM * nN; G = G_; c = c_; }
    __host__ __device__ bool next(int i, Unit& u) const {
        const long L = (long)i * G + c; if (L >= nwg) return false;
        int wgid = (int)L; { const int q = nwg / NXCD, r = nwg % NXCD, xcd = wgid % NXCD, off = wgid / NXCD; wgid = (xcd < r ? xcd * (q + 1) : r * (q + 1) + (xcd - r) * q) + off; }
        const int nig = WGM * nN, gid = wgid / nig, fm = gid * WGM, gsz = (nM - fm) < WGM ? (nM - fm) : WGM;
        u.pm = fm + ((wgid % nig) % gsz); u.pn = (wgid % nig) / gsz; u.e = 0; u.boff = 0; return true;
    }
    __device__ __forceinline__ void a_ready(const Unit&) const {}
    __device__ __forceinline__ void done(const Unit&) const {}
};
__device__ __forceinline__ unsigned cvt_pk_bf16(float lo, float hi) { unsigned r; asm volatile("v_cvt_pk_bf16_f32 %0, %1, %2" : "=v"(r) : "v"(lo), "v"(hi)); return r; }

template <class Epi, class Sched, bool ALIGN_EPI = false, bool SP2 = false>
__device__ __forceinline__ void gemm_phase(PG8_LAS unsigned char* lds, const Gemm g, const Sched& S, const Epi& E) {
    const int tid = threadIdx.x, wid = __builtin_amdgcn_readfirstlane(tid >> 6), lane = tid & 63, wr = wid >> 2, wc = wid & 3, fr = lane & 15, fq = lane >> 4;
    const int K = g.K, nt = K / BK;
    unsigned voffA[2], voffB[2];
#pragma unroll
    for (int i = 0; i < 2; ++i) { int R, C; stage_rc(tid * 16 + i * 8192, R, C); const int Rb = Epi::PERM ? ((R & ~31) + perm32(R & 31)) : R;
        voffA[i] = (unsigned)(R * K + C) * 2u; voffB[i] = (unsigned)(Rb * K + C) * 2u; }
    const size_t kstep = (size_t)(BK * 2);
    const size_t hstep = (size_t)HALF * K * 2;
    const size_t tstep = 2 * hstep;
    const unsigned ldsw = (unsigned)wid * 1024u;
    const int aoff = lds_byte(wr * 64 + fr, fq * 8), boff = lds_byte(wc * 32 + fr, fq * 8);
#define PG8_SA(b, h) (((b) * 2 + (h)) * HTB)
#define PG8_SB(b, h) ((4 + (b) * 2 + (h)) * HTB)
#define PG8_STAGE(bufoff, gbase, voff) do { _Pragma("unroll") for (int _i = 0; _i < 2; ++_i) \
        __builtin_amdgcn_global_load_lds((const unsigned*)((const char*)(gbase) + (voff)[_i]), (PG8_LAS unsigned*)(lds + (bufoff) + ldsw + _i * 8192), 16, 0, 0); } while (0)
#define PG8_LDA(dst, b, h) do { _Pragma("unroll") for (int m = 0; m < 4; ++m) _Pragma("unroll") for (int k = 0; k < 2; ++k) dst[m][k] = *(const PG8_LAS bf16x8*)(lds + PG8_SA(b, h) + aoff + m * 2048 + k * 1024); } while (0)
#define PG8_LDB(dst, b, h) do { _Pragma("unroll") for (int n = 0; n < 2; ++n) _Pragma("unroll") for (int k = 0; k < 2; ++k) dst[n][k] = *(const PG8_LAS bf16x8*)(lds + PG8_SB(b, h) + boff + n * 2048 + k * 1024); } while (0)
#define PG8_MMA(ai, bj, At, Bt) do { __builtin_amdgcn_s_setprio(1); _Pragma("unroll") for (int m = 0; m < 4; ++m) _Pragma("unroll") for (int n = 0; n < 2; ++n) _Pragma("unroll") for (int k = 0; k < 2; ++k) \
        acc[ai][bj][m][n] = __builtin_amdgcn_mfma_f32_16x16x32_bf16(Bt[n][k], At[m][k], acc[ai][bj][m][n], 0, 0, 0); __builtin_amdgcn_s_setprio(0); } while (0)
#define PG8_WAIT_V(n) asm volatile("s_waitcnt vmcnt(" #n ")" ::: "memory")
#define PG8_WAIT_L(n) asm volatile("s_waitcnt lgkmcnt(" #n ")" ::: "memory")
#define PG8_BAR __builtin_amdgcn_s_barrier()
#define PG8_SCHED __builtin_amdgcn_sched_barrier(0)
    Unit cur, nxt; int ui = 0;
    if (!S.next(0, cur)) return;
    f32x4 acc[2][2][4][2];
#pragma unroll
    for (int a = 0; a < 2; ++a)
#pragma unroll
        for (int b = 0; b < 2; ++b)
#pragma unroll
            for (int m = 0; m < 4; ++m)
#pragma unroll
                for (int n = 0; n < 2; ++n) acc[a][b][m][n] = (f32x4){0.f, 0.f, 0.f, 0.f};
    bf16x8 At[4][2], B0[2][2], B1[2][2];
    const char* cA = (const char*)g.A + (size_t)cur.pm * tstep; const char* cB = (const char*)g.Bt + (size_t)cur.boff * 2 + (size_t)cur.pn * tstep;
    S.a_ready(cur);
    if constexpr (SP2) {
        PG8_STAGE(PG8_SB(0, 0), cB, voffB); PG8_STAGE(PG8_SB(0, 1), cB + hstep, voffB); PG8_STAGE(PG8_SA(0, 0), cA, voffA); PG8_STAGE(PG8_SA(0, 1), cA + hstep, voffA);
        if (wr == 1) PG8_BAR;
        PG8_WAIT_V(2); PG8_BAR;
        PG8_STAGE(PG8_SB(1, 0), cB + kstep, voffB); PG8_STAGE(PG8_SA(1, 0), cA + kstep, voffA); PG8_STAGE(PG8_SB(1, 1), cB + hstep + kstep, voffB);
        PG8_WAIT_V(6); PG8_BAR;
    } else {
        PG8_STAGE(PG8_SB(0, 0), cB, voffB); PG8_STAGE(PG8_SA(0, 0), cA, voffA); PG8_STAGE(PG8_SB(0, 1), cB + hstep, voffB); PG8_STAGE(PG8_SA(0, 1), cA + hstep, voffA);
        if (wr == 1) PG8_BAR;
        PG8_WAIT_V(4); PG8_BAR;
        PG8_STAGE(PG8_SB(1, 0), cB + kstep, voffB); PG8_STAGE(PG8_SA(1, 0), cA + kstep, voffA); PG8_STAGE(PG8_SB(1, 1), cB + hstep + kstep, voffB);
        PG8_WAIT_V(6); PG8_BAR;
    }
    for (;;) {
        const bool has_next = S.next(ui + 1, nxt);
        const char* nA = has_next ? (const char*)g.A + (size_t)nxt.pm * tstep : cA; const char* nB = has_next ? (const char*)g.Bt + (size_t)nxt.boff * 2 + (size_t)nxt.pn * tstep : cB;
        for (int t = 0; t < nt; t += 2) {
            const bool last = (t == nt - 2);
            const char* a1 = cA + (size_t)(t + 1) * kstep;
            const char* a2 = last ? nA : cA + (size_t)(t + 2) * kstep; const char* b2 = last ? nB : cB + (size_t)(t + 2) * kstep;
            const char* a3 = a2 + kstep; const char* b3 = b2 + kstep;
            if (last && has_next) S.a_ready(nxt);
            if constexpr (SP2) {
            PG8_LDB(B0, 0, 0); PG8_LDB(B1, 0, 1); PG8_SCHED; PG8_LDA(At, 0, 0); PG8_STAGE(PG8_SA(1, 1), a1 + hstep, voffA);
            PG8_WAIT_V(8); PG8_WAIT_L(0); PG8_BAR; PG8_MMA(0, 0, At, B0); PG8_MMA(0, 1, At, B1); PG8_BAR; PG8_SCHED;
            PG8_LDA(At, 0, 1); PG8_STAGE(PG8_SB(0, 0), b2, voffB); PG8_STAGE(PG8_SB(0, 1), b2 + hstep, voffB); PG8_STAGE(PG8_SA(0, 0), a2, voffA);
            PG8_WAIT_V(8); PG8_WAIT_L(0); PG8_BAR; PG8_MMA(1, 0, At, B0); PG8_MMA(1, 1, At, B1); PG8_BAR; PG8_SCHED;
            PG8_LDB(B0, 1, 0); PG8_LDB(B1, 1, 1); PG8_SCHED; PG8_LDA(At, 1, 0); PG8_STAGE(PG8_SA(0, 1), a2 + hstep, voffA);
            PG8_WAIT_V(8); PG8_WAIT_L(0); PG8_BAR; PG8_MMA(0, 0, At, B0); PG8_MMA(0, 1, At, B1); PG8_BAR; PG8_SCHED;
            PG8_LDA(At, 1, 1); PG8_STAGE(PG8_SB(1, 0), b3, voffB); PG8_STAGE(PG8_SB(1, 1), b3 + hstep, voffB); PG8_STAGE(PG8_SA(1, 0), a3, voffA);
            PG8_WAIT_V(8); PG8_WAIT_L(0); PG8_BAR; PG8_MMA(1, 0, At, B0); PG8_MMA(1, 1, At, B1); PG8_BAR; PG8_SCHED;
            } else {
            PG8_LDB(B0, 0, 0); PG8_SCHED; PG8_LDA(At, 0, 0); PG8_STAGE(PG8_SA(1, 1), a1 + hstep, voffA);
            PG8_WAIT_L(8); PG8_BAR; PG8_WAIT_L(0); PG8_MMA(0, 0, At, B0); PG8_BAR; PG8_SCHED;
            PG8_LDB(B1, 0, 1); PG8_STAGE(PG8_SB(0, 0), b2, voffB);
            PG8_BAR; PG8_WAIT_L(0); PG8_MMA(0, 1, At, B1); PG8_BAR;
            PG8_LDA(At, 0, 1); PG8_STAGE(PG8_SA(0, 0), a2, voffA);
            PG8_BAR; PG8_WAIT_L(0); PG8_MMA(1, 0, At, B0); PG8_BAR; PG8_SCHED;
            PG8_STAGE(PG8_SB(0, 1), b2 + hstep, voffB);
            PG8_WAIT_V(6); PG8_BAR; PG8_MMA(1, 1, At, B1); PG8_BAR;
            PG8_LDB(B0, 1, 0); PG8_SCHED; PG8_LDA(At, 1, 0); PG8_STAGE(PG8_SA(0, 1), a2 + hstep, voffA);
            PG8_WAIT_L(8); PG8_BAR; PG8_WAIT_L(0); PG8_MMA(0, 0, At, B0); PG8_BAR; PG8_SCHED;
            PG8_LDB(B1, 1, 1); PG8_STAGE(PG8_SB(1, 0), b3, voffB);
            PG8_BAR; PG8_WAIT_L(0); PG8_MMA(0, 1, At, B1); PG8_BAR;
            PG8_LDA(At, 1, 1); PG8_STAGE(PG8_SA(1, 0), a3, voffA);
            PG8_BAR; PG8_WAIT_L(0); PG8_MMA(1, 0, At, B0); PG8_BAR; PG8_SCHED;
            PG8_STAGE(PG8_SB(1, 1), b3 + hstep, voffB);
            PG8_WAIT_V(6); PG8_BAR; PG8_MMA(1, 1, At, B1); PG8_BAR;
            }
        }
        if constexpr (ALIGN_EPI) { if (wr == 0) PG8_BAR; }
        if constexpr (!Epi::AFTER_DRAIN) { E(acc, cur, wr, wc, fr, fq); S.done(cur); }
        if (!has_next) break;
#pragma unroll
        for (int a = 0; a < 2; ++a)
#pragma unroll
            for (int b = 0; b < 2; ++b)
#pragma unroll
                for (int m = 0; m < 4; ++m)
#pragma unroll
                    for (int n = 0; n < 2; ++n) acc[a][b][m][n] = (f32x4){0.f, 0.f, 0.f, 0.f};
        cur = nxt; cA = nA; cB = nB; ++ui;
        if constexpr (ALIGN_EPI) { if (wr == 1) PG8_BAR; }
    }
    PG8_WAIT_V(0);
    if constexpr (!ALIGN_EPI) { if (wr == 0) PG8_BAR; }
    PG8_BAR;
    if constexpr (Epi::AFTER_DRAIN) { E.fused(acc, cur, wr, wc, fr, fq, lds, wid, lane); S.done(cur); }
#undef PG8_SA
#undef PG8_SB
#undef PG8_STAGE
#undef PG8_LDA
#undef PG8_LDB
#undef PG8_MMA
#undef PG8_WAIT_V
#undef PG8_WAIT_L
#undef PG8_BAR
#undef PG8_SCHED
}
}

constexpr int NB = 4, T = 4096, D = 1024, NTOK = NB * T;
constexpr int NEXP = 32, TOPK = 4, DFF = 1024;
constexpr int INW = 8792, NPROJ = 8960;
constexpr int NT_MAX = NTOK * TOPK / 256 + NEXP;
constexpr int PMAX = NT_MAX * 256;
constexpr float EPS = 1e-6f;
constexpr float QA_SCALE = 0.08838834764831845f * 1.4426950408889634f;
constexpr float QB_SCALE = 0.08838834764831845f;
constexpr int NWAVES = 8;

constexpr size_t MiB = 1u << 20;
constexpr size_t WS_CTL = 0, CTL_ZERO_BYTES = 1 * MiB;
constexpr size_t WS_MOD = 1 * MiB;
constexpr size_t WS_TOKE = 2 * MiB, WS_TOKR = WS_TOKE + 256 * 1024, WS_TOKW = WS_TOKR + 256 * 1024, WS_TOKP = WS_TOKW + 256 * 1024;
constexpr size_t WS_TILEE = 3 * MiB;
constexpr size_t WS_DEC = 3 * MiB + 256 * 1024;
constexpr size_t WS_WINT = 4 * MiB, WS_WAT = 22 * MiB, WS_WBT = 24 * MiB, WS_WOT = 26 * MiB, WS_WGUT = 28 * MiB, WS_WDT = 156 * MiB;
constexpr size_t WS_XN = 220 * MiB;
constexpr size_t WS_QA = 252 * MiB, WS_KA = 284 * MiB, WS_VA = 316 * MiB;
constexpr size_t WS_QI = 348 * MiB, WS_QB = 364 * MiB, WS_KB = 380 * MiB;
constexpr size_t WS_VB = 396 * MiB, WS_GB = 428 * MiB, WS_GA = 460 * MiB, WS_GBM = 492 * MiB;
constexpr size_t WS_KI = 524 * MiB;
constexpr size_t WS_SMALL = 526 * MiB;
constexpr size_t WS_MASK = 528 * MiB;
constexpr size_t WS_KVC = 536 * MiB;
constexpr size_t WS_SC = 664 * MiB;
constexpr size_t WS_YA = 728 * MiB, WS_YB = 760 * MiB;
constexpr size_t WS_X1 = 792 * MiB;
constexpr size_t WS_YS = 856 * MiB;
constexpr size_t WS_END = 1000 * MiB;
constexpr size_t WS_QE = WS_XN, WS_KE = WS_XN + 16 * MiB;
constexpr size_t WS_MERGED = WS_XN, WS_TMPA = WS_QA  , WS_H2 = WS_QA, WS_XS = WS_VA  , WS_ACT = WS_KVC;
static_assert(WS_XS + (size_t)PMAX * 1024 * 2 <= WS_GA && WS_ACT + (size_t)PMAX * 1024 * 2 <= WS_YA && WS_YS + (size_t)PMAX * 1024 * 2 <= WS_END, "overlays");
constexpr int CW_BAR = 4096;
constexpr int CW_ECNT = 8192;

constexpr int LDS_BYTES = 155648;
constexpr int LDSCTL_OFF = 154624;

#define GAS __attribute__((address_space(1)))
#define LAS __attribute__((address_space(3)))
typedef unsigned short bf16;
typedef unsigned v4u __attribute__((ext_vector_type(4)));
typedef unsigned v2u __attribute__((ext_vector_type(2)));
typedef float f32x4 __attribute__((ext_vector_type(4)));
typedef float f32x16 __attribute__((ext_vector_type(16)));
typedef short bf16x8 __attribute__((ext_vector_type(8)));
typedef short s16x4 __attribute__((ext_vector_type(4)));
typedef GAS unsigned gu32;
typedef unsigned long long u64;
#define LDS_WAIT() asm volatile("s_waitcnt lgkmcnt(0)" ::: "memory")
#define VM_WAIT() asm volatile("s_waitcnt vmcnt(0)" ::: "memory")
#define SBAR() __builtin_amdgcn_sched_barrier(0)
__device__ __forceinline__ unsigned f2bf(float f) { unsigned u = __builtin_bit_cast(unsigned, f); return (u + 0x7fffu + ((u >> 16) & 1u)) >> 16; }
__device__ __forceinline__ unsigned pk2(float lo, float hi) { return f2bf(lo) | (f2bf(hi) << 16); }
__device__ __forceinline__ float bf2f(unsigned short h) { return __builtin_bit_cast(float, (unsigned)h << 16); }
__device__ __forceinline__ float bflo(unsigned w) { return __builtin_bit_cast(float, w << 16); }
__device__ __forceinline__ float bfhi(unsigned w) { return __builtin_bit_cast(float, w & 0xffff0000u); }
__device__ __forceinline__ unsigned cvtpk(float lo, float hi) { unsigned r; asm volatile("v_cvt_pk_bf16_f32 %0, %1, %2" : "=v"(r) : "v"(lo), "v"(hi)); return r; }
__device__ __forceinline__ float wave_sum(float v) {
#pragma unroll
    for (int o = 1; o < 64; o <<= 1) v += __shfl_xor(v, o);
    return v;
}
__device__ __forceinline__ float sigmoidf_(float x) { return 1.f / (1.f + __expf(-x)); }

#define XB_TMO      128
#define XB_XCNT(j)  (256  + 64 * (j))
#define XB_XSUB(j)  (1280 + 64 * (j))
#define XB_XGEN(j)  (2304 + 64 * (j))
#define XB_TOP      3328
#define XB_TOPGEN   3392
#define XCD_BAR_WORDS 3456
#define XB_SPIN_CAP (1u << 18)

__device__ __forceinline__ unsigned xb_ld(unsigned* p)              { return __hip_atomic_load(p, __ATOMIC_RELAXED, __HIP_MEMORY_SCOPE_AGENT); }
__device__ __forceinline__ unsigned xb_add(unsigned* p, unsigned v) { return __hip_atomic_fetch_add(p, v, __ATOMIC_RELAXED, __HIP_MEMORY_SCOPE_AGENT); }
__device__ __forceinline__ unsigned xb_xcc_id() { return (unsigned)__builtin_amdgcn_s_getreg((3 << 11) | 20) & 0xFu; }
#define XB_SPIN(cond, bar) do { unsigned _sp = 0; while (cond) { __builtin_amdgcn_s_sleep(1); \
    if ((++_sp & 255u) == 0u) { if (xb_ld(&(bar)[XB_TMO])) break; if (_sp > XB_SPIN_CAP) { atomicAdd(&(bar)[XB_TMO], 1u); break; } } } } while (0)

struct XcdBarrier {
    unsigned* bar; unsigned x;
    volatile LAS unsigned* st;
};

__device__ __forceinline__ XcdBarrier xcd_barrier_post(unsigned* bar, volatile LAS unsigned* st) {
    XcdBarrier b; b.bar = bar; b.x = xb_xcc_id(); b.st = st;
    if (threadIdx.x == 0) (void)xb_add(&bar[XB_XCNT(b.x)], 1u);
    return b;
}
__device__ __forceinline__ void xcd_barrier_complete(unsigned* bar, unsigned x, unsigned& nloc, unsigned& nx) {
    const unsigned G = gridDim.x * gridDim.y * gridDim.z;
    unsigned sum, cnt, mine, sp = 0u;
    for (;;) {
        sum = 0u; cnt = 0u; mine = 0u;
#pragma unroll
        for (unsigned j = 0; j < 16; ++j) { const unsigned c = xb_ld(&bar[XB_XCNT(j)]); sum += c; cnt += (c > 0u) ? 1u : 0u; mine = (j == x) ? c : mine; }
        if (sum == G) break;
        __builtin_amdgcn_s_sleep(1);
        if ((++sp & 255u) == 0u) { if (xb_ld(&bar[XB_TMO])) break; if (sp > XB_SPIN_CAP) { atomicAdd(&bar[XB_TMO], 1u); break; } }
    }
    nloc = mine > 0u ? mine : 1u; nx = cnt > 0u ? cnt : 1u;
}

__device__ __forceinline__ void xcd_barrier(const XcdBarrier& b) {
    asm volatile("s_waitcnt vmcnt(0)" ::: "memory");
    __syncthreads();
    if (threadIdx.x == 0) {
        unsigned* bar = b.bar;
        __builtin_amdgcn_s_waitcnt(0);
        unsigned nloc = b.st[0], nx = b.st[1];
        if (nloc == 0u) { xcd_barrier_complete(bar, b.x, nloc, nx); b.st[0] = nloc; b.st[1] = nx; }
        const unsigned old = xb_add(&bar[XB_XSUB(b.x)], 1u);
        const unsigned gen = old / nloc;
        if (old + 1u == (gen + 1u) * nloc) {
            __builtin_amdgcn_fence(__ATOMIC_RELEASE, "agent");
            asm volatile("s_waitcnt vmcnt(0)" ::: "memory");
            const unsigned og = xb_add(&bar[XB_TOP], 1u);
            const unsigned tg = og / nx;
            if (og + 1u == (tg + 1u) * nx) xb_add(&bar[XB_TOPGEN], 1u);
            else XB_SPIN(xb_ld(&bar[XB_TOPGEN]) == tg, bar);
            __builtin_amdgcn_fence(__ATOMIC_ACQUIRE, "agent");
            xb_add(&bar[XB_XGEN(b.x)], 1u);
            asm volatile("s_waitcnt vmcnt(0)" ::: "memory");
        } else {
            XB_SPIN(xb_ld(&bar[XB_XGEN(b.x)]) == gen, bar);
            __builtin_amdgcn_fence(__ATOMIC_ACQUIRE, "agent");
            asm volatile("s_waitcnt vmcnt(0)" ::: "memory");
        }
    }
    __syncthreads();
}

struct Ctx {
    LAS unsigned char* lds;
    unsigned char* ws;
    int tid, lane, wave;
    int bid, G;
    int gw, NGW;
};

__device__ __forceinline__ int win_src_col(int n) {
    if (n < 3584) return n;
    if (n < 6656) return n - 3584 + 3656;
    if (n < 8704) return n - 6656 + 6744;
    if (n < 8768) return n - 8704 + 3584;
    if (n < 8776) return n - 8768 + 3648;
    if (n < 8792) return n - 8776 + 6728;
    return -1;
}
__device__ __forceinline__ void tr_item(const float* Wcol, size_t ldw, int K, bf16* WT0, LAS float* scr, int lane) {
#pragma unroll 8
    for (int i = 0; i < 32; ++i) { const int kk = 2 * i + (lane >> 5); scr[kk * 33 + (lane & 31)] = Wcol ? Wcol[(size_t)kk * ldw] : 0.f; }
    LDS_WAIT(); asm volatile("" ::: "memory");
    const int c = lane & 7;
#pragma unroll
    for (int j = 0; j < 4; ++j) { const int n = (lane >> 3) + 8 * j; const LAS float* s = scr + (8 * c) * 33 + n;
        v4u o; o.x = pk2(s[0 * 33], s[1 * 33]); o.y = pk2(s[2 * 33], s[3 * 33]); o.z = pk2(s[4 * 33], s[5 * 33]); o.w = pk2(s[6 * 33], s[7 * 33]);
        *(GAS v4u*)(WT0 + (size_t)n * K + 8 * c) = o; }
    LDS_WAIT(); asm volatile("" ::: "memory");
}
constexpr int TR_PITCH = 65, TR_SCR_BYTES = 64 * TR_PITCH * 4  , P0_SIL_OFF = 8 * TR_SCR_BYTES  ;
static_assert(P0_SIL_OFF + 16384 <= LDSCTL_OFF, "prologue LDS map");
__device__ __forceinline__ void tr_item64(const float* W0, size_t ldw, int K, bf16* WT0, LAS float* scr, int lane) {
    const int r4 = lane >> 4, c4 = lane & 15;
    f32x4 v[16];
#pragma unroll
    for (int i = 0; i < 16; ++i) v[i] = *(const f32x4*)(W0 + (size_t)(4 * i + r4) * ldw + 4 * c4);
#pragma unroll
    for (int i = 0; i < 16; ++i) { LAS float* p = scr + (4 * i + r4) * TR_PITCH + 4 * c4; p[0] = v[i].x; p[1] = v[i].y; p[2] = v[i].z; p[3] = v[i].w; }
    LDS_WAIT(); asm volatile("" ::: "memory");
    const int c = lane & 7, nl = lane >> 3;
#pragma unroll
    for (int j = 0; j < 8; ++j) { const int n = nl + 8 * j; const LAS float* s = scr + (8 * c) * TR_PITCH + n;
        v4u o; o.x = pk2(s[0 * TR_PITCH], s[1 * TR_PITCH]); o.y = pk2(s[2 * TR_PITCH], s[3 * TR_PITCH]); o.z = pk2(s[4 * TR_PITCH], s[5 * TR_PITCH]); o.w = pk2(s[6 * TR_PITCH], s[7 * TR_PITCH]);
        *(GAS v4u*)(WT0 + (size_t)n * K + 8 * c) = o; }
    LDS_WAIT(); asm volatile("" ::: "memory");
}
__device__ __forceinline__ void p0_prologue(const Ctx& F, const float* c_in, const float* w_ada, const float* b_ada, const float* w_in, const float* w_a, const float* w_b, const float* w_o,
                                            const float* w_gu, const float* w_dn) {
    LAS float* scr = (LAS float*)(F.lds + F.wave * TR_SCR_BYTES);
    LAS float* sil = (LAS float*)(F.lds + P0_SIL_OFF);
    for (int i = F.tid; i < 4096; i += 512) { const float v = c_in[i]; sil[i] = v / (1.f + __expf(-v)); }
    __syncthreads();
    for (int it = F.gw; it < 384; it += F.NGW) {
        const int col = 16 * it + (F.lane & 15), rg = F.lane >> 4;
        float a0 = 0.f, a1 = 0.f, a2 = 0.f, a3 = 0.f;
        const float* wp = w_ada + (size_t)rg * 6144 + col;
#pragma unroll 16
        for (int i = 0; i < 256; ++i) { const int k = 4 * i + rg; const float w = wp[(size_t)i * 4 * 6144];
            a0 = fmaf(sil[k], w, a0); a1 = fmaf(sil[1024 + k], w, a1); a2 = fmaf(sil[2048 + k], w, a2); a3 = fmaf(sil[3072 + k], w, a3); }
        a0 += __shfl_xor(a0, 16); a0 += __shfl_xor(a0, 32); a1 += __shfl_xor(a1, 16); a1 += __shfl_xor(a1, 32);
        a2 += __shfl_xor(a2, 16); a2 += __shfl_xor(a2, 32); a3 += __shfl_xor(a3, 16); a3 += __shfl_xor(a3, 32);
        if (F.lane < 16) { float* mod = (float*)(F.ws + WS_MOD); const float bb = b_ada[col];
            mod[col] = a0 + bb; mod[6144 + col] = a1 + bb; mod[2 * 6144 + col] = a2 + bb; mod[3 * 6144 + col] = a3 + bb; }
    }
    constexpr int J_IN = 16 * 137, J_SQ = 16 * 16, J_GU = NEXP * 16 * 32, J_DN = NEXP * 16 * 16, NJ = J_IN + 3 * J_SQ + J_GU + J_DN;
    for (int it = F.gw; it < NJ; it += F.NGW) {
        int r = it; const float* W0; size_t ldw; int K; bf16* WT0;
        if (r < J_IN) { const int kb = r / 137, n0 = 64 * (r % 137); W0 = w_in + (size_t)(64 * kb) * INW + win_src_col(n0); ldw = INW; K = D; WT0 = (bf16*)(F.ws + WS_WINT) + (size_t)n0 * D + 64 * kb; }
        else if ((r -= J_IN) < 3 * J_SQ) { const int which = r / J_SQ; r -= which * J_SQ; const int kb = r / 16, nb = r % 16;
            W0 = (which == 0 ? w_a : (which == 1 ? w_b : w_o)) + (size_t)(64 * kb) * D + 64 * nb; ldw = D; K = D;
            WT0 = (bf16*)(F.ws + (which == 0 ? WS_WAT : (which == 1 ? WS_WBT : WS_WOT))) + (size_t)(64 * nb) * D + 64 * kb; }
        else if ((r -= 3 * J_SQ) < J_GU) { const int e = r / 512; r -= e * 512; const int kb = r / 32, n0 = 64 * (r % 32), pn = n0 >> 8, i0 = n0 & 255, sc0 = i0 < 128 ? 128 * pn + i0 : 1024 + 128 * pn + (i0 - 128);
            W0 = w_gu + (size_t)e * D * 2048 + (size_t)(64 * kb) * 2048 + sc0; ldw = 2048; K = D; WT0 = (bf16*)(F.ws + WS_WGUT) + (size_t)e * 2048 * D + (size_t)n0 * D + 64 * kb; }
        else { r -= J_GU; const int e = r / 256; r -= e * 256; const int kb = r / 16, nb = r % 16;
            W0 = w_dn + (size_t)e * DFF * D + (size_t)(64 * kb) * D + 64 * nb; ldw = D; K = DFF; WT0 = (bf16*)(F.ws + WS_WDT) + (size_t)e * D * DFF + (size_t)(64 * nb) * DFF + 64 * kb; }
        tr_item64(W0, ldw, K, WT0, scr, F.lane);
    }
    for (int it = F.gw; it < 16 * 6; it += F.NGW) { const int kb = it / 6, nb = 274 + it % 6; const int sc = win_src_col(32 * nb + (F.lane & 31));
        tr_item(sc >= 0 ? w_in + (size_t)(64 * kb) * INW + sc : nullptr, INW, D, (bf16*)(F.ws + WS_WINT) + (size_t)(32 * nb) * D + 64 * kb, scr, F.lane); }
}
__device__ __forceinline__ void p1_xn(const Ctx& F, const float* x, const float* g1) {
    const float* mod = (const float*)(F.ws + WS_MOD);
    bf16* XN = (bf16*)(F.ws + WS_XN);
    for (int r0 = 8 * F.gw; r0 < NTOK; r0 += 8 * F.NGW) {
        const int b = r0 / T; const float* mb = mod + b * 6144;
        f32x4 ga[4], sh[4];
#pragma unroll
        for (int j = 0; j < 4; ++j) { const int c = 4 * F.lane + 256 * j; const f32x4 g = *(const f32x4*)(g1 + c), s = *(const f32x4*)(mb + 1024 + c); ga[j] = g * (s + 1.0f); sh[j] = *(const f32x4*)(mb + c); }
        for (int rr = 0; rr < 8; ++rr) { const int m = r0 + rr;
            const GAS f32x4* xr = (const GAS f32x4*)(x + (size_t)m * D) + F.lane;
            f32x4 v[4]; float s = 0.f;
#pragma unroll
            for (int j = 0; j < 4; ++j) { v[j] = xr[64 * j]; s += (v[j].x * v[j].x + v[j].y * v[j].y) + (v[j].z * v[j].z + v[j].w * v[j].w); }
            const float rstd = 1.f / sqrtf(wave_sum(s) * (1.f / D) + EPS);
            GAS u64* o8 = (GAS u64*)(XN + (size_t)m * D) + F.lane;
#pragma unroll
            for (int j = 0; j < 4; ++j) { const f32x4 h = v[j] * rstd * ga[j] + sh[j]; o8[64 * j] = (u64)pk2(h.x, h.y) | ((u64)pk2(h.z, h.w) << 32); }
        }
    }
}
struct EpiProj {
    static constexpr bool PERM = true, AFTER_DRAIN = false;
    unsigned char* ws;
    __device__ __forceinline__ void operator()(const pg8::f32x4 (&acc)[2][2][4][2], const pg8::Unit& u, int wr, int wc, int fr, int fq) const {
        const int pn = u.pn, row0 = u.pm * 256 + wr * 64 + fr;
        if (pn < 34) {
            size_t off; int ld, ct; float sc = 1.f;
            if (pn < 12) { const int t = pn >> 2; off = WS_QA + (size_t)t * 32 * MiB; ld = 1024; ct = (pn & 3) * 256; if (t == 0) sc = QA_SCALE; }
            else if (pn < 18) { const int t = (pn - 12) >> 1; off = WS_QI + (size_t)t * 16 * MiB; ld = 512; ct = ((pn - 12) & 1) * 256; sc = t == 0 ? 0.125f : (t == 1 ? QB_SCALE : 1.f); }
            else { const int t = (pn - 18) >> 2; off = WS_VB + (size_t)t * 32 * MiB; ld = 1024; ct = ((pn - 18) & 3) * 256; }
            bf16* base = (bf16*)(ws + off); const int col0 = ct + wc * 32 + 8 * fq;
#pragma unroll
            for (int ai = 0; ai < 2; ++ai)
#pragma unroll
                for (int m = 0; m < 4; ++m) { bf16* rowp = base + (size_t)(row0 + ai * 128 + m * 16) * ld + col0;
#pragma unroll
                    for (int bj = 0; bj < 2; ++bj) { const pg8::f32x4 v0 = acc[ai][bj][m][0] * sc, v1 = acc[ai][bj][m][1] * sc;
                        v4u w; w.x = cvtpk(v0[0], v0[1]); w.y = cvtpk(v0[2], v0[3]); w.z = cvtpk(v1[0], v1[1]); w.w = cvtpk(v1[2], v1[3]);
                        *(v4u*)(rowp + bj * 128) = w; } }
        } else {
            if (wc < 2) { bf16* KI = (bf16*)(ws + WS_KI);
#pragma unroll
                for (int ai = 0; ai < 2; ++ai)
#pragma unroll
                    for (int m = 0; m < 4; ++m) { const pg8::f32x4 v0 = acc[ai][0][m][0], v1 = acc[ai][0][m][1];
                        v4u w; w.x = cvtpk(v0[0], v0[1]); w.y = cvtpk(v0[2], v0[3]); w.z = cvtpk(v1[0], v1[1]); w.w = cvtpk(v1[2], v1[3]);
                        *(v4u*)(KI + (size_t)(row0 + ai * 128 + m * 16) * 64 + wc * 32 + 8 * fq) = w; } }
            else if (wc == 2) { float* SM = (float*)(ws + WS_SMALL);
#pragma unroll
                for (int ai = 0; ai < 2; ++ai)
#pragma unroll
                    for (int m = 0; m < 4; ++m) { float* p = SM + (size_t)(row0 + ai * 128 + m * 16) * 32 + 8 * fq;
                        *(f32x4*)p = acc[ai][0][m][0]; *(f32x4*)(p + 4) = acc[ai][0][m][1]; } }
        }
    }
};

constexpr int IDX_ROWB = 8192 + 16, IDX_HIST_OFF = 16 * IDX_ROWB  , IDX_MW_OFF = IDX_HIST_OFF + 8 * 1024  ;
static_assert(IDX_MW_OFF + 16 * 64 * 8 <= LDSCTL_OFF, "indexer LDS map");
__device__ __forceinline__ unsigned quant16(float f) {
    const float a = fminf(fabsf(f), 127.f);
    const unsigned code = (__builtin_bit_cast(unsigned, a + 0.00390625f) - 0x3B800000u) >> 12;
    return (f >= 0.f) ? (0x8000u | code) : (0x7FFFu - code);
}
#define WSYNC() do { asm volatile("s_waitcnt lgkmcnt(0)" ::: "memory"); __builtin_amdgcn_wave_barrier(); } while (0)
__device__ __forceinline__ void radix_scan(LAS unsigned* hist, int lane, unsigned need, unsigned& bin, unsigned& cgt) {
    const v4u hv = *(LAS v4u*)(hist + 4 * lane); const unsigned s = hv.x + hv.y + hv.z + hv.w;
    unsigned suf = s;
#pragma unroll
    for (int o = 1; o < 64; o <<= 1) { const unsigned t = __shfl_down(suf, o); if (lane + o < 64) suf += t; }
    const u64 bal = __ballot(suf >= need); const int L = bal ? 63 - __builtin_clzll(bal) : 0;
    const unsigned above = suf - s, c3 = above + hv.w, c2 = c3 + hv.z, c1 = c2 + hv.y;
    unsigned bsel, cg;
    if (c3 >= need) { bsel = 3; cg = above; } else if (c2 >= need) { bsel = 2; cg = c3; } else if (c1 >= need) { bsel = 1; cg = c2; } else { bsel = 0; cg = c1; }
    bin = __shfl(4 * lane + bsel, L); cgt = __shfl(cg, L);
}
__device__ __forceinline__ void p3_indexer(const Ctx& F) {
    const bf16* QI = (const bf16*)(F.ws + WS_QI); const bf16* KI = (const bf16*)(F.ws + WS_KI); const float* SM = (const float*)(F.ws + WS_SMALL);
    u64* MASKT = (u64*)(F.ws + WS_MASK);
    const int lane = F.lane, l15 = lane & 15, g = lane >> 4;
    for (int it = F.bid; it < 1024; it += F.G) {
        int lz = 0; asm volatile("" : "+v"(lz));
        LAS unsigned char* L = F.lds + lz;
        LAS u64* mw = (LAS u64*)(L + IDX_MW_OFF);
        LAS unsigned* hist = (LAS unsigned*)(L + IDX_HIST_OFF + F.wave * 1024);
        const int r = it >> 8, cc = it & 255, b = r, u = (r & 1) ? 255 - cc : cc;
        const int q0 = 16 * u, nvis = ((q0 >> 6) + 1) * 64; const size_t tb = (size_t)b * T;
        if (nvis <= 256) {
            for (int idx = F.tid; idx < 1024; idx += 512) mw[idx] = ((idx & 63) < (nvis >> 6)) ? ~0ull : 0ull;
        } else {
            bf16x8 bq[8][2]; float wq[8];
            { const bf16* qp = QI + (tb + q0 + l15) * 512 + 8 * g; const float* wp = SM + (tb + q0 + l15) * 32;
#pragma unroll
              for (int h = 0; h < 8; ++h) { bq[h][0] = *(const bf16x8*)(qp + h * 64); bq[h][1] = *(const bf16x8*)(qp + h * 64 + 32); wq[h] = wp[h] * 0.35355339059327373f; } }
            for (int j = F.wave; j < (nvis >> 4); j += 8) {
                const int key0 = 16 * j; const bf16* kp = KI + (tb + key0 + l15) * 64 + 8 * g;
                const bf16x8 a0 = *(const bf16x8*)kp, a1 = *(const bf16x8*)(kp + 32);
                float s0 = 0.f, s1 = 0.f, s2 = 0.f, s3 = 0.f;
#pragma unroll
                for (int h = 0; h < 8; ++h) { f32x4 c = {0.f, 0.f, 0.f, 0.f};
                    c = __builtin_amdgcn_mfma_f32_16x16x32_bf16(a0, bq[h][0], c, 0, 0, 0); c = __builtin_amdgcn_mfma_f32_16x16x32_bf16(a1, bq[h][1], c, 0, 0, 0);
                    s0 = fmaf(wq[h], fmaxf(c[0], 0.f), s0); s1 = fmaf(wq[h], fmaxf(c[1], 0.f), s1); s2 = fmaf(wq[h], fmaxf(c[2], 0.f), s2); s3 = fmaf(wq[h], fmaxf(c[3], 0.f), s3); }
                v2u w; w.x = quant16(s0) | (quant16(s1) << 16); w.y = quant16(s2) | (quant16(s3) << 16);
                *(LAS v2u*)(L + l15 * IDX_ROWB + (key0 + 4 * g) * 2) = w;
            }
            __syncthreads();
            for (int qq = 0; qq < 2; ++qq) {
                const int q = 2 * F.wave + qq; LAS unsigned char* rowp = L + q * IDX_ROWB;
                *(LAS v4u*)(hist + 4 * lane) = (v4u){0u, 0u, 0u, 0u}; WSYNC();
                for (int i = 0; i < (nvis >> 7); ++i) { const unsigned v = *(LAS unsigned*)(rowp + (i * 128 + 2 * lane) * 2);
                    __hip_atomic_fetch_add(hist + ((v >> 8) & 255u), 1u, __ATOMIC_RELAXED, __HIP_MEMORY_SCOPE_WORKGROUP); __hip_atomic_fetch_add(hist + (v >> 24), 1u, __ATOMIC_RELAXED, __HIP_MEMORY_SCOPE_WORKGROUP); }
                WSYNC();
                unsigned b1, cgt1; radix_scan(hist, lane, 256u, b1, cgt1); WSYNC();
                const unsigned r1 = 256u - cgt1;
                *(LAS v4u*)(hist + 4 * lane) = (v4u){0u, 0u, 0u, 0u}; WSYNC();
                for (int i = 0; i < (nvis >> 7); ++i) { const unsigned v = *(LAS unsigned*)(rowp + (i * 128 + 2 * lane) * 2);
                    if (((v >> 8) & 255u) == b1) __hip_atomic_fetch_add(hist + (v & 255u), 1u, __ATOMIC_RELAXED, __HIP_MEMORY_SCOPE_WORKGROUP);
                    if ((v >> 24) == b1) __hip_atomic_fetch_add(hist + ((v >> 16) & 255u), 1u, __ATOMIC_RELAXED, __HIP_MEMORY_SCOPE_WORKGROUP); }
                WSYNC();
                unsigned b2, cgt2; radix_scan(hist, lane, r1, b2, cgt2); WSYNC();
                const unsigned thr = (b1 << 8) | b2, rr = r1 - cgt2;
                unsigned eqrun = 0u; u64 mword = 0ull;
                for (int i = 0; i < (nvis >> 6); ++i) { const unsigned code = *(LAS unsigned short*)(rowp + (i * 64 + lane) * 2);
                    const bool eq = code == thr; const u64 em = __ballot(eq);
                    const unsigned pre = __builtin_amdgcn_mbcnt_hi((unsigned)(em >> 32), __builtin_amdgcn_mbcnt_lo((unsigned)em, 0u));
                    const bool sel = code > thr || (eq && (eqrun + pre) < rr); eqrun += (unsigned)__popcll(em);
                    const u64 m = __ballot(sel); if (lane == i) mword = m; }
                mw[q * 64 + lane] = mword;
            }
        }
        __syncthreads();
        for (int idx = F.tid; idx < 1024; idx += 512) { const int t = idx >> 4, q = idx & 15; MASKT[((size_t)b * 64 + t) * T + q0 + q] = mw[q * 64 + t]; }
        __syncthreads();
    }
}

typedef short v4i16_t __attribute__((ext_vector_type(4)));
__device__ __forceinline__ s16x4 trrd(const LAS unsigned char* p) { return __builtin_bit_cast(s16x4, __builtin_amdgcn_ds_read_tr16_b64_v4i16((LAS v4i16_t*)p)); }
__device__ __forceinline__ bf16x8 cat8(s16x4 lo, s16x4 hi) { return (bf16x8){lo[0], lo[1], lo[2], lo[3], hi[0], hi[1], hi[2], hi[3]}; }
constexpr int G1_LR = 0, G1_TOT = 4096, G1_KD = 8192, G1_KDP = 272, G1_V = G1_KD + 64 * G1_KDP, G1_VP = 528;
__device__ __forceinline__ void p3_gla1(const Ctx& F, const float* w_gate_lr, const float* b_gate) {
    const bf16* QB = (const bf16*)(F.ws + WS_QB); const bf16* KB = (const bf16*)(F.ws + WS_KB); bf16* QE = (bf16*)(F.ws + WS_QE); bf16* KE = (bf16*)(F.ws + WS_KE);
    const bf16* VB = (const bf16*)(F.ws + WS_VB); const float* SM = (const float*)(F.ws + WS_SMALL);
    float* KVC = (float*)(F.ws + WS_KVC); float* DEC = (float*)(F.ws + WS_DEC);
    const int d = F.tid & 127, tq = F.tid >> 7, lane = F.lane, l15 = lane & 15, g = lane >> 4, q4 = l15 >> 2, p4 = lane & 3;
    LAS float* lrs = (LAS float*)(F.lds + G1_LR); LAS float* tot = (LAS float*)(F.lds + G1_TOT);
    for (int it = F.bid; it < 1024; it += F.G) {
        const int bh = it >> 6, c = it & 63, b = bh >> 2, h = bh & 3; const size_t tok0 = (size_t)b * T + 64 * c;
        for (int idx = F.tid; idx < 1024; idx += 512) lrs[idx] = SM[(tok0 + (idx >> 4)) * 32 + 8 + (idx & 15)];
        for (int idx = F.tid; idx < 2048; idx += 512) { const int t = idx >> 5, p = idx & 31; *(LAS v4u*)(F.lds + G1_V + t * G1_VP + 16 * p) = *(const v4u*)(VB + (tok0 + t) * 1024 + h * 256 + 8 * p); }
        float wg[16];
#pragma unroll
        for (int r = 0; r < 16; ++r) wg[r] = w_gate_lr[r * 512 + h * 128 + d];
        const float bg = b_gate[h * 128 + d];
        __syncthreads();
        float Gl[16]; float run = 0.f;
#pragma unroll
        for (int i = 0; i < 16; ++i) { const int t = 16 * tq + i; float z = bg;
#pragma unroll
            for (int r4 = 0; r4 < 4; ++r4) { const f32x4 l = *(LAS f32x4*)(lrs + t * 16 + 4 * r4); z = fmaf(l.x, wg[4 * r4], z); z = fmaf(l.y, wg[4 * r4 + 1], z); z = fmaf(l.z, wg[4 * r4 + 2], z); z = fmaf(l.w, wg[4 * r4 + 3], z); }
            const float la = (fminf(z, 0.f) - log1pf(__expf(-fabsf(z)))) * 0.0625f; run += la; Gl[i] = run; }
        tot[tq * 128 + d] = run;
        __syncthreads();
        float offs = 0.f, glast = 0.f;
#pragma unroll
        for (int qd = 0; qd < 4; ++qd) { const float v = tot[qd * 128 + d]; if (qd < tq) offs += v; glast += v; }
#pragma unroll
        for (int i = 0; i < 16; ++i) { const int t = 16 * tq + i; const float G = Gl[i] + offs; const size_t o = (tok0 + t) * 512 + h * 128 + d;
            const float q = bf2f(QB[o]), k = bf2f(KB[o]);
            QE[o] = (bf16)f2bf(q * __expf(G)); KE[o] = (bf16)f2bf(k * __expf(-G));
            *(LAS unsigned short*)(F.lds + G1_KD + t * G1_KDP + d * 2) = (unsigned short)f2bf(k * __expf(glast - G)); }
        if (tq == 0) DEC[(size_t)(bh * 64 + c) * 128 + d] = __expf(glast);
        __syncthreads();
        const int m0 = 16 * F.wave; bf16x8 a[2];
#pragma unroll
        for (int s = 0; s < 2; ++s) { const LAS unsigned char* ap = F.lds + G1_KD + (32 * s + 8 * g + q4) * G1_KDP + (m0 + 4 * p4) * 2; a[s] = cat8(trrd(ap), trrd(ap + 4 * G1_KDP)); }
        float* out = KVC + (size_t)(bh * 64 + c) * 256 * 128;
#pragma unroll 4
        for (int nt = 0; nt < 16; ++nt) { f32x4 acc = {0.f, 0.f, 0.f, 0.f};
#pragma unroll
            for (int s = 0; s < 2; ++s) { const LAS unsigned char* bp = F.lds + G1_V + (32 * s + 8 * g + q4) * G1_VP + (16 * nt + 4 * p4) * 2; const bf16x8 bv = cat8(trrd(bp), trrd(bp + 4 * G1_VP));
                acc = __builtin_amdgcn_mfma_f32_16x16x32_bf16(a[s], bv, acc, 0, 0, 0); }
            *(f32x4*)(out + (size_t)(16 * nt + l15) * 128 + m0 + 4 * g) = acc; }
        __syncthreads();
    }
}
__device__ __forceinline__ void p4_scan(const Ctx& F) {
    const float* KVC = (const float*)(F.ws + WS_KVC); const float* DEC = (const float*)(F.ws + WS_DEC); bf16* SC = (bf16*)(F.ws + WS_SC);
    for (int e = F.bid * 512 + F.tid; e < 16 * 256 * 32; e += F.G * 512) {
        const int d4 = e & 31, v = (e >> 5) & 255, bh = e >> 13; f32x4 S = {0.f, 0.f, 0.f, 0.f};
#pragma unroll 8
        for (int c = 0; c < 64; ++c) { const size_t o = ((size_t)(bh * 64 + c) * 256 + v) * 128 + 4 * d4;
            const f32x4 kv = *(const f32x4*)(KVC + o), dc = *(const f32x4*)(DEC + (size_t)(bh * 64 + c) * 128 + 4 * d4);
            v2u w; w.x = pk2(S.x, S.y); w.y = pk2(S.z, S.w); *(v2u*)(SC + o) = w;
            S = S * dc + kv; }
    }
}
constexpr int G3_QE = 0, G3_KE = 17408, G3_V = 34816, G3_AM = 68608, G3_AMP = 144, G3_SS = 77824;
__device__ __forceinline__ void p5_gla3(const Ctx& F, const float* gnorm_g) {
    const bf16* QB = (const bf16*)(F.ws + WS_QE); const bf16* KB = (const bf16*)(F.ws + WS_KE); const bf16* VB = (const bf16*)(F.ws + WS_VB); const bf16* GB = (const bf16*)(F.ws + WS_GB);
    const bf16* SC = (const bf16*)(F.ws + WS_SC); bf16* YB = (bf16*)(F.ws + WS_YB);
    const int lane = F.lane, l15 = lane & 15, g = lane >> 4, q4 = l15 >> 2, p4 = lane & 3, w = F.wave;
    LAS float* SS = (LAS float*)(F.lds + G3_SS);
    for (int it = F.bid; it < 1024; it += F.G) {
        const int bh = it >> 6, c = it & 63, b = bh >> 2, h = bh & 3; const size_t tok0 = (size_t)b * T + 64 * c;
        for (int idx = F.tid; idx < 1024; idx += 512) { const int t = idx >> 4, p = idx & 15; const size_t o = (tok0 + t) * 512 + h * 128 + 8 * p;
            *(LAS v4u*)(F.lds + G3_QE + t * 272 + 16 * p) = *(const v4u*)(QB + o); *(LAS v4u*)(F.lds + G3_KE + t * 272 + 16 * p) = *(const v4u*)(KB + o); }
        for (int idx = F.tid; idx < 2048; idx += 512) { const int t = idx >> 5, p = idx & 31; *(LAS v4u*)(F.lds + G3_V + t * G1_VP + 16 * p) = *(const v4u*)(VB + (tok0 + t) * 1024 + h * 256 + 8 * p); }
        bf16x8 bS[2][4];
#pragma unroll
        for (int n = 0; n < 2; ++n)
#pragma unroll
            for (int s = 0; s < 4; ++s) bS[n][s] = *(const bf16x8*)(SC + ((size_t)(bh * 64 + c) * 256 + 32 * w + 16 * n + l15) * 128 + 32 * s + 8 * g);
        __syncthreads();
        { const int mi = w >> 1, mj0 = 2 * (w & 1);
#pragma unroll
          for (int jj = 0; jj < 2; ++jj) { const int mj = mj0 + jj; f32x4 c4 = {0.f, 0.f, 0.f, 0.f};
              if (mj <= mi) {
#pragma unroll
                  for (int s = 0; s < 4; ++s) { const bf16x8 av = *(LAS bf16x8*)(F.lds + G3_QE + (16 * mi + l15) * 272 + (32 * s + 8 * g) * 2), bv = *(LAS bf16x8*)(F.lds + G3_KE + (16 * mj + l15) * 272 + (32 * s + 8 * g) * 2);
                      c4 = __builtin_amdgcn_mfma_f32_16x16x32_bf16(av, bv, c4, 0, 0, 0); } }
#pragma unroll
              for (int r = 0; r < 4; ++r) { const int i = 16 * mi + 4 * g + r, j = 16 * mj + l15; *(LAS unsigned short*)(F.lds + G3_AM + i * G3_AMP + j * 2) = (unsigned short)f2bf(j <= i ? c4[r] : 0.f); } } }
        __syncthreads();
        f32x4 acc[4][2];
#pragma unroll
        for (int m = 0; m < 4; ++m) { acc[m][0] = (f32x4){0.f, 0.f, 0.f, 0.f}; acc[m][1] = (f32x4){0.f, 0.f, 0.f, 0.f}; }
#pragma unroll
        for (int s = 0; s < 4; ++s)
#pragma unroll
            for (int m = 0; m < 4; ++m) { const bf16x8 av = *(LAS bf16x8*)(F.lds + G3_QE + (16 * m + l15) * 272 + (32 * s + 8 * g) * 2);
                acc[m][0] = __builtin_amdgcn_mfma_f32_16x16x32_bf16(av, bS[0][s], acc[m][0], 0, 0, 0); acc[m][1] = __builtin_amdgcn_mfma_f32_16x16x32_bf16(av, bS[1][s], acc[m][1], 0, 0, 0); }
#pragma unroll
        for (int s = 0; s < 2; ++s)
#pragma unroll
            for (int n = 0; n < 2; ++n) { const LAS unsigned char* bp = F.lds + G3_V + (32 * s + 8 * g + q4) * G1_VP + (32 * w + 16 * n + 4 * p4) * 2; const bf16x8 bv = cat8(trrd(bp), trrd(bp + 4 * G1_VP));
#pragma unroll
                for (int m = 0; m < 4; ++m) { const bf16x8 av = *(LAS bf16x8*)(F.lds + G3_AM + (16 * m + l15) * G3_AMP + (32 * s + 8 * g) * 2); acc[m][n] = __builtin_amdgcn_mfma_f32_16x16x32_bf16(av, bv, acc[m][n], 0, 0, 0); } }
#pragma unroll
        for (int m = 0; m < 4; ++m)
#pragma unroll
            for (int r = 0; r < 4; ++r) { float ss = acc[m][0][r] * acc[m][0][r] + acc[m][1][r] * acc[m][1][r];
                ss += __shfl_xor(ss, 1); ss += __shfl_xor(ss, 2); ss += __shfl_xor(ss, 4); ss += __shfl_xor(ss, 8);
                if (l15 == 0) SS[(16 * m + 4 * g + r) * 8 + w] = ss; }
        __syncthreads();
#pragma unroll
        for (int m = 0; m < 4; ++m)
#pragma unroll
            for (int r = 0; r < 4; ++r) { const int row = 16 * m + 4 * g + r; const f32x4 s0 = *(LAS f32x4*)(SS + row * 8), s1 = *(LAS f32x4*)(SS + row * 8 + 4);
                const float rstd = 1.f / sqrtf(((s0.x + s0.y) + (s0.z + s0.w) + (s1.x + s1.y) + (s1.z + s1.w)) * (1.f / 256.f) + EPS);
#pragma unroll
                for (int n = 0; n < 2; ++n) { const int v = 32 * w + 16 * n + l15; const size_t o = (tok0 + row) * 1024 + h * 256 + v;
                    const float gt = bf2f(GB[o]); YB[o] = (bf16)f2bf(acc[m][n][r] * rstd * gnorm_g[v] * (gt * sigmoidf_(gt))); } }
        __syncthreads();
    }
}

namespace att {
constexpr int SHM_K = 16384, SHM_V = 16384, PITCH = 1024;
constexpr float THR = 8.f;
#define KSWZ(row, colB) ((row) * 256 + ((colB) ^ (((row) & 7) << 4)))
__device__ __forceinline__ int v_st(int k, int c) { const int kk = (k & ~0xC) | ((k & 4) << 1) | ((k & 8) >> 1); return ((kk >> 3) * 4 + (c >> 5)) * 512 + ((kk & 7) * 32 + (c & 31)) * 2; }
__device__ __forceinline__ int v_rd_base(int lane) { return ((lane & 3) << 3) | (((lane >> 2) & 3) << 6) | (((lane >> 4) & 1) << 5) | (((lane >> 5) & 1) << 8); }
constexpr int v_rd_off(int d0, int ks, int half) { return d0 * 512 + ks * 4096 + half * 2048; }
__device__ __forceinline__ int crow(int r, int hi) { return (r & 3) + 8 * (r >> 2) + 4 * hi; }
__device__ __forceinline__ void mask_bits(f32x16& p0, f32x16& p1, unsigned lo, unsigned hi32) {
    const float NEG = -__builtin_inff();
#pragma unroll
    for (int r = 0; r < 16; ++r) { const int c = (r & 3) + 8 * (r >> 2);
        if (!((lo >> c) & 1u)) p0[r] = NEG;
        if (!((hi32 >> c) & 1u)) p1[r] = NEG; }
}
__device__ __forceinline__ void partialSM(f32x16& p0, f32x16& p1, float& m_reg, float& mn, float& alpha) {
    float pmax = p0[0];
#pragma unroll
    for (int r = 1; r < 16; ++r) pmax = fmaxf(pmax, p0[r]);
#pragma unroll
    for (int r = 0; r < 16; ++r) pmax = fmaxf(pmax, p1[r]);
    { auto rr = __builtin_amdgcn_permlane32_swap(__float_as_uint(pmax), __float_as_uint(pmax), false, false);
      pmax = fmaxf(__uint_as_float(rr[0]), __uint_as_float(rr[1])); }
    if (__builtin_expect(__all((pmax - m_reg) <= THR), 1)) { mn = m_reg; alpha = 1.f; }
    else { mn = fmaxf(m_reg, pmax); alpha = __builtin_amdgcn_exp2f(m_reg - mn); m_reg = mn; }
#pragma unroll
    for (int r = 0; r < 16; ++r) p0[r] = __builtin_amdgcn_exp2f(p0[r] - mn);
#pragma unroll
    for (int r = 0; r < 16; ++r) p1[r] = __builtin_amdgcn_exp2f(p1[r] - mn);
}
__device__ __forceinline__ void finishSM(f32x16& p0, f32x16& p1, float alpha, float& l_reg, bf16x8& pa0, bf16x8& pa1, bf16x8& pa2, bf16x8& pa3) {
    float ps = 0.f;
#pragma unroll
    for (int r = 0; r < 16; ++r) ps += p0[r];
#pragma unroll
    for (int r = 0; r < 16; ++r) ps += p1[r];
    { auto rr = __builtin_amdgcn_permlane32_swap(__float_as_uint(ps), __float_as_uint(ps), false, false);
      ps = __uint_as_float(rr[0]) + __uint_as_float(rr[1]); }
    l_reg = l_reg * alpha + ps;
#define PK4(P, B_, OUT) do { unsigned a0 = cvtpk(P[B_+0], P[B_+1]), a1 = cvtpk(P[B_+2], P[B_+3]);                          \
        unsigned b0 = cvtpk(P[B_+4], P[B_+5]), b1 = cvtpk(P[B_+6], P[B_+7]);                                             \
        auto r0 = __builtin_amdgcn_permlane32_swap(a0, b0, false, false); auto r1 = __builtin_amdgcn_permlane32_swap(a1, b1, false, false); \
        v4u w_ = {r0[0], r1[0], r0[1], r1[1]}; OUT = __builtin_bit_cast(bf16x8, w_); } while (0)
    PK4(p0, 0, pa0); PK4(p0, 8, pa1); PK4(p1, 0, pa2); PK4(p1, 8, pa3);
#undef PK4
}
template <int KB>
__device__ __forceinline__ void qkt(f32x16& p0, f32x16& p1, const LAS unsigned char* K_lds, int r32, int hi, const bf16x8* qr) {
    p0 = f32x16{}; p1 = f32x16{};
    const LAS unsigned char* kb[4];
#pragma unroll
    for (int dd = 0; dd < 4; ++dd) kb[dd] = K_lds + KB * SHM_K + KSWZ(r32, (dd * 16 + hi * 8) * 2);
#pragma unroll
    for (int d0 = 0; d0 < 8; ++d0) { const LAS unsigned char* a = kb[d0 & 3] + (d0 >> 2) * 128;
        const bf16x8 b0 = *(const LAS bf16x8*)a, b1 = *(const LAS bf16x8*)(a + 32 * 256);
        p0 = __builtin_amdgcn_mfma_f32_32x32x16_bf16(b0, qr[d0], p0, 0, 0, 0);
        p1 = __builtin_amdgcn_mfma_f32_32x32x16_bf16(b1, qr[d0], p1, 0, 0, 0); }
}
template <int VB>
__device__ __forceinline__ void pv_tile(f32x16* o, int vb0, bf16x8 pa0, bf16x8 pa1, bf16x8 pa2, bf16x8 pa3) {
#define TRRD(dst, off) asm volatile("ds_read_b64_tr_b16 %0, %1 offset:%2" : "=&v"(dst) : "v"(vb0), "i"(off) : "memory")
#define PV_D0(d0) do { s16x4 l0, l1, l2, l3, h0, h1, h2, h3; constexpr int b_ = VB * SHM_V + v_rd_off(d0, 0, 0); \
        TRRD(l0, b_); TRRD(h0, b_ + 2048); TRRD(l1, b_ + 4096); TRRD(h1, b_ + 6144); TRRD(l2, b_ + 8192); TRRD(h2, b_ + 10240); TRRD(l3, b_ + 12288); TRRD(h3, b_ + 14336); \
        asm volatile("s_waitcnt lgkmcnt(0)" ::: "memory"); SBAR(); \
        o[d0] = __builtin_amdgcn_mfma_f32_32x32x16_bf16(pa0, (bf16x8){l0[0], l0[1], l0[2], l0[3], h0[0], h0[1], h0[2], h0[3]}, o[d0], 0, 0, 0);   \
        o[d0] = __builtin_amdgcn_mfma_f32_32x32x16_bf16(pa1, (bf16x8){l1[0], l1[1], l1[2], l1[3], h1[0], h1[1], h1[2], h1[3]}, o[d0], 0, 0, 0);   \
        o[d0] = __builtin_amdgcn_mfma_f32_32x32x16_bf16(pa2, (bf16x8){l2[0], l2[1], l2[2], l2[3], h2[0], h2[1], h2[2], h2[3]}, o[d0], 0, 0, 0);   \
        o[d0] = __builtin_amdgcn_mfma_f32_32x32x16_bf16(pa3, (bf16x8){l3[0], l3[1], l3[2], l3[3], h3[0], h3[1], h3[2], h3[3]}, o[d0], 0, 0, 0); } while (0)
    PV_D0(0); PV_D0(1); PV_D0(2); PV_D0(3);
#undef PV_D0
#undef TRRD
}
__device__ __forceinline__ void unit(const Ctx& F, int b, int h, int qb) {
    const bf16* Q = (const bf16*)(F.ws + WS_QA); const bf16* K = (const bf16*)(F.ws + WS_KA); const bf16* V = (const bf16*)(F.ws + WS_VA); bf16* O = (bf16*)(F.ws + WS_YA);
    const u64* MASKT = (const u64*)(F.ws + WS_MASK);
    const int tid = F.tid, wid = F.wave, lane = F.lane, r32 = lane & 31, hi = lane >> 5;
    LAS unsigned char* V_lds = F.lds; LAS unsigned char* K_lds = F.lds + 2 * SHM_V;
    LAS float* wsf = (LAS float*)(F.lds + 2 * SHM_V + 2 * SHM_K) + wid * 64; LAS float* li_l = wsf; LAS float* al_l = wsf + 32;
    const size_t tb = (size_t)b * T; const int NT = 4 * (qb + 1);
    const int sr = tid >> 4, sc = (tid & 15) * 8, vst0 = v_st(sr, sc), vst1 = v_st(32 + sr, sc), kws = KSWZ(sr, sc * 2);
    const int vb0 = (int)(uintptr_t)V_lds + v_rd_base(lane);
    const unsigned kvo = (unsigned)((tb + sr) * PITCH + h * 128 + sc);
    const int qrow = qb * 256 + wid * 32 + r32;
    bf16x8 qr[8];
    { const unsigned qo = (unsigned)((tb + qrow) * PITCH + h * 128 + hi * 8);
#pragma unroll
      for (int d0 = 0; d0 < 8; ++d0) qr[d0] = *(const bf16x8*)(Q + qo + d0 * 16); }
    const unsigned mo = (unsigned)(b * 64 * T + qrow);
    float m_reg = -1e30f, l_reg = 0.f; f32x16 o[4] = {};
    bf16x8 st_k0, st_k1, st_v0, st_v1;
#define SLOAD(t) do { const unsigned r0_ = kvo + (unsigned)((t) * 64 * PITCH); st_k0 = *(const bf16x8*)(K + r0_); st_k1 = *(const bf16x8*)(K + r0_ + 32 * PITCH); st_v0 = *(const bf16x8*)(V + r0_); st_v1 = *(const bf16x8*)(V + r0_ + 32 * PITCH); } while (0)
#define SWRITE(bf) do { *(LAS bf16x8*)(K_lds + (bf) * SHM_K + kws) = st_k0; *(LAS bf16x8*)(K_lds + (bf) * SHM_K + kws + 32 * 256) = st_k1; \
                        *(LAS bf16x8*)(V_lds + (bf) * SHM_V + vst0) = st_v0; *(LAS bf16x8*)(V_lds + (bf) * SHM_V + vst1) = st_v1; } while (0)
#define STEP(t, BUF) do { \
        if ((t) + 1 < NT) SLOAD((t) + 1); \
        const u64 mwd = MASKT[mo + (unsigned)((t) * T)]; \
        f32x16 p0, p1; float mn, alpha; bf16x8 pa0, pa1, pa2, pa3; \
        SBAR(); qkt<BUF>(p0, p1, K_lds, r32, hi, qr); \
        mask_bits(p0, p1, (unsigned)mwd >> (4 * hi), (unsigned)(mwd >> 32) >> (4 * hi)); \
        partialSM(p0, p1, m_reg, mn, alpha); finishSM(p0, p1, alpha, l_reg, pa0, pa1, pa2, pa3); \
        if (__any(alpha < 1.f)) { if (hi == 0) al_l[r32] = alpha; LDS_WAIT(); \
            _Pragma("unroll") for (int d_ = 0; d_ < 4; ++d_) _Pragma("unroll") for (int r = 0; r < 16; ++r) o[d_][r] *= al_l[crow(r, hi)]; } \
        SBAR(); pv_tile<BUF>(o, vb0, pa0, pa1, pa2, pa3); \
        if ((t) + 1 < NT) { VM_WAIT(); SWRITE(1 - (BUF)); } \
        __syncthreads(); } while (0)
    SLOAD(0); VM_WAIT(); SWRITE(0); __syncthreads();
    for (int t = 0; t < NT; t += 2) { STEP(t, 0); STEP(t + 1, 1); }
#undef STEP
#undef SLOAD
#undef SWRITE
    if (hi == 0) li_l[r32] = l_reg; LDS_WAIT();
    const unsigned oo = (unsigned)((tb + qb * 256 + wid * 32) * PITCH + h * 128 + r32);
#pragma unroll
    for (int r = 0; r < 16; ++r) { const int orow = crow(r, hi); const float rl = __builtin_amdgcn_rcpf(li_l[orow]);
#pragma unroll
        for (int d0 = 0; d0 < 4; ++d0) { const float v = o[d0][r] * rl; const float vn = __shfl_xor(v, 1);
            if ((r32 & 1) == 0) *(unsigned*)(O + oo + (unsigned)(orow * PITCH + d0 * 32)) = cvtpk(v, vn); } }
    __syncthreads();
}
}
__device__ __forceinline__ void p4_attention(const Ctx& F) {
    for (int it = F.bid; it < 256; it += F.G) { const int bh = it >> 3, p = it & 7;
        att::unit(F, bh >> 3, bh & 7, 15 - p); att::unit(F, bh >> 3, bh & 7, p); }
}

struct EpiBrA {
    static constexpr bool PERM = false, AFTER_DRAIN = false;
    const bf16* G; float* TMP;
    __device__ __forceinline__ void operator()(const pg8::f32x4 (&acc)[2][2][4][2], const pg8::Unit& u, int wr, int wc, int fr, int fq) const {
        const int row0 = u.pm * 256 + wr * 64 + fr, col0 = u.pn * 256 + wc * 32 + 4 * fq;
#pragma unroll
        for (int ai = 0; ai < 2; ++ai)
#pragma unroll
            for (int m = 0; m < 4; ++m) { const size_t ro = (size_t)(row0 + ai * 128 + m * 16) * 1024 + col0;
#pragma unroll
                for (int bj = 0; bj < 2; ++bj)
#pragma unroll
                    for (int n = 0; n < 2; ++n) { const size_t o = ro + bj * 128 + n * 16; const v2u gw = *(const v2u*)(G + o); const pg8::f32x4 a = acc[ai][bj][m][n];
                        pg8::f32x4 r; r[0] = a[0] * sigmoidf_(bflo(gw.x)); r[1] = a[1] * sigmoidf_(bfhi(gw.x)); r[2] = a[2] * sigmoidf_(bflo(gw.y)); r[3] = a[3] * sigmoidf_(bfhi(gw.y));
                        *(pg8::f32x4*)(TMP + o) = r; } }
    }
};
struct EpiBrB {
    static constexpr bool PERM = false, AFTER_DRAIN = false;
    const bf16* G; const float* TMP; bf16* OUT;
    __device__ __forceinline__ void operator()(const pg8::f32x4 (&acc)[2][2][4][2], const pg8::Unit& u, int wr, int wc, int fr, int fq) const {
        const int row0 = u.pm * 256 + wr * 64 + fr, col0 = u.pn * 256 + wc * 32 + 4 * fq;
#pragma unroll
        for (int ai = 0; ai < 2; ++ai)
#pragma unroll
            for (int m = 0; m < 4; ++m) { const size_t ro = (size_t)(row0 + ai * 128 + m * 16) * 1024 + col0;
#pragma unroll
                for (int bj = 0; bj < 2; ++bj)
#pragma unroll
                    for (int n = 0; n < 2; ++n) { const size_t o = ro + bj * 128 + n * 16; const v2u gw = *(const v2u*)(G + o); const pg8::f32x4 a = acc[ai][bj][m][n], t = *(const pg8::f32x4*)(TMP + o);
                        v2u w; w.x = cvtpk(t[0] + a[0] * sigmoidf_(bflo(gw.x)), t[1] + a[1] * sigmoidf_(bfhi(gw.x))); w.y = cvtpk(t[2] + a[2] * sigmoidf_(bflo(gw.y)), t[3] + a[3] * sigmoidf_(bfhi(gw.y)));
                        *(v2u*)(OUT + o) = w; } }
    }
};
struct EpiOut {
    static constexpr bool PERM = false, AFTER_DRAIN = false;
    const float* X; const float* MOD; float* X1;
    __device__ __forceinline__ void operator()(const pg8::f32x4 (&acc)[2][2][4][2], const pg8::Unit& u, int wr, int wc, int fr, int fq) const {
        const int row0 = u.pm * 256 + wr * 64 + fr, col0 = u.pn * 256 + wc * 32 + 4 * fq; const float* gt = MOD + (u.pm * 256 / T) * 6144 + 2048;
        pg8::f32x4 gv[2][2];
#pragma unroll
        for (int bj = 0; bj < 2; ++bj)
#pragma unroll
            for (int n = 0; n < 2; ++n) gv[bj][n] = *(const pg8::f32x4*)(gt + col0 + bj * 128 + n * 16);
#pragma unroll
        for (int ai = 0; ai < 2; ++ai)
#pragma unroll
            for (int m = 0; m < 4; ++m) { const size_t ro = (size_t)(row0 + ai * 128 + m * 16) * 1024 + col0;
#pragma unroll
                for (int bj = 0; bj < 2; ++bj)
#pragma unroll
                    for (int n = 0; n < 2; ++n) { const size_t o = ro + bj * 128 + n * 16; *(pg8::f32x4*)(X1 + o) = *(const pg8::f32x4*)(X + o) + gv[bj][n] * acc[ai][bj][m][n]; } }
    }
};
constexpr int RW_PITCH = 36, R_CNT = 1024 * RW_PITCH * 4  , R_BASE = R_CNT + 128, R_LE = R_CNT + 256, R_LR = R_LE + 1024;
static_assert(R_LR + 1024 <= LDSCTL_OFF, "router LDS map");
__device__ __forceinline__ float wave_max(float v) {
#pragma unroll
    for (int o = 1; o < 64; o <<= 1) v = fmaxf(v, __shfl_xor(v, o));
    return v;
}
__device__ __forceinline__ void p8_router(const Ctx& F, const float* g2, const float* router_w, const float* router_b, int cnt_off = 0) {
    const float* X1 = (const float*)(F.ws + WS_X1); const float* mod = (const float*)(F.ws + WS_MOD); bf16* H2 = (bf16*)(F.ws + WS_H2);
    int* TOKE = (int*)(F.ws + WS_TOKE); int* TOKR = (int*)(F.ws + WS_TOKR); float* TOKW = (float*)(F.ws + WS_TOKW); unsigned* gcnt = (unsigned*)(F.ws + WS_CTL) + CW_ECNT + cnt_off;
    LAS float* rw = (LAS float*)F.lds; LAS unsigned* lcnt = (LAS unsigned*)(F.lds + R_CNT); LAS unsigned* lbase = (LAS unsigned*)(F.lds + R_BASE);
    LAS int* le = (LAS int*)(F.lds + R_LE); LAS int* lrk = (LAS int*)(F.lds + R_LR);
    const int lane = F.lane;
    for (int i = F.tid; i < 8192; i += 512) { const int k = i >> 3, c4 = i & 7; *(LAS f32x4*)(rw + k * RW_PITCH + 4 * c4) = *(const f32x4*)(router_w + k * 32 + 4 * c4); }
    if (F.tid < 32) lcnt[F.tid] = 0u;
    __syncthreads();
    const float rb = router_b[(lane >> 1) & 31];
    for (int it = F.bid; it < NTOK / 64; it += F.G) {
        const int b = (it * 64) / T; const float* mb = mod + b * 6144;
        float ga[16], sh[16];
#pragma unroll
        for (int jj = 0; jj < 16; ++jj) { const int k = lane + 64 * jj; ga[jj] = g2[k] * (1.f + mb[4096 + k]); sh[jj] = mb[3072 + k]; }
        for (int tt = 0; tt < 8; ++tt) { const int lt = F.wave * 8 + tt, m = it * 64 + lt;
            const float* xr = X1 + (size_t)m * D; float hv[16]; float ss = 0.f;
#pragma unroll
            for (int jj = 0; jj < 16; ++jj) { hv[jj] = xr[lane + 64 * jj]; ss = fmaf(hv[jj], hv[jj], ss); }
            const float rstd = 1.f / sqrtf(wave_sum(ss) * (1.f / D) + EPS);
            float pe[32];
#pragma unroll
            for (int e = 0; e < 32; ++e) pe[e] = 0.f;
#pragma unroll
            for (int jj = 0; jj < 16; ++jj) { const int k = lane + 64 * jj; const float h = hv[jj] * rstd * ga[jj] + sh[jj]; H2[(size_t)m * D + k] = (bf16)f2bf(h);
#pragma unroll
                for (int c4 = 0; c4 < 8; ++c4) { const f32x4 w = *(LAS f32x4*)(rw + k * RW_PITCH + 4 * c4);
                    pe[4 * c4] = fmaf(h, w.x, pe[4 * c4]); pe[4 * c4 + 1] = fmaf(h, w.y, pe[4 * c4 + 1]); pe[4 * c4 + 2] = fmaf(h, w.z, pe[4 * c4 + 2]); pe[4 * c4 + 3] = fmaf(h, w.w, pe[4 * c4 + 3]); } }
#define RSTEP(NH, BIT) _Pragma("unroll") for (int e = 0; e < NH; ++e) { const bool up = (lane & BIT) != 0; const float send = up ? pe[e] : pe[e + NH]; const float keep = up ? pe[e + NH] : pe[e]; pe[e] = keep + __shfl_xor(send, BIT); }
            RSTEP(16, 32) RSTEP(8, 16) RSTEP(4, 8) RSTEP(2, 4) RSTEP(1, 2)
#undef RSTEP
            float lg = pe[0] + __shfl_xor(pe[0], 1) + rb;
            int e0, e1, e2, e3; float v0, v1, v2, v3;
#define TOP1(EK, VK) { const float mx = wave_max(lg); const u64 bm = __ballot(lg == mx); const int L = __ffsll((long long)bm) - 1; EK = (L >> 1) & 31; VK = mx; if (((lane >> 1) & 31) == EK) lg = -__builtin_inff(); }
            TOP1(e0, v0) TOP1(e1, v1) TOP1(e2, v2) TOP1(e3, v3)
#undef TOP1
            const float x1_ = __expf(v1 - v0), x2_ = __expf(v2 - v0), x3_ = __expf(v3 - v0), inv = 1.f / (1.f + x1_ + x2_ + x3_);
            if (lane < 4) { const int ek = lane == 0 ? e0 : (lane == 1 ? e1 : (lane == 2 ? e2 : e3)); const float wk = (lane == 0 ? 1.f : (lane == 1 ? x1_ : (lane == 2 ? x2_ : x3_))) * inv;
                const unsigned rk = __hip_atomic_fetch_add(lcnt + ek, 1u, __ATOMIC_RELAXED, __HIP_MEMORY_SCOPE_WORKGROUP);
                TOKE[m * 4 + lane] = ek; TOKW[m * 4 + lane] = wk; le[lt * 4 + lane] = ek; lrk[lt * 4 + lane] = (int)rk; }
        }
        __syncthreads();
        if (F.tid < 32) { lbase[F.tid] = __hip_atomic_fetch_add(gcnt + 64 * F.tid, lcnt[F.tid], __ATOMIC_RELAXED, __HIP_MEMORY_SCOPE_AGENT); lcnt[F.tid] = 0u; }
        __syncthreads();
        if (F.tid < 256) TOKR[it * 256 + F.tid] = lrk[F.tid] + (int)lbase[le[F.tid]];
        __syncthreads();
    }
}
__device__ __forceinline__ void p9_scatter(const Ctx& F) {
    const unsigned* gcnt = (const unsigned*)(F.ws + WS_CTL) + CW_ECNT; int* TILEE = (int*)(F.ws + WS_TILEE);
    const int* TOKE = (const int*)(F.ws + WS_TOKE); const int* TOKR = (const int*)(F.ws + WS_TOKR); int* TOKP = (int*)(F.ws + WS_TOKP);
    const bf16* H2 = (const bf16*)(F.ws + WS_H2); bf16* XS = (bf16*)(F.ws + WS_XS);
    LAS int* poff = (LAS int*)F.lds;
    if (F.tid == 0) { int acc = 0, nt = 0;
        for (int e = 0; e < NEXP; ++e) { const int cnt = (int)__hip_atomic_load(gcnt + 64 * e, __ATOMIC_RELAXED, __HIP_MEMORY_SCOPE_AGENT); poff[e] = acc; const int tiles = (cnt + 255) >> 8;
            if (F.bid == 0) for (int i = 0; i < tiles; ++i) TILEE[nt + i] = e;
            nt += tiles; acc += tiles * 256; }
        if (F.bid == 0) TILEE[NT_MAX] = nt; }
    __syncthreads();
    for (int m = F.gw; m < NTOK; m += F.NGW) {
        const v4u a0 = *(const v4u*)(H2 + (size_t)m * D + 16 * F.lane), a1 = *(const v4u*)(H2 + (size_t)m * D + 16 * F.lane + 8);
#pragma unroll
        for (int k = 0; k < 4; ++k) { const int pos = poff[TOKE[m * 4 + k]] + TOKR[m * 4 + k]; if (F.lane == 0) TOKP[m * 4 + k] = pos;
            *(v4u*)(XS + (size_t)pos * D + 16 * F.lane) = a0; *(v4u*)(XS + (size_t)pos * D + 16 * F.lane + 8) = a1; }
    }
}
struct MoeOrder {
    const int* tile_e; int ntiles, nN, G, c, wsz;
    __device__ __forceinline__ bool next(int i, pg8::Unit& u) const { const long L = (long)i * G + c; if (L >= (long)ntiles * nN) return false;
        u.pm = (int)(L / nN); u.pn = (int)(L % nN); u.e = tile_e[u.pm]; u.boff = u.e * wsz; return true; }
    __device__ __forceinline__ void a_ready(const pg8::Unit&) const {}
    __device__ __forceinline__ void done(const pg8::Unit&) const {}
};
struct EpiSwiglu {
    static constexpr bool PERM = true, AFTER_DRAIN = false;
    const float* bgu; bf16* ACT;
    __device__ __forceinline__ void operator()(const pg8::f32x4 (&acc)[2][2][4][2], const pg8::Unit& u, int wr, int wc, int fr, int fq) const {
        const int row0 = u.pm * 256 + wr * 64 + fr, oc = u.pn * 128 + wc * 32 + 8 * fq; const float* bp = bgu + (size_t)u.e * 2048 + oc;
        const pg8::f32x4 bg0 = *(const pg8::f32x4*)bp, bg1 = *(const pg8::f32x4*)(bp + 4), bu0 = *(const pg8::f32x4*)(bp + 1024), bu1 = *(const pg8::f32x4*)(bp + 1028);
#pragma unroll
        for (int ai = 0; ai < 2; ++ai)
#pragma unroll
            for (int m = 0; m < 4; ++m) { float r[8];
#pragma unroll
                for (int n = 0; n < 2; ++n)
#pragma unroll
                    for (int j = 0; j < 4; ++j) { const float gte = fminf(acc[ai][0][m][n][j] + (n ? bg1[j] : bg0[j]), 7.f), up = fminf(fmaxf(acc[ai][1][m][n][j] + (n ? bu1[j] : bu0[j]), -7.f), 7.f);
                        r[4 * n + j] = (up + 1.f) * (gte * sigmoidf_(1.702f * gte)); }
                v4u w; w.x = cvtpk(r[0], r[1]); w.y = cvtpk(r[2], r[3]); w.z = cvtpk(r[4], r[5]); w.w = cvtpk(r[6], r[7]);
                *(v4u*)(ACT + (size_t)(row0 + ai * 128 + m * 16) * 1024 + oc) = w; }
    }
};
struct EpiDown {
    static constexpr bool PERM = true, AFTER_DRAIN = false;
    const float* bd; bf16* YS;
    __device__ __forceinline__ void operator()(const pg8::f32x4 (&acc)[2][2][4][2], const pg8::Unit& u, int wr, int wc, int fr, int fq) const {
        const int row0 = u.pm * 256 + wr * 64 + fr, col0 = u.pn * 256 + wc * 32 + 8 * fq; const float* bp = bd + (size_t)u.e * 1024 + col0;
        pg8::f32x4 bv[2][2];
#pragma unroll
        for (int bj = 0; bj < 2; ++bj)
#pragma unroll
            for (int n = 0; n < 2; ++n) bv[bj][n] = *(const pg8::f32x4*)(bp + bj * 128 + 4 * n);
#pragma unroll
        for (int ai = 0; ai < 2; ++ai)
#pragma unroll
            for (int m = 0; m < 4; ++m) { bf16* rowp = YS + (size_t)(row0 + ai * 128 + m * 16) * 1024 + col0;
#pragma unroll
                for (int bj = 0; bj < 2; ++bj) { const pg8::f32x4 v0 = acc[ai][bj][m][0] + bv[bj][0], v1 = acc[ai][bj][m][1] + bv[bj][1];
                    v4u w; w.x = cvtpk(v0[0], v0[1]); w.y = cvtpk(v0[2], v0[3]); w.z = cvtpk(v1[0], v1[1]); w.w = cvtpk(v1[2], v1[3]);
                    *(v4u*)(rowp + bj * 128) = w; } }
    }
};
__device__ __forceinline__ void p12_combine(const Ctx& F, const float* final_g, float* out) {
    const float* X1 = (const float*)(F.ws + WS_X1); const float* mod = (const float*)(F.ws + WS_MOD); const bf16* YS = (const bf16*)(F.ws + WS_YS);
    const int* TOKP = (const int*)(F.ws + WS_TOKP); const float* TOKW = (const float*)(F.ws + WS_TOKW);
    for (int m = F.gw; m < NTOK; m += F.NGW) {
        const int b = m / T; const float* gt = mod + b * 6144 + 5120;
        f32x4 a[4];
#pragma unroll
        for (int j = 0; j < 4; ++j) a[j] = (f32x4){0.f, 0.f, 0.f, 0.f};
#pragma unroll
        for (int k = 0; k < 4; ++k) { const int pos = TOKP[m * 4 + k]; const float w = TOKW[m * 4 + k];
#pragma unroll
            for (int j = 0; j < 4; ++j) { const v2u y = *(const v2u*)(YS + (size_t)pos * D + 4 * F.lane + 256 * j);
                a[j][0] = fmaf(w, bflo(y.x), a[j][0]); a[j][1] = fmaf(w, bfhi(y.x), a[j][1]); a[j][2] = fmaf(w, bflo(y.y), a[j][2]); a[j][3] = fmaf(w, bfhi(y.y), a[j][3]); } }
        float ss = 0.f;
#pragma unroll
        for (int j = 0; j < 4; ++j) { const int c = 4 * F.lane + 256 * j; a[j] = *(const f32x4*)(X1 + (size_t)m * D + c) + *(const f32x4*)(gt + c) * a[j];
            ss += (a[j].x * a[j].x + a[j].y * a[j].y) + (a[j].z * a[j].z + a[j].w * a[j].w); }
        const float rstd = 1.f / sqrtf(wave_sum(ss) * (1.f / D) + EPS);
#pragma unroll
        for (int j = 0; j < 4; ++j) { const int c = 4 * F.lane + 256 * j; *(f32x4*)(out + (size_t)m * D + c) = a[j] * rstd * *(const f32x4*)(final_g + c); }
    }
}

constexpr int NPH = 13;
#ifndef DUP_MASK
#define DUP_MASK 0
#endif
#define DUP(k) (((DUP_MASK) >> (k)) & 1)
struct Args { const float* in[20]; float* out; unsigned char* ws; int ph_lo, ph_hi; };
__global__ void __launch_bounds__(NWAVES * 64, 2) mk_fwd(Args args) {
    extern __shared__ __attribute__((aligned(16))) unsigned char lds_raw[];
    LAS unsigned char* const lds_ = (LAS unsigned char*)lds_raw;
#define MKCTX() Ctx F; { int t_ = threadIdx.x; asm volatile("" : "+v"(t_)); F.lds = lds_; F.ws = args.ws; F.tid = t_; F.lane = t_ & 63; F.wave = __builtin_amdgcn_readfirstlane(t_ >> 6); \
        F.bid = blockIdx.x; F.G = gridDim.x; F.gw = F.bid * NWAVES + F.wave; F.NGW = F.G * NWAVES; }
    const float* x = args.in[0]; const float* c_in = args.in[1]; const float* w_ada = args.in[2]; const float* b_ada = args.in[3]; const float* norm1_g = args.in[4];
    const float* w_in = args.in[5]; const float* w_gate_lr = args.in[6]; const float* b_gate = args.in[7]; const float* gla_norm_g = args.in[8];
    const float* w_br_a = args.in[9]; const float* w_br_b = args.in[10]; const float* w_out = args.in[11]; const float* norm2_g = args.in[12];
    const float* router_w = args.in[13]; const float* router_b = args.in[14]; const float* w_gu = args.in[15]; const float* b_gu = args.in[16];
    const float* w_dn = args.in[17]; const float* b_dn = args.in[18]; const float* final_g = args.in[19];
    unsigned char* ws = args.ws;
    for (int u = threadIdx.x; u < (LDS_BYTES - LDSCTL_OFF) / 4; u += NWAVES * 64) ((LAS unsigned*)(lds_ + LDSCTL_OFF))[u] = 0u;
    __syncthreads();
    const int lo = args.ph_lo, hi = args.ph_hi;
    const bool multi = (hi - lo) > 1;
    XcdBarrier bar; bar.bar = (unsigned*)(ws + WS_CTL) + CW_BAR; bar.x = 0; bar.st = (volatile LAS unsigned*)(lds_ + LDSCTL_OFF + 32);
    if (multi) bar = xcd_barrier_post((unsigned*)(ws + WS_CTL) + CW_BAR, (volatile LAS unsigned*)(lds_ + LDSCTL_OFF + 32));
#define IN(k) (lo <= (k) && (k) < hi)
#define SEAM(k) do { if (IN(k) && IN((k) + 1)) xcd_barrier(bar); } while (0)

    if (IN(0)) { MKCTX(); p0_prologue(F, c_in, w_ada, b_ada, w_in, w_br_a, w_br_b, w_out, w_gu, w_dn); if (DUP(0)) { __syncthreads(); p0_prologue(F, c_in, w_ada, b_ada, w_in, w_br_a, w_br_b, w_out, w_gu, w_dn); } }
    SEAM(0);
    if (IN(1)) { MKCTX(); p1_xn(F, x, norm1_g); if (DUP(1)) p1_xn(F, x, norm1_g); }
    SEAM(1);
    if (IN(2)) { MKCTX(); pg8::Gemm g{(const bf16*)(ws + WS_XN), (const bf16*)(ws + WS_WINT), NTOK, NPROJ, D}; pg8::StaticOrder S; S.init(NTOK, NPROJ, F.G, F.bid);
        EpiProj E{ws}; pg8::gemm_phase<EpiProj, pg8::StaticOrder, true, true>(F.lds, g, S, E); if (DUP(2)) pg8::gemm_phase<EpiProj, pg8::StaticOrder, true, true>(F.lds, g, S, E); }
    SEAM(2);
    if (IN(3)) { { MKCTX(); p3_indexer(F); if (DUP(3)) p3_indexer(F); } { MKCTX(); p3_gla1(F, w_gate_lr, b_gate); if (DUP(14)) p3_gla1(F, w_gate_lr, b_gate); } }
    SEAM(3);
    if (IN(4)) { { MKCTX(); p4_attention(F); if (DUP(4)) p4_attention(F); } { MKCTX(); p4_scan(F); if (DUP(13)) p4_scan(F); } }
    SEAM(4);
    if (IN(5)) { MKCTX(); p5_gla3(F, gla_norm_g); if (DUP(5)) p5_gla3(F, gla_norm_g); }
    SEAM(5);
    if (IN(6)) { MKCTX();
        { pg8::Gemm g{(const bf16*)(ws + WS_YA), (const bf16*)(ws + WS_WAT), NTOK, D, D}; pg8::StaticOrder S; S.init(NTOK, D, F.G, F.bid);
          EpiBrA E{(const bf16*)(ws + WS_GA), (float*)(ws + WS_TMPA)}; pg8::gemm_phase<EpiBrA, pg8::StaticOrder, true, true>(F.lds, g, S, E); if (DUP(6)) pg8::gemm_phase<EpiBrA, pg8::StaticOrder, true, true>(F.lds, g, S, E); }
        { pg8::Gemm g{(const bf16*)(ws + WS_YB), (const bf16*)(ws + WS_WBT), NTOK, D, D}; pg8::StaticOrder S; S.init(NTOK, D, F.G, F.bid);
          EpiBrB E{(const bf16*)(ws + WS_GBM), (const float*)(ws + WS_TMPA), (bf16*)(ws + WS_MERGED)}; pg8::gemm_phase<EpiBrB, pg8::StaticOrder, true, true>(F.lds, g, S, E); if (DUP(6)) pg8::gemm_phase<EpiBrB, pg8::StaticOrder, true, true>(F.lds, g, S, E); }
    }
    SEAM(6);
    if (IN(7)) { MKCTX(); pg8::Gemm g{(const bf16*)(ws + WS_MERGED), (const bf16*)(ws + WS_WOT), NTOK, D, D}; pg8::StaticOrder S; S.init(NTOK, D, F.G, F.bid);
        EpiOut E{x, (const float*)(ws + WS_MOD), (float*)(ws + WS_X1)}; pg8::gemm_phase<EpiOut, pg8::StaticOrder, true, true>(F.lds, g, S, E); if (DUP(7)) pg8::gemm_phase<EpiOut, pg8::StaticOrder, true, true>(F.lds, g, S, E); }
    SEAM(7);
    if (IN(8)) { MKCTX(); p8_router(F, norm2_g, router_w, router_b); if (DUP(8)) { __syncthreads(); p8_router(F, norm2_g, router_w, router_b, 4096); } }
    SEAM(8);
    if (IN(9)) { MKCTX(); p9_scatter(F); if (DUP(9)) { __syncthreads(); p9_scatter(F); } }
    SEAM(9);
    if (IN(10)) { MKCTX(); const int* tile_e = (const int*)(ws + WS_TILEE); const int ntiles = tile_e[NT_MAX];
        pg8::Gemm g{(const bf16*)(ws + WS_XS), (const bf16*)(ws + WS_WGUT), PMAX, 2048, D}; MoeOrder S{tile_e, ntiles, 8, F.G, F.bid, 2048 * D};
        EpiSwiglu E{b_gu, (bf16*)(ws + WS_ACT)}; pg8::gemm_phase<EpiSwiglu, MoeOrder, true, true>(F.lds, g, S, E); if (DUP(10)) pg8::gemm_phase<EpiSwiglu, MoeOrder, true, true>(F.lds, g, S, E); }
    SEAM(10);
    if (IN(11)) { MKCTX(); const int* tile_e = (const int*)(ws + WS_TILEE); const int ntiles = tile_e[NT_MAX];
        pg8::Gemm g{(const bf16*)(ws + WS_ACT), (const bf16*)(ws + WS_WDT), PMAX, D, DFF}; MoeOrder S{tile_e, ntiles, 4, F.G, F.bid, D * DFF};
        EpiDown E{b_dn, (bf16*)(ws + WS_YS)}; pg8::gemm_phase<EpiDown, MoeOrder, true, true>(F.lds, g, S, E); if (DUP(11)) pg8::gemm_phase<EpiDown, MoeOrder, true, true>(F.lds, g, S, E); }
    SEAM(11);
    if (DUP(15) && multi) { xcd_barrier(bar); xcd_barrier(bar); xcd_barrier(bar); xcd_barrier(bar); xcd_barrier(bar); xcd_barrier(bar); xcd_barrier(bar); xcd_barrier(bar); xcd_barrier(bar); xcd_barrier(bar); }
    if (IN(12)) { MKCTX(); p12_combine(F, final_g, args.out); if (DUP(12)) p12_combine(F, final_g, args.out); }
#undef IN
#undef SEAM
}

#ifndef MK_N_LAUNCHES
#define MK_N_LAUNCHES 1
#endif
extern "C" void kernel_launch(void* const* d_in, const int* in_sizes, int n_in, void* d_out, int out_size, void* d_ws, size_t ws_size, hipStream_t stream) {
    static int grid = 0;
    if (grid == 0) {
        if (n_in != 20 || out_size != NTOK * D || ws_size < WS_END) { fprintf(stderr, "kernel_launch: unexpected shapes (n_in %d out %d ws %zu)\n", n_in, out_size, ws_size); grid = -1; return; }
        int dev = 0, cus = 0, per_cu = 0;
        if (hipGetDevice(&dev) != hipSuccess || hipDeviceGetAttribute(&cus, hipDeviceAttributeMultiprocessorCount, dev) != hipSuccess) { grid = -1; return; }
        if (hipFuncSetAttribute((const void*)mk_fwd, hipFuncAttributeMaxDynamicSharedMemorySize, LDS_BYTES) != hipSuccess) { fprintf(stderr, "kernel_launch: hipFuncSetAttribute failed\n"); grid = -1; return; }
        if (hipOccupancyMaxActiveBlocksPerMultiprocessor(&per_cu, (const void*)mk_fwd, NWAVES * 64, LDS_BYTES) != hipSuccess || per_cu < 1) { fprintf(stderr, "kernel_launch: occupancy query says %d\n", per_cu); }
        (void)hipGetLastError();
        grid = cus;
    }
    if (grid < 0) return;
    if (hipMemsetAsync((char*)d_ws + WS_CTL, 0, CTL_ZERO_BYTES, stream) != hipSuccess) return;
    Args a{};
    for (int i = 0; i < 20; ++i) a.in[i] = (const float*)d_in[i];
    a.out = (float*)d_out; a.ws = (unsigned char*)d_ws;
#if MK_N_LAUNCHES == 1
    a.ph_lo = 0; a.ph_hi = NPH;
    hipLaunchKernelGGL(mk_fwd, dim3(grid), dim3(NWAVES * 64), LDS_BYTES, stream, a);
#else
    for (int p = 0; p < NPH; ++p) { a.ph_lo = p; a.ph_hi = p + 1; hipLaunchKernelGGL(mk_fwd, dim3(grid), dim3(NWAVES * 64), LDS_BYTES, stream, a); }
#endif
}
```

```cpp
#include <hip/hip_runtime.h>
#include <cstdio>
#include <cstdint>
namespace pg8 {
#define PG8_LAS __attribute__((address_space(3)))
typedef unsigned short bf16_t;
typedef short bf16x8 __attribute__((ext_vector_type(8)));
typedef float f32x4 __attribute__((ext_vector_type(4)));
typedef unsigned u32x4 __attribute__((ext_vector_type(4)));
typedef unsigned u32x2 __attribute__((ext_vector_type(2)));
constexpr int BM = 256, BK = 64, HALF = 128, HTB = HALF * BK * 2  , STAGE_BYTES = 8 * HTB, NXCD = 8, WGM = 8;

__host__ __device__ __forceinline__ int lds_byte(int r, int c) { const int st = (r >> 4) * 2 + (c >> 5), rr = r & 15, cc = c & 31, ob = rr * 64 + cc * 2; return st * 1024 + (ob ^ (((ob >> 9) & 1) << 5)); }
__host__ __device__ __forceinline__ void stage_rc(int b, int& R, int& C) { const int st = b / 1024, sb = b % 1024, swz = sb ^ (((sb >> 9) & 1) << 5); R = (st >> 1) * 16 + swz / 64; C = (st & 1) * 32 + (swz % 64) / 2; }
__host__ __device__ __forceinline__ int perm32(int rho) { const int n = rho >> 4, i = rho & 15; return 8 * (i >> 2) + 4 * n + (i & 3); }

struct Unit { int pm, pn, e, boff, aoff, kind; };
struct Gemm { const bf16_t* A; const bf16_t* Bt; int M, N, K; };

struct StaticOrder {
    int nM, nN, nwg, G, c;
    __host__ __device__ void init(int M, int N, int G_, int c_) { nM = M / BM; nN = N / BM; nwg = nM * nN; G = G_; c = c_; }
    __host__ __device__ bool next(int i, Unit& u) const {
        const long L = (long)i * G + c; if (L >= nwg) return false;
        int wgid = (int)L; { const int q = nwg / NXCD, r = nwg % NXCD, xcd = wgid % NXCD, off = wgid / NXCD; wgid = (xcd < r ? xcd * (q + 1) : r * (q + 1) + (xcd - r) * q) + off; }
        const int nig = WGM * nN, gid = wgid / nig, fm = gid * WGM, gsz = (nM - fm) < WGM ? (nM - fm) : WGM;
        u.pm = fm + ((wgid % nig) % gsz); u.pn = (wgid % nig) / gsz; u.e = 0; u.boff = 0; u.aoff = 0; u.kind = 0; return true;
    }
    __device__ __forceinline__ void a_ready(const Unit&) const {}
    __device__ __forceinline__ void done(const Unit&) const {}
};
__device__ __forceinline__ unsigned cvt_pk_bf16(float lo, float hi) { unsigned r; asm volatile("v_cvt_pk_bf16_f32 %0, %1, %2" : "=v"(r) : "v"(lo), "v"(hi)); return r; }

template <class Epi, class Sched, bool ALIGN_EPI = false, bool SP2 = false>
__device__ __forceinline__ void gemm_phase(PG8_LAS unsigned char* lds, const Gemm g, const Sched& S, const Epi& E) {
    const int tid = threadIdx.x, wid = __builtin_amdgcn_readfirstlane(tid >> 6), lane = tid & 63, wr = wid >> 2, wc = wid & 3, fr = lane & 15, fq = lane >> 4;
    const int K = g.K, nt = K / BK;
    unsigned voffA[2], voffB[2];
#pragma unroll
    for (int i = 0; i < 2; ++i) { int R, C; stage_rc(tid * 16 + i * 8192, R, C); const int Rb = Epi::PERM ? ((R & ~31) + perm32(R & 31)) : R;
        voffA[i] = (unsigned)(R * K + C) * 2u; voffB[i] = (unsigned)(Rb * K + C) * 2u; }
    const size_t kstep = (size_t)(BK * 2);
    const size_t hstep = (size_t)HALF * K * 2;
    const size_t tstep = 2 * hstep;
    const unsigned ldsw = (unsigned)wid * 1024u;
    const int aoff = lds_byte(wr * 64 + fr, fq * 8), boff = lds_byte(wc * 32 + fr, fq * 8);
#define PG8_SA(b, h) (((b) * 2 + (h)) * HTB)
#define PG8_SB(b, h) ((4 + (b) * 2 + (h)) * HTB)
#define PG8_STAGE(bufoff, gbase, voff) do { _Pragma("unroll") for (int _i = 0; _i < 2; ++_i) \
        __builtin_amdgcn_global_load_lds((const unsigned*)((const char*)(gbase) + (voff)[_i]), (PG8_LAS unsigned*)(lds + (bufoff) + ldsw + _i * 8192), 16, 0, 0); } while (0)
#define PG8_LDA(dst, b, h) do { _Pragma("unroll") for (int m = 0; m < 4; ++m) _Pragma("unroll") for (int k = 0; k < 2; ++k) dst[m][k] = *(const PG8_LAS bf16x8*)(lds + PG8_SA(b, h) + aoff + m * 2048 + k * 1024); } while (0)
#define PG8_LDB(dst, b, h) do { _Pragma("unroll") for (int n = 0; n < 2; ++n) _Pragma("unroll") for (int k = 0; k < 2; ++k) dst[n][k] = *(const PG8_LAS bf16x8*)(lds + PG8_SB(b, h) + boff + n * 2048 + k * 1024); } while (0)
#define PG8_MMA(ai, bj, At, Bt) do { __builtin_amdgcn_s_setprio(1); _Pragma("unroll") for (int m = 0; m < 4; ++m) _Pragma("unroll") for (int n = 0; n < 2; ++n) _Pragma("unroll") for (int k = 0; k < 2; ++k) \
        acc[ai][bj][m][n] = __builtin_amdgcn_mfma_f32_16x16x32_bf16(Bt[n][k], At[m][k], acc[ai][bj][m][n], 0, 0, 0); __builtin_amdgcn_s_setprio(0); } while (0)
#define PG8_WAIT_V(n) asm volatile("s_waitcnt vmcnt(" #n ")" ::: "memory")
#define PG8_WAIT_L(n) asm volatile("s_waitcnt lgkmcnt(" #n ")" ::: "memory")
#define PG8_BAR __builtin_amdgcn_s_barrier()
#define PG8_SCHED __builtin_amdgcn_sched_barrier(0)
    Unit cur, nxt; int ui = 0;
    if (!S.next(0, cur)) return;
    f32x4 acc[2][2][4][2];
#pragma unroll
    for (int a = 0; a < 2; ++a)
#pragma unroll
        for (int b = 0; b < 2; ++b)
#pragma unroll
            for (int m = 0; m < 4; ++m)
#pragma unroll
                for (int n = 0; n < 2; ++n) acc[a][b][m][n] = (f32x4){0.f, 0.f, 0.f, 0.f};
    bf16x8 At[4][2], B0[2][2], B1[2][2];
    const char* cA = (const char*)g.A + (size_t)cur.aoff * 2 + (size_t)cur.pm * tstep; const char* cB = (const char*)g.Bt + (size_t)cur.boff * 2 + (size_t)cur.pn * tstep;
    S.a_ready(cur);
    if constexpr (SP2) {
        PG8_STAGE(PG8_SB(0, 0), cB, voffB); PG8_STAGE(PG8_SB(0, 1), cB + hstep, voffB); PG8_STAGE(PG8_SA(0, 0), cA, voffA); PG8_STAGE(PG8_SA(0, 1), cA + hstep, voffA);
        if (wr == 1) PG8_BAR;
        PG8_WAIT_V(2); PG8_BAR;
        PG8_STAGE(PG8_SB(1, 0), cB + kstep, voffB); PG8_STAGE(PG8_SA(1, 0), cA + kstep, voffA); PG8_STAGE(PG8_SB(1, 1), cB + hstep + kstep, voffB);
        PG8_WAIT_V(6); PG8_BAR;
    } else {
        PG8_STAGE(PG8_SB(0, 0), cB, voffB); PG8_STAGE(PG8_SA(0, 0), cA, voffA); PG8_STAGE(PG8_SB(0, 1), cB + hstep, voffB); PG8_STAGE(PG8_SA(0, 1), cA + hstep, voffA);
        if (wr == 1) PG8_BAR;
        PG8_WAIT_V(4); PG8_BAR;
        PG8_STAGE(PG8_SB(1, 0), cB + kstep, voffB); PG8_STAGE(PG8_SA(1, 0), cA + kstep, voffA); PG8_STAGE(PG8_SB(1, 1), cB + hstep + kstep, voffB);
        PG8_WAIT_V(6); PG8_BAR;
    }
    for (;;) {
        const bool has_next = S.next(ui + 1, nxt);
        const char* nA = has_next ? (const char*)g.A + (size_t)nxt.aoff * 2 + (size_t)nxt.pm * tstep : cA; const char* nB = has_next ? (const char*)g.Bt + (size_t)nxt.boff * 2 + (size_t)nxt.pn * tstep : cB;
        for (int t = 0; t < nt; t += 2) {
            const bool last = (t == nt - 2);
            const char* a1 = cA + (size_t)(t + 1) * kstep;
            const char* a2 = last ? nA : cA + (size_t)(t + 2) * kstep; const char* b2 = last ? nB : cB + (size_t)(t + 2) * kstep;
            const char* a3 = a2 + kstep; const char* b3 = b2 + kstep;
            if (last && has_next) S.a_ready(nxt);
            if constexpr (SP2) {
            PG8_LDB(B0, 0, 0); PG8_LDB(B1, 0, 1); PG8_SCHED; PG8_LDA(At, 0, 0); PG8_STAGE(PG8_SA(1, 1), a1 + hstep, voffA);
            PG8_WAIT_V(8); PG8_WAIT_L(0); PG8_BAR; PG8_MMA(0, 0, At, B0); PG8_MMA(0, 1, At, B1); PG8_BAR; PG8_SCHED;
            PG8_LDA(At, 0, 1); PG8_STAGE(PG8_SB(0, 0), b2, voffB); PG8_STAGE(PG8_SB(0, 1), b2 + hstep, voffB); PG8_STAGE(PG8_SA(0, 0), a2, voffA);
            PG8_WAIT_V(8); PG8_WAIT_L(0); PG8_BAR; PG8_MMA(1, 0, At, B0); PG8_MMA(1, 1, At, B1); PG8_BAR; PG8_SCHED;
            PG8_LDB(B0, 1, 0); PG8_LDB(B1, 1, 1); PG8_SCHED; PG8_LDA(At, 1, 0); PG8_STAGE(PG8_SA(0, 1), a2 + hstep, voffA);
            PG8_WAIT_V(8); PG8_WAIT_L(0); PG8_BAR; PG8_MMA(0, 0, At, B0); PG8_MMA(0, 1, At, B1); PG8_BAR; PG8_SCHED;
            PG8_LDA(At, 1, 1); PG8_STAGE(PG8_SB(1, 0), b3, voffB); PG8_STAGE(PG8_SB(1, 1), b3 + hstep, voffB); PG8_STAGE(PG8_SA(1, 0), a3, voffA);
            PG8_WAIT_V(8); PG8_WAIT_L(0); PG8_BAR; PG8_MMA(1, 0, At, B0); PG8_MMA(1, 1, At, B1); PG8_BAR; PG8_SCHED;
            } else {
            PG8_LDB(B0, 0, 0); PG8_SCHED; PG8_LDA(At, 0, 0); PG8_STAGE(PG8_SA(1, 1), a1 + hstep, voffA);
            PG8_WAIT_L(8); PG8_BAR; PG8_WAIT_L(0); PG8_MMA(0, 0, At, B0); PG8_BAR; PG8_SCHED;
            PG8_LDB(B1, 0, 1); PG8_STAGE(PG8_SB(0, 0), b2, voffB);
            PG8_BAR; PG8_WAIT_L(0); PG8_MMA(0, 1, At, B1); PG8_BAR;
            PG8_LDA(At, 0, 1); PG8_STAGE(PG8_SA(0, 0), a2, voffA);
            PG8_BAR; PG8_WAIT_L(0); PG8_MMA(1, 0, At, B0); PG8_BAR; PG8_SCHED;
            PG8_STAGE(PG8_SB(0, 1), b2 + hstep, voffB);
            PG8_WAIT_V(6); PG8_BAR; PG8_MMA(1, 1, At, B1); PG8_BAR;
            PG8_LDB(B0, 1, 0); PG8_SCHED; PG8_LDA(At, 1, 0); PG8_STAGE(PG8_SA(0, 1), a2 + hstep, voffA);
            PG8_WAIT_L(8); PG8_BAR; PG8_WAIT_L(0); PG8_MMA(0, 0, At, B0); PG8_BAR; PG8_SCHED;
            PG8_LDB(B1, 1, 1); PG8_STAGE(PG8_SB(1, 0), b3, voffB);
            PG8_BAR; PG8_WAIT_L(0); PG8_MMA(0, 1, At, B1); PG8_BAR;
            PG8_LDA(At, 1, 1); PG8_STAGE(PG8_SA(1, 0), a3, voffA);
            PG8_BAR; PG8_WAIT_L(0); PG8_MMA(1, 0, At, B0); PG8_BAR; PG8_SCHED;
            PG8_STAGE(PG8_SB(1, 1), b3 + hstep, voffB);
            PG8_WAIT_V(6); PG8_BAR; PG8_MMA(1, 1, At, B1); PG8_BAR;
            }
        }
        if constexpr (ALIGN_EPI) { if (wr == 0) PG8_BAR; }
        if constexpr (!Epi::AFTER_DRAIN) { E(acc, cur, wr, wc, fr, fq); S.done(cur); }
        if (!has_next) break;
#pragma unroll
        for (int a = 0; a < 2; ++a)
#pragma unroll
            for (int b = 0; b < 2; ++b)
#pragma unroll
                for (int m = 0; m < 4; ++m)
#pragma unroll
                    for (int n = 0; n < 2; ++n) acc[a][b][m][n] = (f32x4){0.f, 0.f, 0.f, 0.f};
        cur = nxt; cA = nA; cB = nB; ++ui;
        if constexpr (ALIGN_EPI) { if (wr == 1) PG8_BAR; }
    }
    PG8_WAIT_V(0);
    if constexpr (!ALIGN_EPI) { if (wr == 0) PG8_BAR; }
    PG8_BAR;
    if constexpr (Epi::AFTER_DRAIN) { E.fused(acc, cur, wr, wc, fr, fq, lds, wid, lane); S.done(cur); }
#undef PG8_SA
#undef PG8_SB
#undef PG8_STAGE
#undef PG8_LDA
#undef PG8_LDB
#undef PG8_MMA
#undef PG8_WAIT_V
#undef PG8_WAIT_L
#undef PG8_BAR
#undef PG8_SCHED
}
}

constexpr int NB = 4, T = 4096, D = 1024, NTOK = NB * T;
constexpr int NEXP = 32, TOPK = 4, DFF = 1024;
constexpr int INW = 8792, NPROJ = 8960;
constexpr int NT_MAX = NTOK * TOPK / 256 + NEXP;
constexpr int PMAX = NT_MAX * 256;
constexpr float EPS = 1e-6f;
constexpr float QA_SCALE = 0.08838834764831845f * 1.4426950408889634f;
constexpr float QB_SCALE = 0.08838834764831845f;
constexpr int NWAVES = 8;

constexpr size_t MiB = 1u << 20;
constexpr size_t WS_CTL = 0, CTL_ZERO_BYTES = 1 * MiB;
constexpr size_t WS_MOD = 1 * MiB;
constexpr size_t WS_TOKE = 2 * MiB, WS_TOKR = WS_TOKE + 256 * 1024, WS_TOKW = WS_TOKR + 256 * 1024, WS_TOKP = WS_TOKW + 256 * 1024;
constexpr size_t WS_TILEE = 3 * MiB;
constexpr size_t WS_DEC = 3 * MiB + 256 * 1024;
constexpr size_t WS_WINT = 4 * MiB, WS_WAT = 22 * MiB, WS_WBT = 24 * MiB, WS_WOT = 26 * MiB, WS_WGUT = 28 * MiB, WS_WDT = 156 * MiB;
constexpr size_t WS_XN = 220 * MiB;
constexpr size_t WS_QA = 252 * MiB, WS_KA = 284 * MiB, WS_VA = 316 * MiB;
constexpr size_t WS_QI = 348 * MiB, WS_QB = 364 * MiB, WS_KB = 380 * MiB;
constexpr size_t WS_VB = 396 * MiB, WS_GB = 428 * MiB, WS_GA = 460 * MiB, WS_GBM = 492 * MiB;
constexpr size_t WS_KI = 524 * MiB;
constexpr size_t WS_SMALL = 526 * MiB;
constexpr size_t WS_MASK = 528 * MiB;
constexpr size_t WS_KVC = 536 * MiB;
constexpr size_t WS_SC = 664 * MiB;
constexpr size_t WS_YA = 728 * MiB, WS_YB = 760 * MiB;
constexpr size_t WS_X1 = 792 * MiB;
constexpr size_t WS_YS = 856 * MiB;
constexpr size_t WS_END = 1000 * MiB;
constexpr size_t WS_QE = WS_XN, WS_KE = WS_XN + 16 * MiB;
constexpr size_t WS_MERGED = WS_XN, WS_TMPA = WS_QA  , WS_H2 = WS_QA, WS_XS = WS_VA  , WS_ACT = WS_KVC;
static_assert(WS_XS + (size_t)PMAX * 1024 * 2 <= WS_GA && WS_ACT + (size_t)PMAX * 1024 * 2 <= WS_YA && WS_YS + (size_t)PMAX * 1024 * 2 <= WS_END, "overlays");
constexpr int CW_BAR = 4096;
constexpr int CW_ECNT = 8192;

constexpr int LDS_BYTES = 155648;
constexpr int LDSCTL_OFF = 154624;

#define GAS __attribute__((address_space(1)))
#define LAS __attribute__((address_space(3)))
typedef unsigned short bf16;
typedef unsigned v4u __attribute__((ext_vector_type(4)));
typedef unsigned v2u __attribute__((ext_vector_type(2)));
typedef float f32x4 __attribute__((ext_vector_type(4)));
typedef float f32x16 __attribute__((ext_vector_type(16)));
typedef short bf16x8 __attribute__((ext_vector_type(8)));
typedef short s16x4 __attribute__((ext_vector_type(4)));
typedef GAS unsigned gu32;
typedef unsigned long long u64;
#define LDS_WAIT() asm volatile("s_waitcnt lgkmcnt(0)" ::: "memory")
#define VM_WAIT() asm volatile("s_waitcnt vmcnt(0)" ::: "memory")
#define SBAR() __builtin_amdgcn_sched_barrier(0)
__device__ __forceinline__ unsigned f2bf(float f) { unsigned u = __builtin_bit_cast(unsigned, f); return (u + 0x7fffu + ((u >> 16) & 1u)) >> 16; }
__device__ __forceinline__ unsigned pk2(float lo, float hi) { return f2bf(lo) | (f2bf(hi) << 16); }
__device__ __forceinline__ float bf2f(unsigned short h) { return __builtin_bit_cast(float, (unsigned)h << 16); }
__device__ __forceinline__ float bflo(unsigned w) { return __builtin_bit_cast(float, w << 16); }
__device__ __forceinline__ float bfhi(unsigned w) { return __builtin_bit_cast(float, w & 0xffff0000u); }
__device__ __forceinline__ unsigned cvtpk(float lo, float hi) { unsigned r; asm volatile("v_cvt_pk_bf16_f32 %0, %1, %2" : "=v"(r) : "v"(lo), "v"(hi)); return r; }
__device__ __forceinline__ float wave_sum(float v) {
#pragma unroll
    for (int o = 1; o < 64; o <<= 1) v += __shfl_xor(v, o);
    return v;
}
__device__ __forceinline__ float sigmoidf_(float x) { return 1.f / (1.f + __expf(-x)); }

#define XB_TMO      128
#define XB_XCNT(j)  (256  + 64 * (j))
#define XB_XSUB(j)  (1280 + 64 * (j))
#define XB_XGEN(j)  (2304 + 64 * (j))
#define XB_TOP      3328
#define XB_TOPGEN   3392
#define XCD_BAR_WORDS 3456
#define XB_SPIN_CAP (1u << 18)

__device__ __forceinline__ unsigned xb_ld(unsigned* p)              { return __hip_atomic_load(p, __ATOMIC_RELAXED, __HIP_MEMORY_SCOPE_AGENT); }
__device__ __forceinline__ unsigned xb_add(unsigned* p, unsigned v) { return __hip_atomic_fetch_add(p, v, __ATOMIC_RELAXED, __HIP_MEMORY_SCOPE_AGENT); }
__device__ __forceinline__ unsigned xb_xcc_id() { return (unsigned)__builtin_amdgcn_s_getreg((3 << 11) | 20) & 0xFu; }
#define XB_SPIN(cond, bar) do { unsigned _sp = 0; while (cond) { __builtin_amdgcn_s_sleep(1); \
    if ((++_sp & 255u) == 0u) { if (xb_ld(&(bar)[XB_TMO])) break; if (_sp > XB_SPIN_CAP) { atomicAdd(&(bar)[XB_TMO], 1u); break; } } } } while (0)

struct XcdBarrier {
    unsigned* bar; unsigned x;
    volatile LAS unsigned* st;
};

__device__ __forceinline__ XcdBarrier xcd_barrier_post(unsigned* bar, volatile LAS unsigned* st) {
    XcdBarrier b; b.bar = bar; b.x = xb_xcc_id(); b.st = st;
    if (threadIdx.x == 0) (void)xb_add(&bar[XB_XCNT(b.x)], 1u);
    return b;
}
__device__ __forceinline__ void xcd_barrier_complete(unsigned* bar, unsigned x, unsigned& nloc, unsigned& nx) {
    const unsigned G = gridDim.x * gridDim.y * gridDim.z;
    unsigned sum, cnt, mine, sp = 0u;
    for (;;) {
        sum = 0u; cnt = 0u; mine = 0u;
#pragma unroll
        for (unsigned j = 0; j < 16; ++j) { const unsigned c = xb_ld(&bar[XB_XCNT(j)]); sum += c; cnt += (c > 0u) ? 1u : 0u; mine = (j == x) ? c : mine; }
        if (sum == G) break;
        __builtin_amdgcn_s_sleep(1);
        if ((++sp & 255u) == 0u) { if (xb_ld(&bar[XB_TMO])) break; if (sp > XB_SPIN_CAP) { atomicAdd(&bar[XB_TMO], 1u); break; } }
    }
    nloc = mine > 0u ? mine : 1u; nx = cnt > 0u ? cnt : 1u;
}

__device__ __forceinline__ void xcd_barrier(const XcdBarrier& b) {
    asm volatile("s_waitcnt vmcnt(0)" ::: "memory");
    __syncthreads();
    if (threadIdx.x == 0) {
        unsigned* bar = b.bar;
        __builtin_amdgcn_s_waitcnt(0);
        unsigned nloc = b.st[0], nx = b.st[1];
        if (nloc == 0u) { xcd_barrier_complete(bar, b.x, nloc, nx); b.st[0] = nloc; b.st[1] = nx; }
        const unsigned old = xb_add(&bar[XB_XSUB(b.x)], 1u);
        const unsigned gen = old / nloc;
        if (old + 1u == (gen + 1u) * nloc) {
            __builtin_amdgcn_fence(__ATOMIC_RELEASE, "agent");
            asm volatile("s_waitcnt vmcnt(0)" ::: "memory");
            const unsigned og = xb_add(&bar[XB_TOP], 1u);
            const unsigned tg = og / nx;
            if (og + 1u == (tg + 1u) * nx) xb_add(&bar[XB_TOPGEN], 1u);
            else XB_SPIN(xb_ld(&bar[XB_TOPGEN]) == tg, bar);
            __builtin_amdgcn_fence(__ATOMIC_ACQUIRE, "agent");
            xb_add(&bar[XB_XGEN(b.x)], 1u);
            asm volatile("s_waitcnt vmcnt(0)" ::: "memory");
        } else {
            XB_SPIN(xb_ld(&bar[XB_XGEN(b.x)]) == gen, bar);
            __builtin_amdgcn_fence(__ATOMIC_ACQUIRE, "agent");
            asm volatile("s_waitcnt vmcnt(0)" ::: "memory");
        }
    }
    __syncthreads();
}

struct Ctx {
    LAS unsigned char* lds;
    unsigned char* ws;
    int tid, lane, wave;
    int bid, G;
    int gw, NGW;
};

__device__ __forceinline__ int win_src_col(int n) {
    if (n < 3584) return n;
    if (n < 6656) return n - 3584 + 3656;
    if (n < 8704) return n - 6656 + 6744;
    if (n < 8768) return n - 8704 + 3584;
    if (n < 8776) return n - 8768 + 3648;
    if (n < 8792) return n - 8776 + 6728;
    return -1;
}
__device__ __forceinline__ void tr_item(const float* Wcol, size_t ldw, int K, bf16* WT0, LAS float* scr, int lane) {
#pragma unroll 8
    for (int i = 0; i < 32; ++i) { const int kk = 2 * i + (lane >> 5); scr[kk * 33 + (lane & 31)] = Wcol ? Wcol[(size_t)kk * ldw] : 0.f; }
    LDS_WAIT(); asm volatile("" ::: "memory");
    const int c = lane & 7;
#pragma unroll
    for (int j = 0; j < 4; ++j) { const int n = (lane >> 3) + 8 * j; const LAS float* s = scr + (8 * c) * 33 + n;
        v4u o; o.x = pk2(s[0 * 33], s[1 * 33]); o.y = pk2(s[2 * 33], s[3 * 33]); o.z = pk2(s[4 * 33], s[5 * 33]); o.w = pk2(s[6 * 33], s[7 * 33]);
        *(GAS v4u*)(WT0 + (size_t)n * K + 8 * c) = o; }
    LDS_WAIT(); asm volatile("" ::: "memory");
}
constexpr int TR_PITCH = 65, TR_SCR_BYTES = 64 * TR_PITCH * 4  , P0_SIL_OFF = 8 * TR_SCR_BYTES  ;
static_assert(P0_SIL_OFF + 16384 <= LDSCTL_OFF, "prologue LDS map");
__device__ __forceinline__ void tr_item64(const float* W0, size_t ldw, int K, bf16* WT0, LAS float* scr, int lane) {
    const int r4 = lane >> 4, c4 = lane & 15;
    f32x4 v[16];
#pragma unroll
    for (int i = 0; i < 16; ++i) v[i] = *(const f32x4*)(W0 + (size_t)(4 * i + r4) * ldw + 4 * c4);
#pragma unroll
    for (int i = 0; i < 16; ++i) { LAS float* p = scr + (4 * i + r4) * TR_PITCH + 4 * c4; p[0] = v[i].x; p[1] = v[i].y; p[2] = v[i].z; p[3] = v[i].w; }
    LDS_WAIT(); asm volatile("" ::: "memory");
    const int c = lane & 7, nl = lane >> 3;
#pragma unroll
    for (int j = 0; j < 8; ++j) { const int n = nl + 8 * j; const LAS float* s = scr + (8 * c) * TR_PITCH + n;
        v4u o; o.x = pk2(s[0 * TR_PITCH], s[1 * TR_PITCH]); o.y = pk2(s[2 * TR_PITCH], s[3 * TR_PITCH]); o.z = pk2(s[4 * TR_PITCH], s[5 * TR_PITCH]); o.w = pk2(s[6 * TR_PITCH], s[7 * TR_PITCH]);
        *(GAS v4u*)(WT0 + (size_t)n * K + 8 * c) = o; }
    LDS_WAIT(); asm volatile("" ::: "memory");
}
__device__ __forceinline__ void p0_prologue(const Ctx& F, const float* c_in, const float* w_ada, const float* b_ada, const float* w_in, const float* w_a, const float* w_b, const float* w_o,
                                            const float* w_gu, const float* w_dn) {
    LAS float* scr = (LAS float*)(F.lds + F.wave * TR_SCR_BYTES);
    LAS float* sil = (LAS float*)(F.lds + P0_SIL_OFF);
    for (int i = F.tid; i < 4096; i += 512) { const float v = c_in[i]; sil[i] = v / (1.f + __expf(-v)); }
    __syncthreads();
    for (int it = F.NGW - 1 - F.gw; it < 384; it += F.NGW) {
        const int c4 = F.lane & 3, rg = F.lane >> 2, col = 16 * it + 4 * c4;
        f32x4 a0 = {0.f, 0.f, 0.f, 0.f}, a1 = a0, a2 = a0, a3 = a0;
        const float* wp = w_ada + (size_t)rg * 6144 + col;
#pragma unroll 16
        for (int i = 0; i < 64; ++i) { const int k = 16 * i + rg; const f32x4 w = *(const f32x4*)(wp + (size_t)i * 16 * 6144);
            a0 += w * sil[k]; a1 += w * sil[1024 + k]; a2 += w * sil[2048 + k]; a3 += w * sil[3072 + k]; }
#pragma unroll
        for (int o = 4; o < 64; o <<= 1) {
#pragma unroll
            for (int j = 0; j < 4; ++j) { a0[j] += __shfl_xor(a0[j], o); a1[j] += __shfl_xor(a1[j], o); a2[j] += __shfl_xor(a2[j], o); a3[j] += __shfl_xor(a3[j], o); } }
        if (F.lane < 4) { float* mod = (float*)(F.ws + WS_MOD); const f32x4 bb = *(const f32x4*)(b_ada + col);
            *(f32x4*)(mod + col) = a0 + bb; *(f32x4*)(mod + 6144 + col) = a1 + bb; *(f32x4*)(mod + 2 * 6144 + col) = a2 + bb; *(f32x4*)(mod + 3 * 6144 + col) = a3 + bb; }
    }
    constexpr int J_IN = 16 * 137, J_SQ = 16 * 16, J_GU = NEXP * 16 * 32, J_DN = NEXP * 16 * 16, NJ = J_IN + 3 * J_SQ + J_GU + J_DN;
    for (int it = F.gw; it < NJ; it += F.NGW) {
        int r = it; const float* W0; size_t ldw; int K; bf16* WT0;
        if (r < J_IN) { const int kb = r / 137, n0 = 64 * (r % 137); W0 = w_in + (size_t)(64 * kb) * INW + win_src_col(n0); ldw = INW; K = D; WT0 = (bf16*)(F.ws + WS_WINT) + (size_t)n0 * D + 64 * kb; }
        else if ((r -= J_IN) < 3 * J_SQ) { const int which = r / J_SQ; r -= which * J_SQ; const int kb = r / 16, nb = r % 16;
            W0 = (which == 0 ? w_a : (which == 1 ? w_b : w_o)) + (size_t)(64 * kb) * D + 64 * nb; ldw = D; K = D;
            WT0 = (bf16*)(F.ws + (which == 0 ? WS_WAT : (which == 1 ? WS_WBT : WS_WOT))) + (size_t)(64 * nb) * D + 64 * kb; }
        else if ((r -= 3 * J_SQ) < J_GU) { const int e = r / 512; r -= e * 512; const int kb = r / 32, n0 = 64 * (r % 32), pn = n0 >> 8, i0 = n0 & 255, sc0 = i0 < 128 ? 128 * pn + i0 : 1024 + 128 * pn + (i0 - 128);
            W0 = w_gu + (size_t)e * D * 2048 + (size_t)(64 * kb) * 2048 + sc0; ldw = 2048; K = D; WT0 = (bf16*)(F.ws + WS_WGUT) + (size_t)e * 2048 * D + (size_t)n0 * D + 64 * kb; }
        else { r -= J_GU; const int e = r / 256; r -= e * 256; const int kb = r / 16, nb = r % 16;
            W0 = w_dn + (size_t)e * DFF * D + (size_t)(64 * kb) * D + 64 * nb; ldw = D; K = DFF; WT0 = (bf16*)(F.ws + WS_WDT) + (size_t)e * D * DFF + (size_t)(64 * nb) * DFF + 64 * kb; }
        tr_item64(W0, ldw, K, WT0, scr, F.lane);
    }
    for (int it = F.gw; it < 16 * 6; it += F.NGW) { const int kb = it / 6, nb = 274 + it % 6; const int sc = win_src_col(32 * nb + (F.lane & 31));
        tr_item(sc >= 0 ? w_in + (size_t)(64 * kb) * INW + sc : nullptr, INW, D, (bf16*)(F.ws + WS_WINT) + (size_t)(32 * nb) * D + 64 * kb, scr, F.lane); }
}
__device__ __forceinline__ void p1_xn(const Ctx& F, const float* x, const float* g1) {
    const float* mod = (const float*)(F.ws + WS_MOD);
    bf16* XN = (bf16*)(F.ws + WS_XN);
    for (int r0 = 8 * F.gw; r0 < NTOK; r0 += 8 * F.NGW) {
        const int b = r0 / T; const float* mb = mod + b * 6144;
        f32x4 ga[4], sh[4];
#pragma unroll
        for (int j = 0; j < 4; ++j) { const int c = 4 * F.lane + 256 * j; const f32x4 g = *(const f32x4*)(g1 + c), s = *(const f32x4*)(mb + 1024 + c); ga[j] = g * (s + 1.0f); sh[j] = *(const f32x4*)(mb + c); }
        for (int rr = 0; rr < 8; ++rr) { const int m = r0 + rr;
            const GAS f32x4* xr = (const GAS f32x4*)(x + (size_t)m * D) + F.lane;
            f32x4 v[4]; float s = 0.f;
#pragma unroll
            for (int j = 0; j < 4; ++j) { v[j] = xr[64 * j]; s += (v[j].x * v[j].x + v[j].y * v[j].y) + (v[j].z * v[j].z + v[j].w * v[j].w); }
            const float rstd = 1.f / sqrtf(wave_sum(s) * (1.f / D) + EPS);
            GAS u64* o8 = (GAS u64*)(XN + (size_t)m * D) + F.lane;
#pragma unroll
            for (int j = 0; j < 4; ++j) { const f32x4 h = v[j] * rstd * ga[j] + sh[j]; o8[64 * j] = (u64)pk2(h.x, h.y) | ((u64)pk2(h.z, h.w) << 32); }
        }
    }
}
struct EpiProj {
    static constexpr bool PERM = true, AFTER_DRAIN = false;
    unsigned char* ws;
    __device__ __forceinline__ void operator()(const pg8::f32x4 (&acc)[2][2][4][2], const pg8::Unit& u, int wr, int wc, int fr, int fq) const {
        const int pn = u.pn, row0 = u.pm * 256 + wr * 64 + fr;
        if (pn < 34) {
            size_t off; int ld, ct; float sc = 1.f;
            if (pn < 12) { const int t = pn >> 2; off = WS_QA + (size_t)t * 32 * MiB; ld = 1024; ct = (pn & 3) * 256; if (t == 0) sc = QA_SCALE; }
            else if (pn < 18) { const int t = (pn - 12) >> 1; off = WS_QI + (size_t)t * 16 * MiB; ld = 512; ct = ((pn - 12) & 1) * 256; sc = t == 0 ? 0.125f : (t == 1 ? QB_SCALE : 1.f); }
            else { const int t = (pn - 18) >> 2; off = WS_VB + (size_t)t * 32 * MiB; ld = 1024; ct = ((pn - 18) & 3) * 256; }
            bf16* base = (bf16*)(ws + off); const int col0 = ct + wc * 32 + 8 * fq;
#pragma unroll
            for (int ai = 0; ai < 2; ++ai)
#pragma unroll
                for (int m = 0; m < 4; ++m) { bf16* rowp = base + (size_t)(row0 + ai * 128 + m * 16) * ld + col0;
#pragma unroll
                    for (int bj = 0; bj < 2; ++bj) { const pg8::f32x4 v0 = acc[ai][bj][m][0] * sc, v1 = acc[ai][bj][m][1] * sc;
                        v4u w; w.x = cvtpk(v0[0], v0[1]); w.y = cvtpk(v0[2], v0[3]); w.z = cvtpk(v1[0], v1[1]); w.w = cvtpk(v1[2], v1[3]);
                        *(v4u*)(rowp + bj * 128) = w; } }
        } else {
            if (wc < 2) { bf16* KI = (bf16*)(ws + WS_KI);
#pragma unroll
                for (int ai = 0; ai < 2; ++ai)
#pragma unroll
                    for (int m = 0; m < 4; ++m) { const pg8::f32x4 v0 = acc[ai][0][m][0], v1 = acc[ai][0][m][1];
                        v4u w; w.x = cvtpk(v0[0], v0[1]); w.y = cvtpk(v0[2], v0[3]); w.z = cvtpk(v1[0], v1[1]); w.w = cvtpk(v1[2], v1[3]);
                        *(v4u*)(KI + (size_t)(row0 + ai * 128 + m * 16) * 64 + wc * 32 + 8 * fq) = w; } }
            else if (wc == 2) { float* SM = (float*)(ws + WS_SMALL);
#pragma unroll
                for (int ai = 0; ai < 2; ++ai)
#pragma unroll
                    for (int m = 0; m < 4; ++m) { float* p = SM + (size_t)(row0 + ai * 128 + m * 16) * 32 + 8 * fq;
                        *(f32x4*)p = acc[ai][0][m][0]; *(f32x4*)(p + 4) = acc[ai][0][m][1]; } }
        }
    }
};

constexpr int IDX_ROWB = 8192 + 16, IDX_HIST_OFF = 16 * IDX_ROWB  ;
static_assert(IDX_HIST_OFF + 16 * 1024 <= LDSCTL_OFF, "indexer LDS map");
__device__ __forceinline__ unsigned quant16(float f) {
    const float a = fminf(fabsf(f), 127.f);
    const unsigned code = (__builtin_bit_cast(unsigned, a + 0.00390625f) - 0x3B800000u) >> 12;
    return (f >= 0.f) ? (0x8000u | code) : (0x7FFFu - code);
}
#define WSYNC() do { asm volatile("s_waitcnt lgkmcnt(0)" ::: "memory"); __builtin_amdgcn_wave_barrier(); } while (0)
__device__ __forceinline__ void radix_scan(LAS unsigned* hist, int lane, unsigned need, unsigned& bin, unsigned& cgt) {
    const v4u hv = *(LAS v4u*)(hist + 4 * lane); const unsigned s = hv.x + hv.y + hv.z + hv.w;
    unsigned suf = s;
#pragma unroll
    for (int o = 1; o < 64; o <<= 1) { const unsigned t = __shfl_down(suf, o); if (lane + o < 64) suf += t; }
    const u64 bal = __ballot(suf >= need); const int L = bal ? 63 - __builtin_clzll(bal) : 0;
    const unsigned above = suf - s, c3 = above + hv.w, c2 = c3 + hv.z, c1 = c2 + hv.y;
    unsigned bsel, cg;
    if (c3 >= need) { bsel = 3; cg = above; } else if (c2 >= need) { bsel = 2; cg = c3; } else if (c1 >= need) { bsel = 1; cg = c2; } else { bsel = 0; cg = c1; }
    bin = __shfl(4 * lane + bsel, L); cgt = __shfl(cg, L);
}
__device__ __forceinline__ void p3_indexer(const Ctx& F) {
    const bf16* QI = (const bf16*)(F.ws + WS_QI); const bf16* KI = (const bf16*)(F.ws + WS_KI); const float* SM = (const float*)(F.ws + WS_SMALL);
    u64* MASKT = (u64*)(F.ws + WS_MASK);
    const int lane = F.lane, l15 = lane & 15, g = lane >> 4;
    for (int it = F.bid; it < 1024; it += F.G) {
        int lz = 0; asm volatile("" : "+v"(lz));
        LAS unsigned char* L = F.lds + lz;
        LAS unsigned* histq = (LAS unsigned*)(L + IDX_HIST_OFF);
        const int r = it >> 8, cc = it & 255, b = r, u = (r & 1) ? 255 - cc : cc;
        const int q0 = 16 * u, nvis = ((q0 >> 6) + 1) * 64, ntile = nvis >> 6; const size_t tb = (size_t)b * T;
        if (nvis <= 256) {
            for (int idx = F.tid; idx < 1024; idx += 512) *(LAS u64*)(histq + (idx >> 6) * 256 + 2 * (idx & 63)) = ((idx & 63) < ntile) ? ~0ull : 0ull;
        } else {
            for (int idx = F.tid; idx < 1024; idx += 512) *(LAS v4u*)(histq + 4 * idx) = (v4u){0u, 0u, 0u, 0u};
            bf16x8 bq[8][2]; float wq[8];
            { const bf16* qp = QI + (tb + q0 + l15) * 512 + 8 * g; const float* wp = SM + (tb + q0 + l15) * 32;
#pragma unroll
              for (int h = 0; h < 8; ++h) { bq[h][0] = *(const bf16x8*)(qp + h * 64); bq[h][1] = *(const bf16x8*)(qp + h * 64 + 32); wq[h] = wp[h] * 0.35355339059327373f; } }
            __syncthreads();
            LAS unsigned* hq = histq + l15 * 256;
            const int ntl = nvis >> 4;
            for (int j0 = F.wave; j0 < ntl; j0 += 32) {
                bf16x8 ka[4][2];
#pragma unroll
                for (int u4 = 0; u4 < 4; ++u4) { const int j = (j0 + 8 * u4 < ntl) ? j0 + 8 * u4 : j0; const bf16* kp = KI + (tb + 16 * j + l15) * 64 + 8 * g;
                    ka[u4][0] = *(const bf16x8*)kp; ka[u4][1] = *(const bf16x8*)(kp + 32); }
#pragma unroll
                for (int u4 = 0; u4 < 4; ++u4) { const int j = j0 + 8 * u4;
                    if (j < ntl) { const int key0 = 16 * j;
                        float s0 = 0.f, s1 = 0.f, s2 = 0.f, s3 = 0.f;
#pragma unroll
                        for (int h = 0; h < 8; ++h) { f32x4 c = {0.f, 0.f, 0.f, 0.f};
                            c = __builtin_amdgcn_mfma_f32_16x16x32_bf16(ka[u4][0], bq[h][0], c, 0, 0, 0); c = __builtin_amdgcn_mfma_f32_16x16x32_bf16(ka[u4][1], bq[h][1], c, 0, 0, 0);
                            s0 = fmaf(wq[h], fmaxf(c[0], 0.f), s0); s1 = fmaf(wq[h], fmaxf(c[1], 0.f), s1); s2 = fmaf(wq[h], fmaxf(c[2], 0.f), s2); s3 = fmaf(wq[h], fmaxf(c[3], 0.f), s3); }
                        const unsigned c0 = quant16(s0), c1 = quant16(s1), c2 = quant16(s2), c3 = quant16(s3);
                        v2u w; w.x = c0 | (c1 << 16); w.y = c2 | (c3 << 16);
                        *(LAS v2u*)(L + l15 * IDX_ROWB + (key0 + 4 * g) * 2) = w;
                        __hip_atomic_fetch_add(hq + (c0 >> 8), 1u, __ATOMIC_RELAXED, __HIP_MEMORY_SCOPE_WORKGROUP); __hip_atomic_fetch_add(hq + (c1 >> 8), 1u, __ATOMIC_RELAXED, __HIP_MEMORY_SCOPE_WORKGROUP);
                        __hip_atomic_fetch_add(hq + (c2 >> 8), 1u, __ATOMIC_RELAXED, __HIP_MEMORY_SCOPE_WORKGROUP); __hip_atomic_fetch_add(hq + (c3 >> 8), 1u, __ATOMIC_RELAXED, __HIP_MEMORY_SCOPE_WORKGROUP); } }
            }
            __syncthreads();
            const int nblk = (ntile + 7) >> 3;
            for (int qq = 0; qq < 2; ++qq) {
                const int q = 2 * F.wave + qq; LAS unsigned char* rowp = L + q * IDX_ROWB; LAS unsigned* hist = histq + q * 256;
                unsigned b1, cgt1; radix_scan(hist, lane, 256u, b1, cgt1); WSYNC();
                const unsigned r1 = 256u - cgt1;
                *(LAS v4u*)(hist + 4 * lane) = (v4u){0u, 0u, 0u, 0u}; WSYNC();
                for (int i = 0; i < nblk; ++i) {
                    const v4u v = *(LAS v4u*)(rowp + (i * 512 + 8 * lane) * 2); const int kbase = i * 512 + 8 * lane;
#define LVL2(W, KO) { if (kbase + (KO) < nvis) { if ((((W) >> 8) & 255u) == b1) __hip_atomic_fetch_add(hist + ((W) & 255u), 1u, __ATOMIC_RELAXED, __HIP_MEMORY_SCOPE_WORKGROUP); \
                                                   if (((W) >> 24) == b1) __hip_atomic_fetch_add(hist + (((W) >> 16) & 255u), 1u, __ATOMIC_RELAXED, __HIP_MEMORY_SCOPE_WORKGROUP); } }
                    LVL2(v.x, 0) LVL2(v.y, 2) LVL2(v.z, 4) LVL2(v.w, 6)
#undef LVL2
                }
                WSYNC();
                unsigned b2, cgt2; radix_scan(hist, lane, r1, b2, cgt2); WSYNC();
                const unsigned thr = (b1 << 8) | b2, rr = r1 - cgt2;
                unsigned eqrun = 0u; u64 mword = 0ull;
                for (int i = 0; i < nblk; ++i) {
                    unsigned code[8];
#pragma unroll
                    for (int j = 0; j < 8; ++j) code[j] = *(LAS unsigned short*)(rowp + ((8 * i + j) * 64 + lane) * 2);
#pragma unroll
                    for (int j = 0; j < 8; ++j) { const int t = 8 * i + j;
                        if (t < ntile) { u64 m = __ballot(code[j] > thr); const u64 em = __ballot(code[j] == thr);
                            if (em) { const unsigned pre = __builtin_amdgcn_mbcnt_hi((unsigned)(em >> 32), __builtin_amdgcn_mbcnt_lo((unsigned)em, 0u));
                                m |= __ballot(code[j] == thr && (eqrun + pre) < rr); eqrun += (unsigned)__popcll(em); }
                            if (lane == t) mword = m; } }
                }
                WSYNC(); *(LAS u64*)(hist + 2 * lane) = mword;
            }
        }
        __syncthreads();
        for (int idx = F.tid; idx < 1024; idx += 512) { const int t = idx >> 4, q = idx & 15; MASKT[((size_t)b * 64 + t) * T + q0 + q] = *(LAS u64*)(histq + q * 256 + 2 * t); }
        __syncthreads();
    }
}

typedef short v4i16_t __attribute__((ext_vector_type(4)));
__device__ __forceinline__ s16x4 trrd(const LAS unsigned char* p) { return __builtin_bit_cast(s16x4, __builtin_amdgcn_ds_read_tr16_b64_v4i16((LAS v4i16_t*)p)); }
__device__ __forceinline__ bf16x8 cat8(s16x4 lo, s16x4 hi) { return (bf16x8){lo[0], lo[1], lo[2], lo[3], hi[0], hi[1], hi[2], hi[3]}; }
constexpr int G1_LR = 0, G1_TOT = 4096, G1_KD = 8192, G1_KDP = 272, G1_V = G1_KD + 64 * G1_KDP, G1_VP = 528;
__device__ __forceinline__ void p3_gla1(const Ctx& F, const float* w_gate_lr, const float* b_gate) {
    const bf16* QB = (const bf16*)(F.ws + WS_QB); const bf16* KB = (const bf16*)(F.ws + WS_KB); bf16* QE = (bf16*)(F.ws + WS_QE); bf16* KE = (bf16*)(F.ws + WS_KE);
    const bf16* VB = (const bf16*)(F.ws + WS_VB); const float* SM = (const float*)(F.ws + WS_SMALL);
    float* KVC = (float*)(F.ws + WS_KVC); float* DEC = (float*)(F.ws + WS_DEC);
    const int d = F.tid & 127, tq = F.tid >> 7, lane = F.lane, l15 = lane & 15, g = lane >> 4, q4 = l15 >> 2, p4 = lane & 3;
    LAS float* lrs = (LAS float*)(F.lds + G1_LR); LAS float* tot = (LAS float*)(F.lds + G1_TOT);
    for (int it = F.bid; it < 1024; it += F.G) {
        const int bh = it >> 6, c = it & 63, b = bh >> 2, h = bh & 3; const size_t tok0 = (size_t)b * T + 64 * c;
        for (int idx = F.tid; idx < 1024; idx += 512) lrs[idx] = SM[(tok0 + (idx >> 4)) * 32 + 8 + (idx & 15)];
        for (int idx = F.tid; idx < 2048; idx += 512) { const int t = idx >> 5, p = idx & 31; *(LAS v4u*)(F.lds + G1_V + t * G1_VP + 16 * p) = *(const v4u*)(VB + (tok0 + t) * 1024 + h * 256 + 8 * p); }
        float wg[16];
#pragma unroll
        for (int r = 0; r < 16; ++r) wg[r] = w_gate_lr[r * 512 + h * 128 + d];
        const float bg = b_gate[h * 128 + d];
        __syncthreads();
        float Gl[16]; float run = 0.f;
#pragma unroll
        for (int i = 0; i < 16; ++i) { const int t = 16 * tq + i; float z = bg;
#pragma unroll
            for (int r4 = 0; r4 < 4; ++r4) { const f32x4 l = *(LAS f32x4*)(lrs + t * 16 + 4 * r4); z = fmaf(l.x, wg[4 * r4], z); z = fmaf(l.y, wg[4 * r4 + 1], z); z = fmaf(l.z, wg[4 * r4 + 2], z); z = fmaf(l.w, wg[4 * r4 + 3], z); }
            const float la = (fminf(z, 0.f) - log1pf(__expf(-fabsf(z)))) * 0.0625f; run += la; Gl[i] = run; }
        tot[tq * 128 + d] = run;
        __syncthreads();
        float offs = 0.f, glast = 0.f;
#pragma unroll
        for (int qd = 0; qd < 4; ++qd) { const float v = tot[qd * 128 + d]; if (qd < tq) offs += v; glast += v; }
#pragma unroll
        for (int i = 0; i < 16; ++i) { const int t = 16 * tq + i; const float G = Gl[i] + offs; const size_t o = (tok0 + t) * 512 + h * 128 + d;
            const float q = bf2f(QB[o]), k = bf2f(KB[o]);
            QE[o] = (bf16)f2bf(q * __expf(G)); KE[o] = (bf16)f2bf(k * __expf(-G));
            *(LAS unsigned short*)(F.lds + G1_KD + t * G1_KDP + d * 2) = (unsigned short)f2bf(k * __expf(glast - G)); }
        if (tq == 0) DEC[(size_t)(bh * 64 + c) * 128 + d] = __expf(glast);
        __syncthreads();
        const int m0 = 16 * F.wave; bf16x8 a[2];
#pragma unroll
        for (int s = 0; s < 2; ++s) { const LAS unsigned char* ap = F.lds + G1_KD + (32 * s + 8 * g + q4) * G1_KDP + (m0 + 4 * p4) * 2; a[s] = cat8(trrd(ap), trrd(ap + 4 * G1_KDP)); }
        float* out = KVC + (size_t)(bh * 64 + c) * 256 * 128;
#pragma unroll 4
        for (int nt = 0; nt < 16; ++nt) { f32x4 acc = {0.f, 0.f, 0.f, 0.f};
#pragma unroll
            for (int s = 0; s < 2; ++s) { const LAS unsigned char* bp = F.lds + G1_V + (32 * s + 8 * g + q4) * G1_VP + (16 * nt + 4 * p4) * 2; const bf16x8 bv = cat8(trrd(bp), trrd(bp + 4 * G1_VP));
                acc = __builtin_amdgcn_mfma_f32_16x16x32_bf16(a[s], bv, acc, 0, 0, 0); }
            *(f32x4*)(out + (size_t)(16 * nt + l15) * 128 + m0 + 4 * g) = acc; }
        __syncthreads();
    }
}
__device__ __forceinline__ void p4_scan(const Ctx& F) {
    const float* KVC = (const float*)(F.ws + WS_KVC); const float* DEC = (const float*)(F.ws + WS_DEC); bf16* SC = (bf16*)(F.ws + WS_SC);
    for (int e = F.bid * 512 + F.tid; e < 16 * 256 * 32; e += F.G * 512) {
        const int d4 = e & 31, v = (e >> 5) & 255, bh = e >> 13; f32x4 S = {0.f, 0.f, 0.f, 0.f};
#pragma unroll 8
        for (int c = 0; c < 64; ++c) { const size_t o = ((size_t)(bh * 64 + c) * 256 + v) * 128 + 4 * d4;
            const f32x4 kv = *(const f32x4*)(KVC + o), dc = *(const f32x4*)(DEC + (size_t)(bh * 64 + c) * 128 + 4 * d4);
            v2u w; w.x = pk2(S.x, S.y); w.y = pk2(S.z, S.w); *(v2u*)(SC + o) = w;
            S = S * dc + kv; }
    }
}
constexpr int G3_QE = 0, G3_KE = 17408, G3_V = 34816, G3_AM = 68608, G3_AMP = 144, G3_SS = 77824;
__device__ __forceinline__ void p5_gla3(const Ctx& F, const float* gnorm_g) {
    const bf16* QB = (const bf16*)(F.ws + WS_QE); const bf16* KB = (const bf16*)(F.ws + WS_KE); const bf16* VB = (const bf16*)(F.ws + WS_VB); const bf16* GB = (const bf16*)(F.ws + WS_GB);
    const bf16* SC = (const bf16*)(F.ws + WS_SC); bf16* YB = (bf16*)(F.ws + WS_YB);
    const int lane = F.lane, l15 = lane & 15, g = lane >> 4, q4 = l15 >> 2, p4 = lane & 3, w = F.wave;
    LAS float* SS = (LAS float*)(F.lds + G3_SS);
    for (int it = F.bid; it < 1024; it += F.G) {
        const int bh = it >> 6, c = it & 63, b = bh >> 2, h = bh & 3; const size_t tok0 = (size_t)b * T + 64 * c;
        for (int idx = F.tid; idx < 1024; idx += 512) { const int t = idx >> 4, p = idx & 15; const size_t o = (tok0 + t) * 512 + h * 128 + 8 * p;
            *(LAS v4u*)(F.lds + G3_QE + t * 272 + 16 * p) = *(const v4u*)(QB + o); *(LAS v4u*)(F.lds + G3_KE + t * 272 + 16 * p) = *(const v4u*)(KB + o); }
        for (int idx = F.tid; idx < 2048; idx += 512) { const int t = idx >> 5, p = idx & 31; *(LAS v4u*)(F.lds + G3_V + t * G1_VP + 16 * p) = *(const v4u*)(VB + (tok0 + t) * 1024 + h * 256 + 8 * p); }
        bf16x8 bS[2][4];
#pragma unroll
        for (int n = 0; n < 2; ++n)
#pragma unroll
            for (int s = 0; s < 4; ++s) bS[n][s] = *(const bf16x8*)(SC + ((size_t)(bh * 64 + c) * 256 + 32 * w + 16 * n + l15) * 128 + 32 * s + 8 * g);
        __syncthreads();
        { const int mi = w >> 1, mj0 = 2 * (w & 1);
#pragma unroll
          for (int jj = 0; jj < 2; ++jj) { const int mj = mj0 + jj; f32x4 c4 = {0.f, 0.f, 0.f, 0.f};
              if (mj <= mi) {
#pragma unroll
                  for (int s = 0; s < 4; ++s) { const bf16x8 av = *(LAS bf16x8*)(F.lds + G3_QE + (16 * mi + l15) * 272 + (32 * s + 8 * g) * 2), bv = *(LAS bf16x8*)(F.lds + G3_KE + (16 * mj + l15) * 272 + (32 * s + 8 * g) * 2);
                      c4 = __builtin_amdgcn_mfma_f32_16x16x32_bf16(av, bv, c4, 0, 0, 0); } }
#pragma unroll
              for (int r = 0; r < 4; ++r) { const int i = 16 * mi + 4 * g + r, j = 16 * mj + l15; *(LAS unsigned short*)(F.lds + G3_AM + i * G3_AMP + j * 2) = (unsigned short)f2bf(j <= i ? c4[r] : 0.f); } } }
        __syncthreads();
        f32x4 acc[4][2];
#pragma unroll
        for (int m = 0; m < 4; ++m) { acc[m][0] = (f32x4){0.f, 0.f, 0.f, 0.f}; acc[m][1] = (f32x4){0.f, 0.f, 0.f, 0.f}; }
#pragma unroll
        for (int s = 0; s < 4; ++s)
#pragma unroll
            for (int m = 0; m < 4; ++m) { const bf16x8 av = *(LAS bf16x8*)(F.lds + G3_QE + (16 * m + l15) * 272 + (32 * s + 8 * g) * 2);
                acc[m][0] = __builtin_amdgcn_mfma_f32_16x16x32_bf16(av, bS[0][s], acc[m][0], 0, 0, 0); acc[m][1] = __builtin_amdgcn_mfma_f32_16x16x32_bf16(av, bS[1][s], acc[m][1], 0, 0, 0); }
#pragma unroll
        for (int s = 0; s < 2; ++s)
#pragma unroll
            for (int n = 0; n < 2; ++n) { const LAS unsigned char* bp = F.lds + G3_V + (32 * s + 8 * g + q4) * G1_VP + (32 * w + 16 * n + 4 * p4) * 2; const bf16x8 bv = cat8(trrd(bp), trrd(bp + 4 * G1_VP));
#pragma unroll
                for (int m = 0; m < 4; ++m) { const bf16x8 av = *(LAS bf16x8*)(F.lds + G3_AM + (16 * m + l15) * G3_AMP + (32 * s + 8 * g) * 2); acc[m][n] = __builtin_amdgcn_mfma_f32_16x16x32_bf16(av, bv, acc[m][n], 0, 0, 0); } }
#pragma unroll
        for (int m = 0; m < 4; ++m)
#pragma unroll
            for (int r = 0; r < 4; ++r) { float ss = acc[m][0][r] * acc[m][0][r] + acc[m][1][r] * acc[m][1][r];
                ss += __shfl_xor(ss, 1); ss += __shfl_xor(ss, 2); ss += __shfl_xor(ss, 4); ss += __shfl_xor(ss, 8);
                if (l15 == 0) SS[(16 * m + 4 * g + r) * 8 + w] = ss; }
        __syncthreads();
#pragma unroll
        for (int m = 0; m < 4; ++m)
#pragma unroll
            for (int r = 0; r < 4; ++r) { const int row = 16 * m + 4 * g + r; const f32x4 s0 = *(LAS f32x4*)(SS + row * 8), s1 = *(LAS f32x4*)(SS + row * 8 + 4);
                const float rstd = 1.f / sqrtf(((s0.x + s0.y) + (s0.z + s0.w) + (s1.x + s1.y) + (s1.z + s1.w)) * (1.f / 256.f) + EPS);
#pragma unroll
                for (int n = 0; n < 2; ++n) { const int v = 32 * w + 16 * n + l15; const size_t o = (tok0 + row) * 1024 + h * 256 + v;
                    const float gt = bf2f(GB[o]); YB[o] = (bf16)f2bf(acc[m][n][r] * rstd * gnorm_g[v] * (gt * sigmoidf_(gt))); } }
        __syncthreads();
    }
}

namespace att {
constexpr int SHM_K = 16384, SHM_V = 16384, PITCH = 1024;
constexpr float THR = 8.f;
#define KSWZ(row, colB) ((row) * 256 + ((colB) ^ (((row) & 7) << 4)))
__device__ __forceinline__ int v_st(int k, int c) { const int kk = (k & ~0xC) | ((k & 4) << 1) | ((k & 8) >> 1); return ((kk >> 3) * 4 + (c >> 5)) * 512 + ((kk & 7) * 32 + (c & 31)) * 2; }
__device__ __forceinline__ int v_rd_base(int lane) { return ((lane & 3) << 3) | (((lane >> 2) & 3) << 6) | (((lane >> 4) & 1) << 5) | (((lane >> 5) & 1) << 8); }
constexpr int v_rd_off(int d0, int ks, int half) { return d0 * 512 + ks * 4096 + half * 2048; }
__device__ __forceinline__ int crow(int r, int hi) { return (r & 3) + 8 * (r >> 2) + 4 * hi; }
__device__ __forceinline__ void mask_bits(f32x16& p0, f32x16& p1, unsigned lo, unsigned hi32) {
    const float NEG = -__builtin_inff();
#pragma unroll
    for (int r = 0; r < 16; ++r) { const int c = (r & 3) + 8 * (r >> 2);
        if (!((lo >> c) & 1u)) p0[r] = NEG;
        if (!((hi32 >> c) & 1u)) p1[r] = NEG; }
}
__device__ __forceinline__ void partialSM(f32x16& p0, f32x16& p1, float& m_reg, float& mn, float& alpha) {
    float pmax = p0[0];
#pragma unroll
    for (int r = 1; r < 16; ++r) pmax = fmaxf(pmax, p0[r]);
#pragma unroll
    for (int r = 0; r < 16; ++r) pmax = fmaxf(pmax, p1[r]);
    { auto rr = __builtin_amdgcn_permlane32_swap(__float_as_uint(pmax), __float_as_uint(pmax), false, false);
      pmax = fmaxf(__uint_as_float(rr[0]), __uint_as_float(rr[1])); }
    if (__builtin_expect(__all((pmax - m_reg) <= THR), 1)) { mn = m_reg; alpha = 1.f; }
    else { mn = fmaxf(m_reg, pmax); alpha = __builtin_amdgcn_exp2f(m_reg - mn); m_reg = mn; }
#pragma unroll
    for (int r = 0; r < 16; ++r) p0[r] = __builtin_amdgcn_exp2f(p0[r] - mn);
#pragma unroll
    for (int r = 0; r < 16; ++r) p1[r] = __builtin_amdgcn_exp2f(p1[r] - mn);
}
__device__ __forceinline__ void finishSM(f32x16& p0, f32x16& p1, float alpha, float& l_reg, bf16x8& pa0, bf16x8& pa1, bf16x8& pa2, bf16x8& pa3) {
    float ps = 0.f;
#pragma unroll
    for (int r = 0; r < 16; ++r) ps += p0[r];
#pragma unroll
    for (int r = 0; r < 16; ++r) ps += p1[r];
    { auto rr = __builtin_amdgcn_permlane32_swap(__float_as_uint(ps), __float_as_uint(ps), false, false);
      ps = __uint_as_float(rr[0]) + __uint_as_float(rr[1]); }
    l_reg = l_reg * alpha + ps;
#define PK4(P, B_, OUT) do { unsigned a0 = cvtpk(P[B_+0], P[B_+1]), a1 = cvtpk(P[B_+2], P[B_+3]);                          \
        unsigned b0 = cvtpk(P[B_+4], P[B_+5]), b1 = cvtpk(P[B_+6], P[B_+7]);                                             \
        auto r0 = __builtin_amdgcn_permlane32_swap(a0, b0, false, false); auto r1 = __builtin_amdgcn_permlane32_swap(a1, b1, false, false); \
        v4u w_ = {r0[0], r1[0], r0[1], r1[1]}; OUT = __builtin_bit_cast(bf16x8, w_); } while (0)
    PK4(p0, 0, pa0); PK4(p0, 8, pa1); PK4(p1, 0, pa2); PK4(p1, 8, pa3);
#undef PK4
}
template <int KB>
__device__ __forceinline__ void qkt(f32x16& p0, f32x16& p1, const LAS unsigned char* K_lds, int r32, int hi, const bf16x8* qr) {
    p0 = f32x16{}; p1 = f32x16{};
    const LAS unsigned char* kb[4];
#pragma unroll
    for (int dd = 0; dd < 4; ++dd) kb[dd] = K_lds + KB * SHM_K + KSWZ(r32, (dd * 16 + hi * 8) * 2);
#pragma unroll
    for (int d0 = 0; d0 < 8; ++d0) { const LAS unsigned char* a = kb[d0 & 3] + (d0 >> 2) * 128;
        const bf16x8 b0 = *(const LAS bf16x8*)a, b1 = *(const LAS bf16x8*)(a + 32 * 256);
        p0 = __builtin_amdgcn_mfma_f32_32x32x16_bf16(b0, qr[d0], p0, 0, 0, 0);
        p1 = __builtin_amdgcn_mfma_f32_32x32x16_bf16(b1, qr[d0], p1, 0, 0, 0); }
}
template <int VB>
__device__ __forceinline__ void pv_tile(f32x16* o, int vb0, bf16x8 pa0, bf16x8 pa1, bf16x8 pa2, bf16x8 pa3) {
#define TRRD(dst, off) asm volatile("ds_read_b64_tr_b16 %0, %1 offset:%2" : "=&v"(dst) : "v"(vb0), "i"(off) : "memory")
#define PV_D0(d0) do { s16x4 l0, l1, l2, l3, h0, h1, h2, h3; constexpr int b_ = VB * SHM_V + v_rd_off(d0, 0, 0); \
        TRRD(l0, b_); TRRD(h0, b_ + 2048); TRRD(l1, b_ + 4096); TRRD(h1, b_ + 6144); TRRD(l2, b_ + 8192); TRRD(h2, b_ + 10240); TRRD(l3, b_ + 12288); TRRD(h3, b_ + 14336); \
        asm volatile("s_waitcnt lgkmcnt(0)" ::: "memory"); SBAR(); \
        o[d0] = __builtin_amdgcn_mfma_f32_32x32x16_bf16(pa0, (bf16x8){l0[0], l0[1], l0[2], l0[3], h0[0], h0[1], h0[2], h0[3]}, o[d0], 0, 0, 0);   \
        o[d0] = __builtin_amdgcn_mfma_f32_32x32x16_bf16(pa1, (bf16x8){l1[0], l1[1], l1[2], l1[3], h1[0], h1[1], h1[2], h1[3]}, o[d0], 0, 0, 0);   \
        o[d0] = __builtin_amdgcn_mfma_f32_32x32x16_bf16(pa2, (bf16x8){l2[0], l2[1], l2[2], l2[3], h2[0], h2[1], h2[2], h2[3]}, o[d0], 0, 0, 0);   \
        o[d0] = __builtin_amdgcn_mfma_f32_32x32x16_bf16(pa3, (bf16x8){l3[0], l3[1], l3[2], l3[3], h3[0], h3[1], h3[2], h3[3]}, o[d0], 0, 0, 0); } while (0)
    PV_D0(0); PV_D0(1); PV_D0(2); PV_D0(3);
#undef PV_D0
#undef TRRD
}
__device__ __forceinline__ void unit(const Ctx& F, int b, int h, int qb) {
    const bf16* Q = (const bf16*)(F.ws + WS_QA); const bf16* K = (const bf16*)(F.ws + WS_KA); const bf16* V = (const bf16*)(F.ws + WS_VA); bf16* O = (bf16*)(F.ws + WS_YA);
    const u64* MASKT = (const u64*)(F.ws + WS_MASK);
    const int tid = F.tid, wid = F.wave, lane = F.lane, r32 = lane & 31, hi = lane >> 5;
    LAS unsigned char* V_lds = F.lds; LAS unsigned char* K_lds = F.lds + 2 * SHM_V;
    LAS float* wsf = (LAS float*)(F.lds + 2 * SHM_V + 2 * SHM_K) + wid * 64; LAS float* li_l = wsf; LAS float* al_l = wsf + 32;
    const size_t tb = (size_t)b * T; const int NT = 4 * (qb + 1);
    const int sr = tid >> 4, sc = (tid & 15) * 8, vst0 = v_st(sr, sc), vst1 = v_st(32 + sr, sc), kws = KSWZ(sr, sc * 2);
    const int vb0 = (int)(uintptr_t)V_lds + v_rd_base(lane);
    const unsigned kvo = (unsigned)((tb + sr) * PITCH + h * 128 + sc);
    const int qrow = qb * 256 + wid * 32 + r32;
    bf16x8 qr[8];
    { const unsigned qo = (unsigned)((tb + qrow) * PITCH + h * 128 + hi * 8);
#pragma unroll
      for (int d0 = 0; d0 < 8; ++d0) qr[d0] = *(const bf16x8*)(Q + qo + d0 * 16); }
    const unsigned mo = (unsigned)(b * 64 * T + qrow);
    float m_reg = -1e30f, l_reg = 0.f; f32x16 o[4] = {};
    bf16x8 st_k0, st_k1, st_v0, st_v1;
#define SLOAD(t) do { const unsigned r0_ = kvo + (unsigned)((t) * 64 * PITCH); st_k0 = *(const bf16x8*)(K + r0_); st_k1 = *(const bf16x8*)(K + r0_ + 32 * PITCH); st_v0 = *(const bf16x8*)(V + r0_); st_v1 = *(const bf16x8*)(V + r0_ + 32 * PITCH); } while (0)
#define SWRITE(bf) do { *(LAS bf16x8*)(K_lds + (bf) * SHM_K + kws) = st_k0; *(LAS bf16x8*)(K_lds + (bf) * SHM_K + kws + 32 * 256) = st_k1; \
                        *(LAS bf16x8*)(V_lds + (bf) * SHM_V + vst0) = st_v0; *(LAS bf16x8*)(V_lds + (bf) * SHM_V + vst1) = st_v1; } while (0)
#define STEP(t, BUF) do { \
        if ((t) + 1 < NT) SLOAD((t) + 1); \
        const u64 mwd = MASKT[mo + (unsigned)((t) * T)]; \
        f32x16 p0, p1; float mn, alpha; bf16x8 pa0, pa1, pa2, pa3; \
        SBAR(); qkt<BUF>(p0, p1, K_lds, r32, hi, qr); \
        mask_bits(p0, p1, (unsigned)mwd >> (4 * hi), (unsigned)(mwd >> 32) >> (4 * hi)); \
        partialSM(p0, p1, m_reg, mn, alpha); finishSM(p0, p1, alpha, l_reg, pa0, pa1, pa2, pa3); \
        if (__any(alpha < 1.f)) { if (hi == 0) al_l[r32] = alpha; LDS_WAIT(); \
            _Pragma("unroll") for (int d_ = 0; d_ < 4; ++d_) _Pragma("unroll") for (int r = 0; r < 16; ++r) o[d_][r] *= al_l[crow(r, hi)]; } \
        SBAR(); pv_tile<BUF>(o, vb0, pa0, pa1, pa2, pa3); \
        if ((t) + 1 < NT) { VM_WAIT(); SWRITE(1 - (BUF)); } \
        __syncthreads(); } while (0)
    SLOAD(0); VM_WAIT(); SWRITE(0); __syncthreads();
    for (int t = 0; t < NT; t += 2) { STEP(t, 0); STEP(t + 1, 1); }
#undef STEP
#undef SLOAD
#undef SWRITE
    if (hi == 0) li_l[r32] = l_reg; LDS_WAIT();
    const unsigned oo = (unsigned)((tb + qb * 256 + wid * 32) * PITCH + h * 128 + r32);
#pragma unroll
    for (int r = 0; r < 16; ++r) { const int orow = crow(r, hi); const float rl = __builtin_amdgcn_rcpf(li_l[orow]);
#pragma unroll
        for (int d0 = 0; d0 < 4; ++d0) { const float v = o[d0][r] * rl; const float vn = __shfl_xor(v, 1);
            if ((r32 & 1) == 0) *(unsigned*)(O + oo + (unsigned)(orow * PITCH + d0 * 32)) = cvtpk(v, vn); } }
    __syncthreads();
}
}
__device__ __forceinline__ void p4_attention(const Ctx& F) {
    for (int it = F.bid; it < 256; it += F.G) { const int bh = it >> 3, p = it & 7;
        att::unit(F, bh >> 3, bh & 7, 15 - p); att::unit(F, bh >> 3, bh & 7, p); }
}

struct BranchOrder : pg8::StaticOrder {
    int aoff1, boff1;
    __device__ __forceinline__ bool next(int i, pg8::Unit& u) const { if (!pg8::StaticOrder::next(i >> 1, u)) return false; u.kind = i & 1; u.aoff = (i & 1) ? aoff1 : 0; u.boff = (i & 1) ? boff1 : 0; return true; }
};
struct EpiBr {
    static constexpr bool PERM = false, AFTER_DRAIN = false;
    const bf16* GA; const bf16* GBM; float* TMP; bf16* OUT;
    __device__ __forceinline__ void operator()(const pg8::f32x4 (&acc)[2][2][4][2], const pg8::Unit& u, int wr, int wc, int fr, int fq) const {
        const int row0 = u.pm * 256 + wr * 64 + fr, col0 = u.pn * 256 + wc * 32 + 4 * fq; const bf16* G = u.kind ? GBM : GA;
#pragma unroll
        for (int ai = 0; ai < 2; ++ai)
#pragma unroll
            for (int m = 0; m < 4; ++m) { const size_t ro = (size_t)(row0 + ai * 128 + m * 16) * 1024 + col0;
#pragma unroll
                for (int bj = 0; bj < 2; ++bj)
#pragma unroll
                    for (int n = 0; n < 2; ++n) { const size_t o = ro + bj * 128 + n * 16; const v2u gw = *(const v2u*)(G + o); const pg8::f32x4 a = acc[ai][bj][m][n];
                        pg8::f32x4 r; r[0] = a[0] * sigmoidf_(bflo(gw.x)); r[1] = a[1] * sigmoidf_(bfhi(gw.x)); r[2] = a[2] * sigmoidf_(bflo(gw.y)); r[3] = a[3] * sigmoidf_(bfhi(gw.y));
                        if (u.kind == 0) *(pg8::f32x4*)(TMP + o) = r;
                        else { const pg8::f32x4 t = *(const pg8::f32x4*)(TMP + o); v2u w; w.x = cvtpk(t[0] + r[0], t[1] + r[1]); w.y = cvtpk(t[2] + r[2], t[3] + r[3]); *(v2u*)(OUT + o) = w; } } }
    }
};
struct EpiOut {
    static constexpr bool PERM = false, AFTER_DRAIN = false;
    const float* X; const float* MOD; float* X1;
    __device__ __forceinline__ void operator()(const pg8::f32x4 (&acc)[2][2][4][2], const pg8::Unit& u, int wr, int wc, int fr, int fq) const {
        const int row0 = u.pm * 256 + wr * 64 + fr, col0 = u.pn * 256 + wc * 32 + 4 * fq; const float* gt = MOD + (u.pm * 256 / T) * 6144 + 2048;
        pg8::f32x4 gv[2][2];
#pragma unroll
        for (int bj = 0; bj < 2; ++bj)
#pragma unroll
            for (int n = 0; n < 2; ++n) gv[bj][n] = *(const pg8::f32x4*)(gt + col0 + bj * 128 + n * 16);
#pragma unroll
        for (int ai = 0; ai < 2; ++ai)
#pragma unroll
            for (int m = 0; m < 4; ++m) { const size_t ro = (size_t)(row0 + ai * 128 + m * 16) * 1024 + col0;
#pragma unroll
                for (int bj = 0; bj < 2; ++bj)
#pragma unroll
                    for (int n = 0; n < 2; ++n) { const size_t o = ro + bj * 128 + n * 16; *(pg8::f32x4*)(X1 + o) = *(const pg8::f32x4*)(X + o) + gv[bj][n] * acc[ai][bj][m][n]; } }
    }
};
constexpr int RW_PITCH = 36, R_CNT = 1024 * RW_PITCH * 4  , R_BASE = R_CNT + 128, R_LE = R_CNT + 256, R_LR = R_LE + 1024;
static_assert(R_LR + 1024 <= LDSCTL_OFF, "router LDS map");
__device__ __forceinline__ float wave_max(float v) {
#pragma unroll
    for (int o = 1; o < 64; o <<= 1) v = fmaxf(v, __shfl_xor(v, o));
    return v;
}
__device__ __forceinline__ void p8_router(const Ctx& F, const float* g2, const float* router_w, const float* router_b, int cnt_off = 0) {
    const float* X1 = (const float*)(F.ws + WS_X1); const float* mod = (const float*)(F.ws + WS_MOD); bf16* H2 = (bf16*)(F.ws + WS_H2);
    int* TOKE = (int*)(F.ws + WS_TOKE); int* TOKR = (int*)(F.ws + WS_TOKR); float* TOKW = (float*)(F.ws + WS_TOKW); unsigned* gcnt = (unsigned*)(F.ws + WS_CTL) + CW_ECNT + cnt_off;
    LAS float* rw = (LAS float*)F.lds; LAS unsigned* lcnt = (LAS unsigned*)(F.lds + R_CNT); LAS unsigned* lbase = (LAS unsigned*)(F.lds + R_BASE);
    LAS int* le = (LAS int*)(F.lds + R_LE); LAS int* lrk = (LAS int*)(F.lds + R_LR);
    const int lane = F.lane;
    for (int i = F.tid; i < 8192; i += 512) { const int k = i >> 3, c4 = i & 7; *(LAS f32x4*)(rw + k * RW_PITCH + 4 * c4) = *(const f32x4*)(router_w + k * 32 + 4 * c4); }
    if (F.tid < 32) lcnt[F.tid] = 0u;
    __syncthreads();
    const float rb = router_b[(lane >> 1) & 31];
    for (int it = F.bid; it < NTOK / 64; it += F.G) {
        const int b = (it * 64) / T; const float* mb = mod + b * 6144;
        float ga[16], sh[16];
#pragma unroll
        for (int jj = 0; jj < 16; ++jj) { const int k = lane + 64 * jj; ga[jj] = g2[k] * (1.f + mb[4096 + k]); sh[jj] = mb[3072 + k]; }
        for (int tt = 0; tt < 8; ++tt) { const int lt = F.wave * 8 + tt, m = it * 64 + lt;
            const float* xr = X1 + (size_t)m * D; float hv[16]; float ss = 0.f;
#pragma unroll
            for (int jj = 0; jj < 16; ++jj) { hv[jj] = xr[lane + 64 * jj]; ss = fmaf(hv[jj], hv[jj], ss); }
            const float rstd = 1.f / sqrtf(wave_sum(ss) * (1.f / D) + EPS);
            float pe[32];
#pragma unroll
            for (int e = 0; e < 32; ++e) pe[e] = 0.f;
#pragma unroll
            for (int jj = 0; jj < 16; ++jj) { const int k = lane + 64 * jj; const float h = hv[jj] * rstd * ga[jj] + sh[jj]; H2[(size_t)m * D + k] = (bf16)f2bf(h);
#pragma unroll
                for (int c4 = 0; c4 < 8; ++c4) { const f32x4 w = *(LAS f32x4*)(rw + k * RW_PITCH + 4 * c4);
                    pe[4 * c4] = fmaf(h, w.x, pe[4 * c4]); pe[4 * c4 + 1] = fmaf(h, w.y, pe[4 * c4 + 1]); pe[4 * c4 + 2] = fmaf(h, w.z, pe[4 * c4 + 2]); pe[4 * c4 + 3] = fmaf(h, w.w, pe[4 * c4 + 3]); } }
#define RSTEP(NH, BIT) _Pragma("unroll") for (int e = 0; e < NH; ++e) { const bool up = (lane & BIT) != 0; const float send = up ? pe[e] : pe[e + NH]; const float keep = up ? pe[e + NH] : pe[e]; pe[e] = keep + __shfl_xor(send, BIT); }
            RSTEP(16, 32) RSTEP(8, 16) RSTEP(4, 8) RSTEP(2, 4) RSTEP(1, 2)
#undef RSTEP
            float lg = pe[0] + __shfl_xor(pe[0], 1) + rb;
            int e0, e1, e2, e3; float v0, v1, v2, v3;
#define TOP1(EK, VK) { const float mx = wave_max(lg); const u64 bm = __ballot(lg == mx); const int L = __ffsll((long long)bm) - 1; EK = (L >> 1) & 31; VK = mx; if (((lane >> 1) & 31) == EK) lg = -__builtin_inff(); }
            TOP1(e0, v0) TOP1(e1, v1) TOP1(e2, v2) TOP1(e3, v3)
#undef TOP1
            const float x1_ = __expf(v1 - v0), x2_ = __expf(v2 - v0), x3_ = __expf(v3 - v0), inv = 1.f / (1.f + x1_ + x2_ + x3_);
            if (lane < 4) { const int ek = lane == 0 ? e0 : (lane == 1 ? e1 : (lane == 2 ? e2 : e3)); const float wk = (lane == 0 ? 1.f : (lane == 1 ? x1_ : (lane == 2 ? x2_ : x3_))) * inv;
                const unsigned rk = __hip_atomic_fetch_add(lcnt + ek, 1u, __ATOMIC_RELAXED, __HIP_MEMORY_SCOPE_WORKGROUP);
                TOKE[m * 4 + lane] = ek; TOKW[m * 4 + lane] = wk; le[lt * 4 + lane] = ek; lrk[lt * 4 + lane] = (int)rk; }
        }
        __syncthreads();
        if (F.tid < 32) { lbase[F.tid] = __hip_atomic_fetch_add(gcnt + 64 * F.tid, lcnt[F.tid], __ATOMIC_RELAXED, __HIP_MEMORY_SCOPE_AGENT); lcnt[F.tid] = 0u; }
        __syncthreads();
        if (F.tid < 256) TOKR[it * 256 + F.tid] = lrk[F.tid] + (int)lbase[le[F.tid]];
        __syncthreads();
    }
}
__device__ __forceinline__ void p9_scatter(const Ctx& F) {
    const unsigned* gcnt = (const unsigned*)(F.ws + WS_CTL) + CW_ECNT; int* TILEE = (int*)(F.ws + WS_TILEE);
    const int* TOKE = (const int*)(F.ws + WS_TOKE); const int* TOKR = (const int*)(F.ws + WS_TOKR); int* TOKP = (int*)(F.ws + WS_TOKP);
    const bf16* H2 = (const bf16*)(F.ws + WS_H2); bf16* XS = (bf16*)(F.ws + WS_XS);
    LAS int* poff = (LAS int*)F.lds;
    if (F.tid == 0) { int acc = 0, nt = 0;
        for (int e = 0; e < NEXP; ++e) { const int cnt = (int)__hip_atomic_load(gcnt + 64 * e, __ATOMIC_RELAXED, __HIP_MEMORY_SCOPE_AGENT); poff[e] = acc; const int tiles = (cnt + 255) >> 8;
            if (F.bid == 0) for (int i = 0; i < tiles; ++i) TILEE[nt + i] = e;
            nt += tiles; acc += tiles * 256; }
        if (F.bid == 0) TILEE[NT_MAX] = nt; }
    __syncthreads();
    for (int m = F.gw; m < NTOK; m += F.NGW) {
        const v4u a0 = *(const v4u*)(H2 + (size_t)m * D + 16 * F.lane), a1 = *(const v4u*)(H2 + (size_t)m * D + 16 * F.lane + 8);
#pragma unroll
        for (int k = 0; k < 4; ++k) { const int pos = poff[TOKE[m * 4 + k]] + TOKR[m * 4 + k]; if (F.lane == 0) TOKP[m * 4 + k] = pos;
            *(v4u*)(XS + (size_t)pos * D + 16 * F.lane) = a0; *(v4u*)(XS + (size_t)pos * D + 16 * F.lane + 8) = a1; }
    }
}
struct MoeOrder {
    const int* tile_e; int ntiles, nN, G, c, wsz;
    __device__ __forceinline__ bool next(int i, pg8::Unit& u) const { const long L = (long)i * G + c; if (L >= (long)ntiles * nN) return false;
        u.pm = (int)(L / nN); u.pn = (int)(L % nN); u.e = tile_e[u.pm]; u.boff = u.e * wsz; u.aoff = 0; u.kind = 0; return true; }
    __device__ __forceinline__ void a_ready(const pg8::Unit&) const {}
    __device__ __forceinline__ void done(const pg8::Unit&) const {}
};
struct EpiSwiglu {
    static constexpr bool PERM = true, AFTER_DRAIN = false;
    const float* bgu; bf16* ACT;
    __device__ __forceinline__ void operator()(const pg8::f32x4 (&acc)[2][2][4][2], const pg8::Unit& u, int wr, int wc, int fr, int fq) const {
        const int row0 = u.pm * 256 + wr * 64 + fr, oc = u.pn * 128 + wc * 32 + 8 * fq; const float* bp = bgu + (size_t)u.e * 2048 + oc;
        const pg8::f32x4 bg0 = *(const pg8::f32x4*)bp, bg1 = *(const pg8::f32x4*)(bp + 4), bu0 = *(const pg8::f32x4*)(bp + 1024), bu1 = *(const pg8::f32x4*)(bp + 1028);
#pragma unroll
        for (int ai = 0; ai < 2; ++ai)
#pragma unroll
            for (int m = 0; m < 4; ++m) { float r[8];
#pragma unroll
                for (int n = 0; n < 2; ++n)
#pragma unroll
                    for (int j = 0; j < 4; ++j) { const float gte = fminf(acc[ai][0][m][n][j] + (n ? bg1[j] : bg0[j]), 7.f), up = fminf(fmaxf(acc[ai][1][m][n][j] + (n ? bu1[j] : bu0[j]), -7.f), 7.f);
                        r[4 * n + j] = (up + 1.f) * (gte * sigmoidf_(1.702f * gte)); }
                v4u w; w.x = cvtpk(r[0], r[1]); w.y = cvtpk(r[2], r[3]); w.z = cvtpk(r[4], r[5]); w.w = cvtpk(r[6], r[7]);
                *(v4u*)(ACT + (size_t)(row0 + ai * 128 + m * 16) * 1024 + oc) = w; }
    }
};
struct EpiDown {
    static constexpr bool PERM = true, AFTER_DRAIN = false;
    const float* bd; bf16* YS;
    __device__ __forceinline__ void operator()(const pg8::f32x4 (&acc)[2][2][4][2], const pg8::Unit& u, int wr, int wc, int fr, int fq) const {
        const int row0 = u.pm * 256 + wr * 64 + fr, col0 = u.pn * 256 + wc * 32 + 8 * fq; const float* bp = bd + (size_t)u.e * 1024 + col0;
        pg8::f32x4 bv[2][2];
#pragma unroll
        for (int bj = 0; bj < 2; ++bj)
#pragma unroll
            for (int n = 0; n < 2; ++n) bv[bj][n] = *(const pg8::f32x4*)(bp + bj * 128 + 4 * n);
#pragma unroll
        for (int ai = 0; ai < 2; ++ai)
#pragma unroll
            for (int m = 0; m < 4; ++m) { bf16* rowp = YS + (size_t)(row0 + ai * 128 + m * 16) * 1024 + col0;
#pragma unroll
                for (int bj = 0; bj < 2; ++bj) { const pg8::f32x4 v0 = acc[ai][bj][m][0] + bv[bj][0], v1 = acc[ai][bj][m][1] + bv[bj][1];
                    v4u w; w.x = cvtpk(v0[0], v0[1]); w.y = cvtpk(v0[2], v0[3]); w.z = cvtpk(v1[0], v1[1]); w.w = cvtpk(v1[2], v1[3]);
                    *(v4u*)(rowp + bj * 128) = w; } }
    }
};
__device__ __forceinline__ void p12_combine(const Ctx& F, const float* final_g, float* out) {
    const float* X1 = (const float*)(F.ws + WS_X1); const float* mod = (const float*)(F.ws + WS_MOD); const bf16* YS = (const bf16*)(F.ws + WS_YS);
    const int* TOKP = (const int*)(F.ws + WS_TOKP); const float* TOKW = (const float*)(F.ws + WS_TOKW);
    for (int m = F.gw; m < NTOK; m += F.NGW) {
        const int b = m / T; const float* gt = mod + b * 6144 + 5120;
        f32x4 a[4];
#pragma unroll
        for (int j = 0; j < 4; ++j) a[j] = (f32x4){0.f, 0.f, 0.f, 0.f};
#pragma unroll
        for (int k = 0; k < 4; ++k) { const int pos = TOKP[m * 4 + k]; const float w = TOKW[m * 4 + k];
#pragma unroll
            for (int j = 0; j < 4; ++j) { const v2u y = *(const v2u*)(YS + (size_t)pos * D + 4 * F.lane + 256 * j);
                a[j][0] = fmaf(w, bflo(y.x), a[j][0]); a[j][1] = fmaf(w, bfhi(y.x), a[j][1]); a[j][2] = fmaf(w, bflo(y.y), a[j][2]); a[j][3] = fmaf(w, bfhi(y.y), a[j][3]); } }
        float ss = 0.f;
#pragma unroll
        for (int j = 0; j < 4; ++j) { const int c = 4 * F.lane + 256 * j; a[j] = *(const f32x4*)(X1 + (size_t)m * D + c) + *(const f32x4*)(gt + c) * a[j];
            ss += (a[j].x * a[j].x + a[j].y * a[j].y) + (a[j].z * a[j].z + a[j].w * a[j].w); }
        const float rstd = 1.f / sqrtf(wave_sum(ss) * (1.f / D) + EPS);
#pragma unroll
        for (int j = 0; j < 4; ++j) { const int c = 4 * F.lane + 256 * j; *(f32x4*)(out + (size_t)m * D + c) = a[j] * rstd * *(const f32x4*)(final_g + c); }
    }
}

constexpr int NPH = 13;
#ifndef DUP_MASK
#define DUP_MASK 0
#endif
#define DUP(k) (((DUP_MASK) >> (k)) & 1)
struct Args { const float* in[20]; float* out; unsigned char* ws; int ph_lo, ph_hi; };
__global__ void __launch_bounds__(NWAVES * 64, 2) mk_fwd(Args args) {
    extern __shared__ __attribute__((aligned(16))) unsigned char lds_raw[];
    LAS unsigned char* const lds_ = (LAS unsigned char*)lds_raw;
#define MKCTX() Ctx F; { int t_ = threadIdx.x; asm volatile("" : "+v"(t_)); F.lds = lds_; F.ws = args.ws; F.tid = t_; F.lane = t_ & 63; F.wave = __builtin_amdgcn_readfirstlane(t_ >> 6); \
        F.bid = blockIdx.x; F.G = gridDim.x; F.gw = F.bid * NWAVES + F.wave; F.NGW = F.G * NWAVES; }
    const float* x = args.in[0]; const float* c_in = args.in[1]; const float* w_ada = args.in[2]; const float* b_ada = args.in[3]; const float* norm1_g = args.in[4];
    const float* w_in = args.in[5]; const float* w_gate_lr = args.in[6]; const float* b_gate = args.in[7]; const float* gla_norm_g = args.in[8];
    const float* w_br_a = args.in[9]; const float* w_br_b = args.in[10]; const float* w_out = args.in[11]; const float* norm2_g = args.in[12];
    const float* router_w = args.in[13]; const float* router_b = args.in[14]; const float* w_gu = args.in[15]; const float* b_gu = args.in[16];
    const float* w_dn = args.in[17]; const float* b_dn = args.in[18]; const float* final_g = args.in[19];
    unsigned char* ws = args.ws;
    for (int u = threadIdx.x; u < (LDS_BYTES - LDSCTL_OFF) / 4; u += NWAVES * 64) ((LAS unsigned*)(lds_ + LDSCTL_OFF))[u] = 0u;
    __syncthreads();
    const int lo = args.ph_lo, hi = args.ph_hi;
    const bool multi = (hi - lo) > 1;
    XcdBarrier bar; bar.bar = (unsigned*)(ws + WS_CTL) + CW_BAR; bar.x = 0; bar.st = (volatile LAS unsigned*)(lds_ + LDSCTL_OFF + 32);
    if (multi) bar = xcd_barrier_post((unsigned*)(ws + WS_CTL) + CW_BAR, (volatile LAS unsigned*)(lds_ + LDSCTL_OFF + 32));
#define IN(k) (lo <= (k) && (k) < hi)
#ifdef TPROBE
#define STAMP(k) do { if (blockIdx.x == 0 && threadIdx.x == 0) ((volatile LAS unsigned long long*)(lds_ + LDSCTL_OFF + 256))[(k)] = __builtin_amdgcn_s_memrealtime(); } while (0)
#else
#define STAMP(k) do { } while (0)
#endif
    STAMP(0);
#define SEAM(k) do { if (IN(k) && IN((k) + 1)) xcd_barrier(bar); STAMP((k) + 1); } while (0)

    if (IN(0)) { MKCTX(); p0_prologue(F, c_in, w_ada, b_ada, w_in, w_br_a, w_br_b, w_out, w_gu, w_dn); if (DUP(0)) { __syncthreads(); p0_prologue(F, c_in, w_ada, b_ada, w_in, w_br_a, w_br_b, w_out, w_gu, w_dn); } }
    SEAM(0);
    if (IN(1)) { MKCTX(); p1_xn(F, x, norm1_g); if (DUP(1)) p1_xn(F, x, norm1_g); }
    SEAM(1);
    if (IN(2)) { MKCTX(); pg8::Gemm g{(const bf16*)(ws + WS_XN), (const bf16*)(ws + WS_WINT), NTOK, NPROJ, D}; pg8::StaticOrder S; S.init(NTOK, NPROJ, F.G, F.bid);
        EpiProj E{ws}; pg8::gemm_phase<EpiProj, pg8::StaticOrder, true, true>(F.lds, g, S, E); if (DUP(2)) pg8::gemm_phase<EpiProj, pg8::StaticOrder, true, true>(F.lds, g, S, E); }
    SEAM(2);
    if (IN(3)) { { MKCTX(); p3_indexer(F); if (DUP(3)) p3_indexer(F); } { MKCTX(); p3_gla1(F, w_gate_lr, b_gate); if (DUP(14)) p3_gla1(F, w_gate_lr, b_gate); } }
    SEAM(3);
    if (IN(4)) { { MKCTX(); p4_attention(F); if (DUP(4)) p4_attention(F); } { MKCTX(); p4_scan(F); if (DUP(13)) p4_scan(F); } }
    SEAM(4);
    if (IN(5)) { MKCTX(); p5_gla3(F, gla_norm_g); if (DUP(5)) p5_gla3(F, gla_norm_g); }
    SEAM(5);
    if (IN(6)) { MKCTX();
        pg8::Gemm g{(const bf16*)(ws + WS_YA), (const bf16*)(ws + WS_WAT), NTOK, D, D}; BranchOrder S; S.init(NTOK, D, F.G, F.bid); S.aoff1 = (int)((WS_YB - WS_YA) / 2); S.boff1 = (int)((WS_WBT - WS_WAT) / 2);
        EpiBr E{(const bf16*)(ws + WS_GA), (const bf16*)(ws + WS_GBM), (float*)(ws + WS_TMPA), (bf16*)(ws + WS_MERGED)};
        pg8::gemm_phase<EpiBr, BranchOrder, true, true>(F.lds, g, S, E); if (DUP(6)) pg8::gemm_phase<EpiBr, BranchOrder, true, true>(F.lds, g, S, E);
    }
    SEAM(6);
    if (IN(7)) { MKCTX(); pg8::Gemm g{(const bf16*)(ws + WS_MERGED), (const bf16*)(ws + WS_WOT), NTOK, D, D}; pg8::StaticOrder S; S.init(NTOK, D, F.G, F.bid);
        EpiOut E{x, (const float*)(ws + WS_MOD), (float*)(ws + WS_X1)}; pg8::gemm_phase<EpiOut, pg8::StaticOrder, true, true>(F.lds, g, S, E); if (DUP(7)) pg8::gemm_phase<EpiOut, pg8::StaticOrder, true, true>(F.lds, g, S, E); }
    SEAM(7);
    if (IN(8)) { MKCTX(); p8_router(F, norm2_g, router_w, router_b); if (DUP(8)) { __syncthreads(); p8_router(F, norm2_g, router_w, router_b, 4096); } }
    SEAM(8);
    if (IN(9)) { MKCTX(); p9_scatter(F); if (DUP(9)) { __syncthreads(); p9_scatter(F); } }
    SEAM(9);
    if (IN(10)) { MKCTX(); const int* tile_e = (const int*)(ws + WS_TILEE); const int ntiles = tile_e[NT_MAX];
        pg8::Gemm g{(const bf16*)(ws + WS_XS), (const bf16*)(ws + WS_WGUT), PMAX, 2048, D}; MoeOrder S{tile_e, ntiles, 8, F.G, F.bid, 2048 * D};
        EpiSwiglu E{b_gu, (bf16*)(ws + WS_ACT)}; pg8::gemm_phase<EpiSwiglu, MoeOrder, true, true>(F.lds, g, S, E); if (DUP(10)) pg8::gemm_phase<EpiSwiglu, MoeOrder, true, true>(F.lds, g, S, E); }
    SEAM(10);
    if (IN(11)) { MKCTX(); const int* tile_e = (const int*)(ws + WS_TILEE); const int ntiles = tile_e[NT_MAX];
        pg8::Gemm g{(const bf16*)(ws + WS_ACT), (const bf16*)(ws + WS_WDT), PMAX, D, DFF}; MoeOrder S{tile_e, ntiles, 4, F.G, F.bid, D * DFF};
        EpiDown E{b_dn, (bf16*)(ws + WS_YS)}; pg8::gemm_phase<EpiDown, MoeOrder, true, true>(F.lds, g, S, E); if (DUP(11)) pg8::gemm_phase<EpiDown, MoeOrder, true, true>(F.lds, g, S, E); }
    SEAM(11);
    if (DUP(15) && multi) { xcd_barrier(bar); xcd_barrier(bar); xcd_barrier(bar); xcd_barrier(bar); xcd_barrier(bar); xcd_barrier(bar); xcd_barrier(bar); xcd_barrier(bar); xcd_barrier(bar); xcd_barrier(bar); }
    if (IN(12)) { MKCTX(); p12_combine(F, final_g, args.out); if (DUP(12)) p12_combine(F, final_g, args.out); }
#ifdef TPROBE
    STAMP(13);
    if (blockIdx.x == 0 && threadIdx.x == 0) { volatile LAS unsigned long long* st_ = (volatile LAS unsigned long long*)(lds_ + LDSCTL_OFF + 256);
        const unsigned long long dt = st_[TPROBE + 1] - st_[TPROBE], t0 = __builtin_amdgcn_s_memrealtime();
        while (__builtin_amdgcn_s_memrealtime() - t0 < dt) __builtin_amdgcn_s_sleep(8); }
#endif
#undef IN
#undef SEAM
}

#ifndef MK_N_LAUNCHES
#define MK_N_LAUNCHES 1
#endif
extern "C" void kernel_launch(void* const* d_in, const int* in_sizes, int n_in, void* d_out, int out_size, void* d_ws, size_t ws_size, hipStream_t stream) {
    static int grid = 0;
    if (grid == 0) {
        if (n_in != 20 || out_size != NTOK * D || ws_size < WS_END) { fprintf(stderr, "kernel_launch: unexpected shapes (n_in %d out %d ws %zu)\n", n_in, out_size, ws_size); grid = -1; return; }
        int dev = 0, cus = 0, per_cu = 0;
        if (hipGetDevice(&dev) != hipSuccess || hipDeviceGetAttribute(&cus, hipDeviceAttributeMultiprocessorCount, dev) != hipSuccess) { grid = -1; return; }
        if (hipFuncSetAttribute((const void*)mk_fwd, hipFuncAttributeMaxDynamicSharedMemorySize, LDS_BYTES) != hipSuccess) { fprintf(stderr, "kernel_launch: hipFuncSetAttribute failed\n"); grid = -1; return; }
        if (hipOccupancyMaxActiveBlocksPerMultiprocessor(&per_cu, (const void*)mk_fwd, NWAVES * 64, LDS_BYTES) != hipSuccess || per_cu < 1) { fprintf(stderr, "kernel_launch: occupancy query says %d\n", per_cu); }
        (void)hipGetLastError();
        grid = cus;
    }
    if (grid < 0) return;
    if (hipMemsetAsync((char*)d_ws + WS_CTL, 0, CTL_ZERO_BYTES, stream) != hipSuccess) return;
    Args a{};
    for (int i = 0; i < 20; ++i) a.in[i] = (const float*)d_in[i];
    a.out = (float*)d_out; a.ws = (unsigned char*)d_ws;
#if MK_N_LAUNCHES == 1
    a.ph_lo = 0; a.ph_hi = NPH;
    hipLaunchKernelGGL(mk_fwd, dim3(grid), dim3(NWAVES * 64), LDS_BYTES, stream, a);
#else
    for (int p = 0; p < NPH; ++p) { a.ph_lo = p; a.ph_hi = p + 1; hipLaunchKernelGGL(mk_fwd, dim3(grid), dim3(NWAVES * 64), LDS_BYTES, stream, a); }
#endif
}
```

```cpp
#include <hip/hip_runtime.h>
#include <cstdio>
#include <cstdint>
namespace pg8 {
#define PG8_LAS __attribute__((address_space(3)))
typedef unsigned short bf16_t;
typedef short bf16x8 __attribute__((ext_vector_type(8)));
typedef float f32x4 __attribute__((ext_vector_type(4)));
typedef unsigned u32x4 __attribute__((ext_vector_type(4)));
typedef unsigned u32x2 __attribute__((ext_vector_type(2)));
constexpr int BM = 256, BK = 64, HALF = 128, HTB = HALF * BK * 2  , STAGE_BYTES = 8 * HTB, NXCD = 8, WGM = 8;

__host__ __device__ __forceinline__ int lds_byte(int r, int c) { const int st = (r >> 4) * 2 + (c >> 5), rr = r & 15, cc = c & 31, ob = rr * 64 + cc * 2; return st * 1024 + (ob ^ (((ob >> 9) & 1) << 5)); }
__host__ __device__ __forceinline__ void stage_rc(int b, int& R, int& C) { const int st = b / 1024, sb = b % 1024, swz = sb ^ (((sb >> 9) & 1) << 5); R = (st >> 1) * 16 + swz / 64; C = (st & 1) * 32 + (swz % 64) / 2; }
__host__ __device__ __forceinline__ int perm32(int rho) { const int n = rho >> 4, i = rho & 15; return 8 * (i >> 2) + 4 * n + (i & 3); }

struct Unit { int pm, pn, e, boff, aoff, kind; };
struct Gemm { const bf16_t* A; const bf16_t* Bt; int M, N, K; };

struct StaticOrder {
    int nM, nN, nwg, G, c;
    __host__ __device__ void init(int M, int N, int G_, int c_) { nM = M / BM; nN = N / BM; nwg = nM * nN; G = G_; c = c_; }
    __host__ __device__ bool next(int i, Unit& u) const {
        const long L = (long)i * G + c; if (L >= nwg) return false;
        int wgid = (int)L; { const int q = nwg / NXCD, r = nwg % NXCD, xcd = wgid % NXCD, off = wgid / NXCD; wgid = (xcd < r ? xcd * (q + 1) : r * (q + 1) + (xcd - r) * q) + off; }
        const int nig = WGM * nN, gid = wgid / nig, fm = gid * WGM, gsz = (nM - fm) < WGM ? (nM - fm) : WGM;
        u.pm = fm + ((wgid % nig) % gsz); u.pn = (wgid % nig) / gsz; u.e = 0; u.boff = 0; u.aoff = 0; u.kind = 0; return true;
    }
    __device__ __forceinline__ void a_ready(const Unit&) const {}
    __device__ __forceinline__ void done(const Unit&) const {}
};
typedef float f32x2_t __attribute__((ext_vector_type(2)));
typedef __bf16 bf16x2_t __attribute__((ext_vector_type(2)));
__device__ __forceinline__ unsigned cvt_pk_bf16(float lo, float hi) { const f32x2_t v = {lo, hi}; const bf16x2_t b = __builtin_convertvector(v, bf16x2_t); return __builtin_bit_cast(unsigned, b); }

template <class Epi, class Sched, bool ALIGN_EPI = false, bool SP2 = false>
__device__ __forceinline__ void gemm_phase(PG8_LAS unsigned char* lds, const Gemm g, const Sched& S, const Epi& E) {
    const int tid = threadIdx.x, wid = __builtin_amdgcn_readfirstlane(tid >> 6), lane = tid & 63, wr = wid >> 2, wc = wid & 3, fr = lane & 15, fq = lane >> 4;
    const int K = g.K, nt = K / BK;
    unsigned voffA[2], voffB[2];
#pragma unroll
    for (int i = 0; i < 2; ++i) { int R, C; stage_rc(tid * 16 + i * 8192, R, C); const int Rb = Epi::PERM ? ((R & ~31) + perm32(R & 31)) : R;
        voffA[i] = (unsigned)(R * K + C) * 2u; voffB[i] = (unsigned)(Rb * K + C) * 2u; }
    const size_t kstep = (size_t)(BK * 2);
    const size_t hstep = (size_t)HALF * K * 2;
    const size_t tstep = 2 * hstep;
    const unsigned ldsw = (unsigned)wid * 1024u;
    const int aoff = lds_byte(wr * 64 + fr, fq * 8), boff = lds_byte(wc * 32 + fr, fq * 8);
#define PG8_SA(b, h) (((b) * 2 + (h)) * HTB)
#define PG8_SB(b, h) ((4 + (b) * 2 + (h)) * HTB)
#define PG8_STAGE(bufoff, gbase, voff) do { _Pragma("unroll") for (int _i = 0; _i < 2; ++_i) \
        __builtin_amdgcn_global_load_lds((const unsigned*)((const char*)(gbase) + (voff)[_i]), (PG8_LAS unsigned*)(lds + (bufoff) + ldsw + _i * 8192), 16, 0, 0); } while (0)
#define PG8_LDA(dst, b, h) do { _Pragma("unroll") for (int m = 0; m < 4; ++m) _Pragma("unroll") for (int k = 0; k < 2; ++k) dst[m][k] = *(const PG8_LAS bf16x8*)(lds + PG8_SA(b, h) + aoff + m * 2048 + k * 1024); } while (0)
#define PG8_LDB(dst, b, h) do { _Pragma("unroll") for (int n = 0; n < 2; ++n) _Pragma("unroll") for (int k = 0; k < 2; ++k) dst[n][k] = *(const PG8_LAS bf16x8*)(lds + PG8_SB(b, h) + boff + n * 2048 + k * 1024); } while (0)
#define PG8_MMA(ai, bj, At, Bt) do { __builtin_amdgcn_s_setprio(1); _Pragma("unroll") for (int m = 0; m < 4; ++m) _Pragma("unroll") for (int n = 0; n < 2; ++n) _Pragma("unroll") for (int k = 0; k < 2; ++k) \
        acc[ai][bj][m][n] = __builtin_amdgcn_mfma_f32_16x16x32_bf16(Bt[n][k], At[m][k], acc[ai][bj][m][n], 0, 0, 0); __builtin_amdgcn_s_setprio(0); } while (0)
#define PG8_WAIT_V(n) asm volatile("s_waitcnt vmcnt(" #n ")" ::: "memory")
#define PG8_WAIT_L(n) asm volatile("s_waitcnt lgkmcnt(" #n ")" ::: "memory")
#define PG8_BAR __builtin_amdgcn_s_barrier()
#define PG8_SCHED __builtin_amdgcn_sched_barrier(0)
    Unit cur, nxt; int ui = 0;
    if (!S.next(0, cur)) return;
    f32x4 acc[2][2][4][2];
#pragma unroll
    for (int a = 0; a < 2; ++a)
#pragma unroll
        for (int b = 0; b < 2; ++b)
#pragma unroll
            for (int m = 0; m < 4; ++m)
#pragma unroll
                for (int n = 0; n < 2; ++n) acc[a][b][m][n] = (f32x4){0.f, 0.f, 0.f, 0.f};
    bf16x8 At[4][2], B0[2][2], B1[2][2];
    const char* cA = (const char*)g.A + (size_t)cur.aoff * 2 + (size_t)cur.pm * tstep; const char* cB = (const char*)g.Bt + (size_t)cur.boff * 2 + (size_t)cur.pn * tstep;
    S.a_ready(cur);
    if constexpr (SP2) {
        PG8_STAGE(PG8_SB(0, 0), cB, voffB); PG8_STAGE(PG8_SB(0, 1), cB + hstep, voffB); PG8_STAGE(PG8_SA(0, 0), cA, voffA); PG8_STAGE(PG8_SA(0, 1), cA + hstep, voffA);
        if (wr == 1) PG8_BAR;
        PG8_WAIT_V(2); PG8_BAR;
        PG8_STAGE(PG8_SB(1, 0), cB + kstep, voffB); PG8_STAGE(PG8_SA(1, 0), cA + kstep, voffA); PG8_STAGE(PG8_SB(1, 1), cB + hstep + kstep, voffB);
        PG8_WAIT_V(6); PG8_BAR;
    } else {
        PG8_STAGE(PG8_SB(0, 0), cB, voffB); PG8_STAGE(PG8_SA(0, 0), cA, voffA); PG8_STAGE(PG8_SB(0, 1), cB + hstep, voffB); PG8_STAGE(PG8_SA(0, 1), cA + hstep, voffA);
        if (wr == 1) PG8_BAR;
        PG8_WAIT_V(4); PG8_BAR;
        PG8_STAGE(PG8_SB(1, 0), cB + kstep, voffB); PG8_STAGE(PG8_SA(1, 0), cA + kstep, voffA); PG8_STAGE(PG8_SB(1, 1), cB + hstep + kstep, voffB);
        PG8_WAIT_V(6); PG8_BAR;
    }
    for (;;) {
        const bool has_next = S.next(ui + 1, nxt);
        const char* nA = has_next ? (const char*)g.A + (size_t)nxt.aoff * 2 + (size_t)nxt.pm * tstep : cA; const char* nB = has_next ? (const char*)g.Bt + (size_t)nxt.boff * 2 + (size_t)nxt.pn * tstep : cB;
        for (int t = 0; t < nt; t += 2) {
            const bool last = (t == nt - 2);
            const char* a1 = cA + (size_t)(t + 1) * kstep;
            const char* a2 = last ? nA : cA + (size_t)(t + 2) * kstep; const char* b2 = last ? nB : cB + (size_t)(t + 2) * kstep;
            const char* a3 = a2 + kstep; const char* b3 = b2 + kstep;
            if (last && has_next) S.a_ready(nxt);
            if constexpr (SP2) {
            PG8_LDB(B0, 0, 0); PG8_LDB(B1, 0, 1); PG8_SCHED; PG8_LDA(At, 0, 0); PG8_STAGE(PG8_SA(1, 1), a1 + hstep, voffA);
            PG8_WAIT_V(8); PG8_WAIT_L(0); PG8_BAR; PG8_MMA(0, 0, At, B0); PG8_MMA(0, 1, At, B1); PG8_BAR; PG8_SCHED;
            PG8_LDA(At, 0, 1); PG8_STAGE(PG8_SB(0, 0), b2, voffB); PG8_STAGE(PG8_SB(0, 1), b2 + hstep, voffB); PG8_STAGE(PG8_SA(0, 0), a2, voffA);
            PG8_WAIT_V(8); PG8_WAIT_L(0); PG8_BAR; PG8_MMA(1, 0, At, B0); PG8_MMA(1, 1, At, B1); PG8_BAR; PG8_SCHED;
            PG8_LDB(B0, 1, 0); PG8_LDB(B1, 1, 1); PG8_SCHED; PG8_LDA(At, 1, 0); PG8_STAGE(PG8_SA(0, 1), a2 + hstep, voffA);
            PG8_WAIT_V(8); PG8_WAIT_L(0); PG8_BAR; PG8_MMA(0, 0, At, B0); PG8_MMA(0, 1, At, B1); PG8_BAR; PG8_SCHED;
            PG8_LDA(At, 1, 1); PG8_STAGE(PG8_SB(1, 0), b3, voffB); PG8_STAGE(PG8_SB(1, 1), b3 + hstep, voffB); PG8_STAGE(PG8_SA(1, 0), a3, voffA);
            PG8_WAIT_V(8); PG8_WAIT_L(0); PG8_BAR; PG8_MMA(1, 0, At, B0); PG8_MMA(1, 1, At, B1); PG8_BAR; PG8_SCHED;
            } else {
            PG8_LDB(B0, 0, 0); PG8_SCHED; PG8_LDA(At, 0, 0); PG8_STAGE(PG8_SA(1, 1), a1 + hstep, voffA);
            PG8_WAIT_L(8); PG8_BAR; PG8_WAIT_L(0); PG8_MMA(0, 0, At, B0); PG8_BAR; PG8_SCHED;
            PG8_LDB(B1, 0, 1); PG8_STAGE(PG8_SB(0, 0), b2, voffB);
            PG8_BAR; PG8_WAIT_L(0); PG8_MMA(0, 1, At, B1); PG8_BAR;
            PG8_LDA(At, 0, 1); PG8_STAGE(PG8_SA(0, 0), a2, voffA);
            PG8_BAR; PG8_WAIT_L(0); PG8_MMA(1, 0, At, B0); PG8_BAR; PG8_SCHED;
            PG8_STAGE(PG8_SB(0, 1), b2 + hstep, voffB);
            PG8_WAIT_V(6); PG8_BAR; PG8_MMA(1, 1, At, B1); PG8_BAR;
            PG8_LDB(B0, 1, 0); PG8_SCHED; PG8_LDA(At, 1, 0); PG8_STAGE(PG8_SA(0, 1), a2 + hstep, voffA);
            PG8_WAIT_L(8); PG8_BAR; PG8_WAIT_L(0); PG8_MMA(0, 0, At, B0); PG8_BAR; PG8_SCHED;
            PG8_LDB(B1, 1, 1); PG8_STAGE(PG8_SB(1, 0), b3, voffB);
            PG8_BAR; PG8_WAIT_L(0); PG8_MMA(0, 1, At, B1); PG8_BAR;
            PG8_LDA(At, 1, 1); PG8_STAGE(PG8_SA(1, 0), a3, voffA);
            PG8_BAR; PG8_WAIT_L(0); PG8_MMA(1, 0, At, B0); PG8_BAR; PG8_SCHED;
            PG8_STAGE(PG8_SB(1, 1), b3 + hstep, voffB);
            PG8_WAIT_V(6); PG8_BAR; PG8_MMA(1, 1, At, B1); PG8_BAR;
            }
        }
        if constexpr (ALIGN_EPI) { if (wr == 0) PG8_BAR; }
        if constexpr (!Epi::AFTER_DRAIN) { E(acc, cur, wr, wc, fr, fq); S.done(cur); }
        if (!has_next) break;
#pragma unroll
        for (int a = 0; a < 2; ++a)
#pragma unroll
            for (int b = 0; b < 2; ++b)
#pragma unroll
                for (int m = 0; m < 4; ++m)
#pragma unroll
                    for (int n = 0; n < 2; ++n) acc[a][b][m][n] = (f32x4){0.f, 0.f, 0.f, 0.f};
        cur = nxt; cA = nA; cB = nB; ++ui;
        if constexpr (ALIGN_EPI) { if (wr == 1) PG8_BAR; }
    }
    PG8_WAIT_V(0);
    if constexpr (!ALIGN_EPI) { if (wr == 0) PG8_BAR; }
    PG8_BAR;
    if constexpr (Epi::AFTER_DRAIN) { E.fused(acc, cur, wr, wc, fr, fq, lds, wid, lane); S.done(cur); }
#undef PG8_SA
#undef PG8_SB
#undef PG8_STAGE
#undef PG8_LDA
#undef PG8_LDB
#undef PG8_MMA
#undef PG8_WAIT_V
#undef PG8_WAIT_L
#undef PG8_BAR
#undef PG8_SCHED
}
}

constexpr int NB = 4, T = 4096, D = 1024, NTOK = NB * T;
constexpr int NEXP = 32, TOPK = 4, DFF = 1024;
constexpr int INW = 8792, NPROJ = 8960;
constexpr int NT_MAX = NTOK * TOPK / 256 + NEXP;
constexpr int PMAX = NT_MAX * 256;
constexpr float EPS = 1e-6f;
constexpr float QA_SCALE = 0.08838834764831845f * 1.4426950408889634f;
constexpr float QB_SCALE = 0.08838834764831845f;
constexpr int NWAVES = 8;

constexpr size_t MiB = 1u << 20;
constexpr size_t WS_CTL = 0, CTL_ZERO_BYTES = 1 * MiB;
constexpr size_t WS_MOD = 1 * MiB;
constexpr size_t WS_TOKE = 2 * MiB, WS_TOKR = WS_TOKE + 256 * 1024, WS_TOKW = WS_TOKR + 256 * 1024, WS_TOKP = WS_TOKW + 256 * 1024;
constexpr size_t WS_TILEE = 3 * MiB;
constexpr size_t WS_DEC = 3 * MiB + 256 * 1024;
constexpr size_t WS_WINT = 4 * MiB, WS_WAT = 22 * MiB, WS_WBT = 24 * MiB, WS_WOT = 26 * MiB, WS_WGUT = 28 * MiB, WS_WDT = 156 * MiB;
constexpr size_t WS_XN = 220 * MiB;
constexpr size_t WS_QA = 252 * MiB, WS_KA = 284 * MiB, WS_VA = 316 * MiB;
constexpr size_t WS_QI = 348 * MiB, WS_QB = 364 * MiB, WS_KB = 380 * MiB;
constexpr size_t WS_VB = 396 * MiB, WS_GB = 428 * MiB, WS_GA = 460 * MiB, WS_GBM = 492 * MiB;
constexpr size_t WS_KI = 524 * MiB;
constexpr size_t WS_SMALL = 526 * MiB;
constexpr size_t WS_MASK = 528 * MiB;
constexpr size_t WS_KVC = 536 * MiB;
constexpr size_t WS_SC = 664 * MiB;
constexpr size_t WS_YA = 728 * MiB, WS_YB = 760 * MiB;
constexpr size_t WS_X1 = 792 * MiB;
constexpr size_t WS_YS = 856 * MiB;
constexpr size_t WS_END = 1000 * MiB;
constexpr size_t WS_QE = WS_XN, WS_KE = WS_XN + 16 * MiB;
constexpr size_t WS_MERGED = WS_XN, WS_TMPA = WS_QA  , WS_H2 = WS_QA, WS_XS = WS_VA  , WS_ACT = WS_KVC;
static_assert(WS_XS + (size_t)PMAX * 1024 * 2 <= WS_GA && WS_ACT + (size_t)PMAX * 1024 * 2 <= WS_YA && WS_YS + (size_t)PMAX * 1024 * 2 <= WS_END, "overlays");
constexpr int CW_BAR = 4096;
constexpr int CW_ECNT = 8192;

constexpr int LDS_BYTES = 155648;
constexpr int LDSCTL_OFF = 154624;

#define GAS __attribute__((address_space(1)))
#define LAS __attribute__((address_space(3)))
typedef unsigned short bf16;
typedef unsigned v4u __attribute__((ext_vector_type(4)));
typedef unsigned v2u __attribute__((ext_vector_type(2)));
typedef float f32x4 __attribute__((ext_vector_type(4)));
typedef float f32x16 __attribute__((ext_vector_type(16)));
typedef short bf16x8 __attribute__((ext_vector_type(8)));
typedef short s16x4 __attribute__((ext_vector_type(4)));
typedef GAS unsigned gu32;
typedef unsigned long long u64;
#define LDS_WAIT() asm volatile("s_waitcnt lgkmcnt(0)" ::: "memory")
#define VM_WAIT() asm volatile("s_waitcnt vmcnt(0)" ::: "memory")
#define SBAR() __builtin_amdgcn_sched_barrier(0)
typedef float f32x2_t __attribute__((ext_vector_type(2)));
typedef __bf16 bf16x2_t __attribute__((ext_vector_type(2)));
__device__ __forceinline__ unsigned pk2(float lo, float hi) { const f32x2_t v = {lo, hi}; const bf16x2_t b = __builtin_convertvector(v, bf16x2_t); return __builtin_bit_cast(unsigned, b); }
__device__ __forceinline__ unsigned f2bf(float f) { return pk2(f, f) & 0xffffu; }
__device__ __forceinline__ float bf2f(unsigned short h) { return __builtin_bit_cast(float, (unsigned)h << 16); }
__device__ __forceinline__ float bflo(unsigned w) { return __builtin_bit_cast(float, w << 16); }
__device__ __forceinline__ float bfhi(unsigned w) { return __builtin_bit_cast(float, w & 0xffff0000u); }
__device__ __forceinline__ unsigned cvtpk(float lo, float hi) { return pk2(lo, hi); }
__device__ __forceinline__ float wave_sum(float v) {
#pragma unroll
    for (int o = 1; o < 64; o <<= 1) v += __shfl_xor(v, o);
    return v;
}
__device__ __forceinline__ float sigmoidf_(float x) { return 1.f / (1.f + __expf(-x)); }

#define XB_TMO      128
#define XB_XCNT(j)  (256  + 64 * (j))
#define XB_XSUB(j)  (1280 + 64 * (j))
#define XB_XGEN(j)  (2304 + 64 * (j))
#define XB_TOP      3328
#define XB_TOPGEN   3392
#define XCD_BAR_WORDS 3456
#define XB_SPIN_CAP (1u << 18)

__device__ __forceinline__ unsigned xb_ld(unsigned* p)              { return __hip_atomic_load(p, __ATOMIC_RELAXED, __HIP_MEMORY_SCOPE_AGENT); }
__device__ __forceinline__ unsigned xb_add(unsigned* p, unsigned v) { return __hip_atomic_fetch_add(p, v, __ATOMIC_RELAXED, __HIP_MEMORY_SCOPE_AGENT); }
__device__ __forceinline__ unsigned xb_xcc_id() { return (unsigned)__builtin_amdgcn_s_getreg((3 << 11) | 20) & 0xFu; }
#define XB_SPIN(cond, bar) do { unsigned _sp = 0; while (cond) { __builtin_amdgcn_s_sleep(1); \
    if ((++_sp & 255u) == 0u) { if (xb_ld(&(bar)[XB_TMO])) break; if (_sp > XB_SPIN_CAP) { atomicAdd(&(bar)[XB_TMO], 1u); break; } } } } while (0)

struct XcdBarrier {
    unsigned* bar; unsigned x;
    volatile LAS unsigned* st;
};

__device__ __forceinline__ XcdBarrier xcd_barrier_post(unsigned* bar, volatile LAS unsigned* st) {
    XcdBarrier b; b.bar = bar; b.x = xb_xcc_id(); b.st = st;
    if (threadIdx.x == 0) (void)xb_add(&bar[XB_XCNT(b.x)], 1u);
    return b;
}
__device__ __forceinline__ void xcd_barrier_complete(unsigned* bar, unsigned x, unsigned& nloc, unsigned& nx) {
    const unsigned G = gridDim.x * gridDim.y * gridDim.z;
    unsigned sum, cnt, mine, sp = 0u;
    for (;;) {
        sum = 0u; cnt = 0u; mine = 0u;
#pragma unroll
        for (unsigned j = 0; j < 16; ++j) { const unsigned c = xb_ld(&bar[XB_XCNT(j)]); sum += c; cnt += (c > 0u) ? 1u : 0u; mine = (j == x) ? c : mine; }
        if (sum == G) break;
        __builtin_amdgcn_s_sleep(1);
        if ((++sp & 255u) == 0u) { if (xb_ld(&bar[XB_TMO])) break; if (sp > XB_SPIN_CAP) { atomicAdd(&bar[XB_TMO], 1u); break; } }
    }
    nloc = mine > 0u ? mine : 1u; nx = cnt > 0u ? cnt : 1u;
}

__device__ __forceinline__ void xcd_barrier(const XcdBarrier& b) {
    asm volatile("s_waitcnt vmcnt(0)" ::: "memory");
    __syncthreads();
    if (threadIdx.x == 0) {
        unsigned* bar = b.bar;
        __builtin_amdgcn_s_waitcnt(0);
        unsigned nloc = b.st[0], nx = b.st[1];
        if (nloc == 0u) { xcd_barrier_complete(bar, b.x, nloc, nx); b.st[0] = nloc; b.st[1] = nx; }
        const unsigned old = xb_add(&bar[XB_XSUB(b.x)], 1u);
        const unsigned gen = old / nloc;
        if (old + 1u == (gen + 1u) * nloc) {
            __builtin_amdgcn_fence(__ATOMIC_RELEASE, "agent");
            asm volatile("s_waitcnt vmcnt(0)" ::: "memory");
            const unsigned og = xb_add(&bar[XB_TOP], 1u);
            const unsigned tg = og / nx;
            if (og + 1u == (tg + 1u) * nx) xb_add(&bar[XB_TOPGEN], 1u);
            else XB_SPIN(xb_ld(&bar[XB_TOPGEN]) == tg, bar);
            __builtin_amdgcn_fence(__ATOMIC_ACQUIRE, "agent");
            xb_add(&bar[XB_XGEN(b.x)], 1u);
            asm volatile("s_waitcnt vmcnt(0)" ::: "memory");
        } else {
            XB_SPIN(xb_ld(&bar[XB_XGEN(b.x)]) == gen, bar);
            __builtin_amdgcn_fence(__ATOMIC_ACQUIRE, "agent");
            asm volatile("s_waitcnt vmcnt(0)" ::: "memory");
        }
    }
    __syncthreads();
}

struct Ctx {
    LAS unsigned char* lds;
    unsigned char* ws;
    int tid, lane, wave;
    int bid, G;
    int gw, NGW;
};

__device__ __forceinline__ int win_src_col(int n) {
    if (n < 3584) return n;
    if (n < 6656) return n - 3584 + 3656;
    if (n < 8704) return n - 6656 + 6744;
    if (n < 8768) return n - 8704 + 3584;
    if (n < 8776) return n - 8768 + 3648;
    if (n < 8792) return n - 8776 + 6728;
    return -1;
}
__device__ __forceinline__ void tr_item(const float* Wcol, size_t ldw, int K, bf16* WT0, LAS float* scr, int lane) {
#pragma unroll 8
    for (int i = 0; i < 32; ++i) { const int kk = 2 * i + (lane >> 5); scr[kk * 33 + (lane & 31)] = Wcol ? Wcol[(size_t)kk * ldw] : 0.f; }
    LDS_WAIT(); asm volatile("" ::: "memory");
    const int c = lane & 7;
#pragma unroll
    for (int j = 0; j < 4; ++j) { const int n = (lane >> 3) + 8 * j; const LAS float* s = scr + (8 * c) * 33 + n;
        v4u o; o.x = pk2(s[0 * 33], s[1 * 33]); o.y = pk2(s[2 * 33], s[3 * 33]); o.z = pk2(s[4 * 33], s[5 * 33]); o.w = pk2(s[6 * 33], s[7 * 33]);
        *(GAS v4u*)(WT0 + (size_t)n * K + 8 * c) = o; }
    LDS_WAIT(); asm volatile("" ::: "memory");
}
constexpr int TR_PITCH = 65, TR_SCR_BYTES = 64 * TR_PITCH * 4  , P0_SIL_OFF = 8 * TR_SCR_BYTES  ;
static_assert(P0_SIL_OFF + 16384 <= LDSCTL_OFF, "prologue LDS map");
__device__ __forceinline__ void tr_item64(const float* W0, size_t ldw, int K, bf16* WT0, LAS float* scr, int lane) {
    const int r4 = lane >> 4, c4 = lane & 15;
    f32x4 v[16];
#pragma unroll
    for (int i = 0; i < 16; ++i) v[i] = *(const f32x4*)(W0 + (size_t)(4 * i + r4) * ldw + 4 * c4);
#pragma unroll
    for (int i = 0; i < 16; ++i) { LAS float* p = scr + (4 * i + r4) * TR_PITCH + 4 * c4; p[0] = v[i].x; p[1] = v[i].y; p[2] = v[i].z; p[3] = v[i].w; }
    LDS_WAIT(); asm volatile("" ::: "memory");
    const int c = lane & 7, nl = lane >> 3;
#pragma unroll
    for (int j = 0; j < 8; ++j) { const int n = nl + 8 * j; const LAS float* s = scr + (8 * c) * TR_PITCH + n;
        v4u o; o.x = pk2(s[0 * TR_PITCH], s[1 * TR_PITCH]); o.y = pk2(s[2 * TR_PITCH], s[3 * TR_PITCH]); o.z = pk2(s[4 * TR_PITCH], s[5 * TR_PITCH]); o.w = pk2(s[6 * TR_PITCH], s[7 * TR_PITCH]);
        *(GAS v4u*)(WT0 + (size_t)n * K + 8 * c) = o; }
    LDS_WAIT(); asm volatile("" ::: "memory");
}
__device__ __forceinline__ void moe_item_ptrs(int r, const float* w_gu, const float* w_dn, unsigned char* ws, const float*& W0, int& ldw, int& K, bf16*& WT0) {
    constexpr int J_GU = NEXP * 16 * 32;
    if (r < J_GU) { const int e = r / 512; r -= e * 512; const int kb = r / 32, n0 = 64 * (r % 32), pn = n0 >> 8, i0 = n0 & 255, sc0 = i0 < 128 ? 128 * pn + i0 : 1024 + 128 * pn + (i0 - 128);
        W0 = w_gu + (size_t)e * D * 2048 + (size_t)(64 * kb) * 2048 + sc0; ldw = 2048; K = D; WT0 = (bf16*)(ws + WS_WGUT) + (size_t)e * 2048 * D + (size_t)n0 * D + 64 * kb; }
    else { r -= J_GU; const int e = r / 256; r -= e * 256; const int kb = r / 16, nb = r % 16;
        W0 = w_dn + (size_t)e * DFF * D + (size_t)(64 * kb) * D + 64 * nb; ldw = D; K = DFF; WT0 = (bf16*)(ws + WS_WDT) + (size_t)e * D * DFF + (size_t)(64 * nb) * DFF + 64 * kb; }
}
__device__ __forceinline__ void tr_store64(const f32x4 (&v)[16], int K, bf16* WT0, LAS float* scr, int lane) {
    const int r4 = lane >> 4, c4 = lane & 15;
#pragma unroll
    for (int i = 0; i < 16; ++i) { LAS float* p = scr + (4 * i + r4) * TR_PITCH + 4 * c4; p[0] = v[i].x; p[1] = v[i].y; p[2] = v[i].z; p[3] = v[i].w; }
    LDS_WAIT(); asm volatile("" ::: "memory");
    const int c = lane & 7, nl = lane >> 3;
#pragma unroll
    for (int j = 0; j < 8; ++j) { const int n = nl + 8 * j; const LAS float* s = scr + (8 * c) * TR_PITCH + n;
        v4u o; o.x = pk2(s[0 * TR_PITCH], s[1 * TR_PITCH]); o.y = pk2(s[2 * TR_PITCH], s[3 * TR_PITCH]); o.z = pk2(s[4 * TR_PITCH], s[5 * TR_PITCH]); o.w = pk2(s[6 * TR_PITCH], s[7 * TR_PITCH]);
        *(GAS v4u*)(WT0 + (size_t)n * K + 8 * c) = o; }
    LDS_WAIT(); asm volatile("" ::: "memory");
}
__device__ __forceinline__ void tr_scatter64(const f32x4 (&v)[16], LAS float* scr, int lane) {
    const int r4 = lane >> 4, c4 = lane & 15;
#pragma unroll
    for (int i = 0; i < 16; ++i) { LAS float* p = scr + (4 * i + r4) * TR_PITCH + 4 * c4; p[0] = v[i].x; p[1] = v[i].y; p[2] = v[i].z; p[3] = v[i].w; }
}
__device__ __forceinline__ void tr_gather64(int K, bf16* WT0, LAS float* scr, int lane) {
    LDS_WAIT(); asm volatile("" ::: "memory");
    const int c = lane & 7, nl = lane >> 3;
#pragma unroll
    for (int j = 0; j < 8; ++j) { const int n = nl + 8 * j; const LAS float* s = scr + (8 * c) * TR_PITCH + n;
        v4u o; o.x = pk2(s[0 * TR_PITCH], s[1 * TR_PITCH]); o.y = pk2(s[2 * TR_PITCH], s[3 * TR_PITCH]); o.z = pk2(s[4 * TR_PITCH], s[5 * TR_PITCH]); o.w = pk2(s[6 * TR_PITCH], s[7 * TR_PITCH]);
        *(GAS v4u*)(WT0 + (size_t)n * K + 8 * c) = o; }
    LDS_WAIT(); asm volatile("" ::: "memory");
}
__device__ __forceinline__ void moe_convert(const Ctx& F, const float* w_gu, const float* w_dn, int wi, int nw, int j_lo, int j_hi) {
    LAS float* scr = (LAS float*)(F.lds + F.wave * TR_SCR_BYTES);
    const int r4 = F.lane >> 4, c4 = F.lane & 15;
    const float* Wa; int lda, Ka; bf16* Ta; const float* Wb; int ldb, Kb; bf16* Tb;
    f32x4 va[16], vb[16];
#define MC_LOAD(V, W_, LD_) do { _Pragma("unroll") for (int i = 0; i < 16; ++i) V[i] = *(const f32x4*)(W_ + (size_t)(4 * i + r4) * LD_ + 4 * c4); } while (0)
    int ia = j_lo + wi, ib = ia + nw;
    if (ia < j_hi) { moe_item_ptrs(ia, w_gu, w_dn, F.ws, Wa, lda, Ka, Ta); MC_LOAD(va, Wa, lda); }
    if (ib < j_hi) { moe_item_ptrs(ib, w_gu, w_dn, F.ws, Wb, ldb, Kb, Tb); MC_LOAD(vb, Wb, ldb); }
    while (ia < j_hi) {
        tr_scatter64(va, scr, F.lane);
        { bf16* T_ = Ta; const int K_ = Ka; ia += 2 * nw; if (ia < j_hi) { moe_item_ptrs(ia, w_gu, w_dn, F.ws, Wa, lda, Ka, Ta); MC_LOAD(va, Wa, lda); } tr_gather64(K_, T_, scr, F.lane); }
        if (ib < j_hi) { tr_scatter64(vb, scr, F.lane);
            bf16* T_ = Tb; const int K_ = Kb; ib += 2 * nw; if (ib < j_hi) { moe_item_ptrs(ib, w_gu, w_dn, F.ws, Wb, ldb, Kb, Tb); MC_LOAD(vb, Wb, ldb); } tr_gather64(K_, T_, scr, F.lane); }
    }
#undef MC_LOAD
}
__device__ __forceinline__ void p0_prologue(const Ctx& F, const float* c_in, const float* w_ada, const float* b_ada, const float* w_in, const float* w_a, const float* w_b, const float* w_o,
                                            const float* w_gu, const float* w_dn, int moe_p0_items) {
    LAS float* scr = (LAS float*)(F.lds + F.wave * TR_SCR_BYTES);
    LAS float* sil = (LAS float*)(F.lds + P0_SIL_OFF);
    for (int i = F.tid; i < 4096; i += 512) { const float v = c_in[i]; sil[i] = v / (1.f + __expf(-v)); }
    __syncthreads();
    for (int it = F.NGW - 1 - F.gw; it < 384; it += F.NGW) {
        const int c4 = F.lane & 3, rg = F.lane >> 2, col = 16 * it + 4 * c4;
        f32x4 a0 = {0.f, 0.f, 0.f, 0.f}, a1 = a0, a2 = a0, a3 = a0;
        const float* wp = w_ada + (size_t)rg * 6144 + col;
#pragma unroll 16
        for (int i = 0; i < 64; ++i) { const int k = 16 * i + rg; const f32x4 w = *(const f32x4*)(wp + (size_t)i * 16 * 6144);
            a0 += w * sil[k]; a1 += w * sil[1024 + k]; a2 += w * sil[2048 + k]; a3 += w * sil[3072 + k]; }
#pragma unroll
        for (int o = 4; o < 64; o <<= 1) {
#pragma unroll
            for (int j = 0; j < 4; ++j) { a0[j] += __shfl_xor(a0[j], o); a1[j] += __shfl_xor(a1[j], o); a2[j] += __shfl_xor(a2[j], o); a3[j] += __shfl_xor(a3[j], o); } }
        if (F.lane < 4) { float* mod = (float*)(F.ws + WS_MOD); const f32x4 bb = *(const f32x4*)(b_ada + col);
            *(f32x4*)(mod + col) = a0 + bb; *(f32x4*)(mod + 6144 + col) = a1 + bb; *(f32x4*)(mod + 2 * 6144 + col) = a2 + bb; *(f32x4*)(mod + 3 * 6144 + col) = a3 + bb; }
    }
    constexpr int J_IN = 16 * 137, J_SQ = 16 * 16, NJ = J_IN + 3 * J_SQ;
    for (int it = F.gw; it < NJ; it += F.NGW) {
        int r = it; const float* W0; size_t ldw; int K; bf16* WT0;
        if (r < J_IN) { const int kb = r / 137, n0 = 64 * (r % 137); W0 = w_in + (size_t)(64 * kb) * INW + win_src_col(n0); ldw = INW; K = D; WT0 = (bf16*)(F.ws + WS_WINT) + (size_t)n0 * D + 64 * kb; }
        else { r -= J_IN; const int which = r / J_SQ; r -= which * J_SQ; const int kb = r / 16, nb = r % 16;
            W0 = (which == 0 ? w_a : (which == 1 ? w_b : w_o)) + (size_t)(64 * kb) * D + 64 * nb; ldw = D; K = D;
            WT0 = (bf16*)(F.ws + (which == 0 ? WS_WAT : (which == 1 ? WS_WBT : WS_WOT))) + (size_t)(64 * nb) * D + 64 * kb; }
        tr_item64(W0, ldw, K, WT0, scr, F.lane);
    }
    for (int it = F.gw; it < 16 * 6; it += F.NGW) { const int kb = it / 6, nb = 274 + it % 6; const int sc = win_src_col(32 * nb + (F.lane & 31));
        tr_item(sc >= 0 ? w_in + (size_t)(64 * kb) * INW + sc : nullptr, INW, D, (bf16*)(F.ws + WS_WINT) + (size_t)(32 * nb) * D + 64 * kb, scr, F.lane); }
    moe_convert(F, w_gu, w_dn, F.gw, F.NGW, 0, moe_p0_items);
}
__device__ __forceinline__ void p1_xn(const Ctx& F, const float* x, const float* g1) {
    const float* mod = (const float*)(F.ws + WS_MOD);
    bf16* XN = (bf16*)(F.ws + WS_XN);
    for (int r0 = 8 * F.gw; r0 < NTOK; r0 += 8 * F.NGW) {
        const int b = r0 / T; const float* mb = mod + b * 6144;
        f32x4 ga[4], sh[4];
#pragma unroll
        for (int j = 0; j < 4; ++j) { const int c = 4 * F.lane + 256 * j; const f32x4 g = *(const f32x4*)(g1 + c), s = *(const f32x4*)(mb + 1024 + c); ga[j] = g * (s + 1.0f); sh[j] = *(const f32x4*)(mb + c); }
        for (int rr = 0; rr < 8; rr += 4) {
            f32x4 v[4][4];
#pragma unroll
            for (int q = 0; q < 4; ++q) { const GAS f32x4* xr = (const GAS f32x4*)(x + (size_t)(r0 + rr + q) * D) + F.lane;
#pragma unroll
                for (int j = 0; j < 4; ++j) v[q][j] = xr[64 * j]; }
#pragma unroll
            for (int q = 0; q < 4; ++q) { float s = 0.f;
#pragma unroll
                for (int j = 0; j < 4; ++j) s += (v[q][j].x * v[q][j].x + v[q][j].y * v[q][j].y) + (v[q][j].z * v[q][j].z + v[q][j].w * v[q][j].w);
                const float rstd = 1.f / sqrtf(wave_sum(s) * (1.f / D) + EPS);
                GAS u64* o8 = (GAS u64*)(XN + (size_t)(r0 + rr + q) * D) + F.lane;
#pragma unroll
                for (int j = 0; j < 4; ++j) { const f32x4 h = v[q][j] * rstd * ga[j] + sh[j]; o8[64 * j] = (u64)pk2(h.x, h.y) | ((u64)pk2(h.z, h.w) << 32); } }
        }
    }
}
struct EpiProj {
    static constexpr bool PERM = true, AFTER_DRAIN = false;
    unsigned char* ws;
    __device__ __forceinline__ void operator()(const pg8::f32x4 (&acc)[2][2][4][2], const pg8::Unit& u, int wr, int wc, int fr, int fq) const {
        const int pn = u.pn, row0 = u.pm * 256 + wr * 64 + fr;
        if (pn < 34) {
            size_t off; int ld, ct; float sc = 1.f;
            if (pn < 12) { const int t = pn >> 2; off = WS_QA + (size_t)t * 32 * MiB; ld = 1024; ct = (pn & 3) * 256; if (t == 0) sc = QA_SCALE; }
            else if (pn < 18) { const int t = (pn - 12) >> 1; off = WS_QI + (size_t)t * 16 * MiB; ld = 512; ct = ((pn - 12) & 1) * 256; sc = t == 0 ? 0.125f : (t == 1 ? QB_SCALE : 1.f); }
            else { const int t = (pn - 18) >> 2; off = WS_VB + (size_t)t * 32 * MiB; ld = 1024; ct = ((pn - 18) & 3) * 256; }
            bf16* base = (bf16*)(ws + off); const int col0 = ct + wc * 32 + 8 * fq;
#pragma unroll
            for (int ai = 0; ai < 2; ++ai)
#pragma unroll
                for (int m = 0; m < 4; ++m) { bf16* rowp = base + (size_t)(row0 + ai * 128 + m * 16) * ld + col0;
#pragma unroll
                    for (int bj = 0; bj < 2; ++bj) { const pg8::f32x4 v0 = acc[ai][bj][m][0] * sc, v1 = acc[ai][bj][m][1] * sc;
                        v4u w; w.x = cvtpk(v0[0], v0[1]); w.y = cvtpk(v0[2], v0[3]); w.z = cvtpk(v1[0], v1[1]); w.w = cvtpk(v1[2], v1[3]);
                        *(v4u*)(rowp + bj * 128) = w; } }
        } else {
            if (wc < 2) { bf16* KI = (bf16*)(ws + WS_KI);
#pragma unroll
                for (int ai = 0; ai < 2; ++ai)
#pragma unroll
                    for (int m = 0; m < 4; ++m) { const pg8::f32x4 v0 = acc[ai][0][m][0], v1 = acc[ai][0][m][1];
                        v4u w; w.x = cvtpk(v0[0], v0[1]); w.y = cvtpk(v0[2], v0[3]); w.z = cvtpk(v1[0], v1[1]); w.w = cvtpk(v1[2], v1[3]);
                        *(v4u*)(KI + (size_t)(row0 + ai * 128 + m * 16) * 64 + wc * 32 + 8 * fq) = w; } }
            else if (wc == 2) { float* SM = (float*)(ws + WS_SMALL);
#pragma unroll
                for (int ai = 0; ai < 2; ++ai)
#pragma unroll
                    for (int m = 0; m < 4; ++m) { float* p = SM + (size_t)(row0 + ai * 128 + m * 16) * 32 + 8 * fq;
                        *(f32x4*)p = acc[ai][0][m][0]; *(f32x4*)(p + 4) = acc[ai][0][m][1]; } }
        }
    }
};

constexpr int IDX_ROWB = 8192 + 16, IDX_HIST_OFF = 16 * IDX_ROWB  ;
static_assert(IDX_HIST_OFF + 16 * 1024 <= LDSCTL_OFF, "indexer LDS map");
__device__ __forceinline__ unsigned quant16(float f) {
    const float a = fminf(fabsf(f), 127.f);
    const unsigned code = (__builtin_bit_cast(unsigned, a + 0.00390625f) - 0x3B800000u) >> 12;
    return (f >= 0.f) ? (0x8000u | code) : (0x7FFFu - code);
}
#define WSYNC() do { asm volatile("s_waitcnt lgkmcnt(0)" ::: "memory"); __builtin_amdgcn_wave_barrier(); } while (0)
__device__ __forceinline__ void radix_scan(LAS unsigned* hist, int lane, unsigned need, unsigned& bin, unsigned& cgt) {
    const v4u hv = *(LAS v4u*)(hist + 4 * lane); const unsigned s = hv.x + hv.y + hv.z + hv.w;
    unsigned suf = s;
#pragma unroll
    for (int o = 1; o < 64; o <<= 1) { const unsigned t = __shfl_down(suf, o); if (lane + o < 64) suf += t; }
    const u64 bal = __ballot(suf >= need); const int L = bal ? 63 - __builtin_clzll(bal) : 0;
    const unsigned above = suf - s, c3 = above + hv.w, c2 = c3 + hv.z, c1 = c2 + hv.y;
    unsigned bsel, cg;
    if (c3 >= need) { bsel = 3; cg = above; } else if (c2 >= need) { bsel = 2; cg = c3; } else if (c1 >= need) { bsel = 1; cg = c2; } else { bsel = 0; cg = c1; }
    bin = __shfl(4 * lane + bsel, L); cgt = __shfl(cg, L);
}
__device__ __forceinline__ void p3_indexer(const Ctx& F) {
    const bf16* QI = (const bf16*)(F.ws + WS_QI); const bf16* KI = (const bf16*)(F.ws + WS_KI); const float* SM = (const float*)(F.ws + WS_SMALL);
    u64* MASKT = (u64*)(F.ws + WS_MASK);
    const int lane = F.lane, l15 = lane & 15, g = lane >> 4;
    for (int it = F.bid; it < 1024; it += F.G) {
        int lz = 0; asm volatile("" : "+v"(lz));
        LAS unsigned char* L = F.lds + lz;
        LAS unsigned* histq = (LAS unsigned*)(L + IDX_HIST_OFF);
        const int r = it >> 8, cc = it & 255, b = r, u = (r & 1) ? 255 - cc : cc;
        const int q0 = 16 * u, nvis = ((q0 >> 6) + 1) * 64, ntile = nvis >> 6; const size_t tb = (size_t)b * T;
        if (nvis <= 256) {
            for (int idx = F.tid; idx < 1024; idx += 512) *(LAS u64*)(histq + (idx >> 6) * 256 + 2 * (idx & 63)) = ((idx & 63) < ntile) ? ~0ull : 0ull;
        } else {
            for (int idx = F.tid; idx < 1024; idx += 512) *(LAS v4u*)(histq + 4 * idx) = (v4u){0u, 0u, 0u, 0u};
            bf16x8 bq[8][2]; float wq[8];
            { const bf16* qp = QI + (tb + q0 + l15) * 512 + 8 * g; const float* wp = SM + (tb + q0 + l15) * 32;
#pragma unroll
              for (int h = 0; h < 8; ++h) { bq[h][0] = *(const bf16x8*)(qp + h * 64); bq[h][1] = *(const bf16x8*)(qp + h * 64 + 32); wq[h] = wp[h] * 0.35355339059327373f; } }
            __syncthreads();
            LAS unsigned* hq = histq + l15 * 256;
            const int ntl = nvis >> 4;
            for (int j0 = F.wave; j0 < ntl; j0 += 32) {
                bf16x8 ka[4][2];
#pragma unroll
                for (int u4 = 0; u4 < 4; ++u4) { const int j = (j0 + 8 * u4 < ntl) ? j0 + 8 * u4 : j0; const bf16* kp = KI + (tb + 16 * j + l15) * 64 + 8 * g;
                    ka[u4][0] = *(const bf16x8*)kp; ka[u4][1] = *(const bf16x8*)(kp + 32); }
#pragma unroll
                for (int u4 = 0; u4 < 4; ++u4) { const int j = j0 + 8 * u4;
                    if (j < ntl) { const int key0 = 16 * j;
                        float s0 = 0.f, s1 = 0.f, s2 = 0.f, s3 = 0.f;
#pragma unroll
                        for (int h = 0; h < 8; ++h) { f32x4 c = {0.f, 0.f, 0.f, 0.f};
                            c = __builtin_amdgcn_mfma_f32_16x16x32_bf16(ka[u4][0], bq[h][0], c, 0, 0, 0); c = __builtin_amdgcn_mfma_f32_16x16x32_bf16(ka[u4][1], bq[h][1], c, 0, 0, 0);
                            s0 = fmaf(wq[h], fmaxf(c[0], 0.f), s0); s1 = fmaf(wq[h], fmaxf(c[1], 0.f), s1); s2 = fmaf(wq[h], fmaxf(c[2], 0.f), s2); s3 = fmaf(wq[h], fmaxf(c[3], 0.f), s3); }
                        const unsigned c0 = quant16(s0), c1 = quant16(s1), c2 = quant16(s2), c3 = quant16(s3);
                        v2u w; w.x = c0 | (c1 << 16); w.y = c2 | (c3 << 16);
                        *(LAS v2u*)(L + l15 * IDX_ROWB + (key0 + 4 * g) * 2) = w;
                        __hip_atomic_fetch_add(hq + (c0 >> 8), 1u, __ATOMIC_RELAXED, __HIP_MEMORY_SCOPE_WORKGROUP); __hip_atomic_fetch_add(hq + (c1 >> 8), 1u, __ATOMIC_RELAXED, __HIP_MEMORY_SCOPE_WORKGROUP);
                        __hip_atomic_fetch_add(hq + (c2 >> 8), 1u, __ATOMIC_RELAXED, __HIP_MEMORY_SCOPE_WORKGROUP); __hip_atomic_fetch_add(hq + (c3 >> 8), 1u, __ATOMIC_RELAXED, __HIP_MEMORY_SCOPE_WORKGROUP); } }
            }
            __syncthreads();
            const int nblk = (ntile + 7) >> 3;
            for (int qq = 0; qq < 2; ++qq) {
                const int q = 2 * F.wave + qq; LAS unsigned char* rowp = L + q * IDX_ROWB; LAS unsigned* hist = histq + q * 256;
                unsigned b1, cgt1; radix_scan(hist, lane, 256u, b1, cgt1); WSYNC();
                const unsigned r1 = 256u - cgt1;
                *(LAS v4u*)(hist + 4 * lane) = (v4u){0u, 0u, 0u, 0u}; WSYNC();
                for (int i = 0; i < nblk; ++i) {
                    const v4u v = *(LAS v4u*)(rowp + (i * 512 + 8 * lane) * 2); const int kbase = i * 512 + 8 * lane;
#define LVL2(W, KO) { if (kbase + (KO) < nvis) { if ((((W) >> 8) & 255u) == b1) __hip_atomic_fetch_add(hist + ((W) & 255u), 1u, __ATOMIC_RELAXED, __HIP_MEMORY_SCOPE_WORKGROUP); \
                                                   if (((W) >> 24) == b1) __hip_atomic_fetch_add(hist + (((W) >> 16) & 255u), 1u, __ATOMIC_RELAXED, __HIP_MEMORY_SCOPE_WORKGROUP); } }
                    LVL2(v.x, 0) LVL2(v.y, 2) LVL2(v.z, 4) LVL2(v.w, 6)
#undef LVL2
                }
                WSYNC();
                unsigned b2, cgt2; radix_scan(hist, lane, r1, b2, cgt2); WSYNC();
                const unsigned thr = (b1 << 8) | b2, rr = r1 - cgt2;
                unsigned eqrun = 0u; u64 mword = 0ull;
                for (int i = 0; i < nblk; ++i) {
                    unsigned code[8];
#pragma unroll
                    for (int j = 0; j < 8; ++j) code[j] = *(LAS unsigned short*)(rowp + ((8 * i + j) * 64 + lane) * 2);
#pragma unroll
                    for (int j = 0; j < 8; ++j) { const int t = 8 * i + j;
                        if (t < ntile) { u64 m = __ballot(code[j] > thr); const u64 em = __ballot(code[j] == thr);
                            if (em) { const unsigned pre = __builtin_amdgcn_mbcnt_hi((unsigned)(em >> 32), __builtin_amdgcn_mbcnt_lo((unsigned)em, 0u));
                                m |= __ballot(code[j] == thr && (eqrun + pre) < rr); eqrun += (unsigned)__popcll(em); }
                            if (lane == t) mword = m; } }
                }
                WSYNC(); *(LAS u64*)(hist + 2 * lane) = mword;
            }
        }
        __syncthreads();
        for (int idx = F.tid; idx < 1024; idx += 512) { const int t = idx >> 4, q = idx & 15; MASKT[((size_t)b * 64 + t) * T + q0 + q] = *(LAS u64*)(histq + q * 256 + 2 * t); }
        __syncthreads();
    }
}

typedef short v4i16_t __attribute__((ext_vector_type(4)));
__device__ __forceinline__ s16x4 trrd(const LAS unsigned char* p) { return __builtin_bit_cast(s16x4, __builtin_amdgcn_ds_read_tr16_b64_v4i16((LAS v4i16_t*)p)); }
__device__ __forceinline__ bf16x8 cat8(s16x4 lo, s16x4 hi) { return (bf16x8){lo[0], lo[1], lo[2], lo[3], hi[0], hi[1], hi[2], hi[3]}; }
constexpr int G1_LR = 0, G1_TOT = 4096, G1_KD = 8192, G1_KDP = 272, G1_V = G1_KD + 64 * G1_KDP  , G1_VP = 528, G1_Q = G1_V + 64 * G1_VP  , G1_K = G1_Q + 64 * G1_KDP  ;
__device__ __forceinline__ void p3_gla1(const Ctx& F, const float* w_gate_lr, const float* b_gate) {
    const bf16* QB = (const bf16*)(F.ws + WS_QB); const bf16* KB = (const bf16*)(F.ws + WS_KB); bf16* QE = (bf16*)(F.ws + WS_QE); bf16* KE = (bf16*)(F.ws + WS_KE);
    const bf16* VB = (const bf16*)(F.ws + WS_VB); const float* SM = (const float*)(F.ws + WS_SMALL);
    bf16* KVC = (bf16*)(F.ws + WS_KVC); float* DEC = (float*)(F.ws + WS_DEC);
    const int d = F.tid & 127, tq = F.tid >> 7, lane = F.lane, l15 = lane & 15, g = lane >> 4, q4 = l15 >> 2, p4 = lane & 3;
    LAS float* lrs = (LAS float*)(F.lds + G1_LR); LAS float* tot = (LAS float*)(F.lds + G1_TOT);
    const int t16 = F.tid >> 4, p16 = F.tid & 15, t32 = F.tid >> 5, p32 = F.tid & 31;
    float rl0, rl1; v4u rq[2], rk[2], rv[4];
#define G1_LOAD(IT) do { const int bh_ = (IT) >> 6, c_ = (IT) & 63, b_ = bh_ >> 2, h_ = bh_ & 3; const size_t tk_ = (size_t)b_ * T + 64 * c_; \
        rl0 = SM[(tk_ + (F.tid >> 4)) * 32 + 8 + (F.tid & 15)]; rl1 = SM[(tk_ + 32 + (F.tid >> 4)) * 32 + 8 + (F.tid & 15)]; \
        _Pragma("unroll") for (int j = 0; j < 2; ++j) { const size_t o_ = (tk_ + t16 + 32 * j) * 512 + h_ * 128 + 8 * p16; rq[j] = *(const v4u*)(QB + o_); rk[j] = *(const v4u*)(KB + o_); } \
        _Pragma("unroll") for (int j = 0; j < 4; ++j) rv[j] = *(const v4u*)(VB + (tk_ + t32 + 16 * j) * 1024 + h_ * 256 + 8 * p32); } while (0)
    int it = F.bid;
    if (it < 1024) G1_LOAD(it);
    for (; it < 1024; it += F.G) {
        const int bh = it >> 6, c = it & 63, b = bh >> 2, h = bh & 3; const size_t tok0 = (size_t)b * T + 64 * c;
        lrs[F.tid] = rl0; lrs[512 + F.tid] = rl1;
#pragma unroll
        for (int j = 0; j < 2; ++j) { *(LAS v4u*)(F.lds + G1_Q + (t16 + 32 * j) * G1_KDP + 16 * p16) = rq[j]; *(LAS v4u*)(F.lds + G1_K + (t16 + 32 * j) * G1_KDP + 16 * p16) = rk[j]; }
#pragma unroll
        for (int j = 0; j < 4; ++j) *(LAS v4u*)(F.lds + G1_V + (t32 + 16 * j) * G1_VP + 16 * p32) = rv[j];
        float wg[16];
#pragma unroll
        for (int r = 0; r < 16; ++r) wg[r] = w_gate_lr[r * 512 + h * 128 + d];
        const float bg = b_gate[h * 128 + d];
        __syncthreads();
        { const int itn = it + F.G; if (itn < 1024) G1_LOAD(itn); }
        float Gl[16]; float run = 0.f;
#pragma unroll
        for (int i = 0; i < 16; ++i) { const int t = 16 * tq + i; float z = bg;
#pragma unroll
            for (int r4 = 0; r4 < 4; ++r4) { const f32x4 l = *(LAS f32x4*)(lrs + t * 16 + 4 * r4); z = fmaf(l.x, wg[4 * r4], z); z = fmaf(l.y, wg[4 * r4 + 1], z); z = fmaf(l.z, wg[4 * r4 + 2], z); z = fmaf(l.w, wg[4 * r4 + 3], z); }
            const float la = (fminf(z, 0.f) - log1pf(__expf(-fabsf(z)))) * 0.0625f; run += la; Gl[i] = run; }
        tot[tq * 128 + d] = run;
        __syncthreads();
        float offs = 0.f, glast = 0.f;
#pragma unroll
        for (int qd = 0; qd < 4; ++qd) { const float v = tot[qd * 128 + d]; if (qd < tq) offs += v; glast += v; }
#pragma unroll
        for (int i = 0; i < 16; ++i) { const int t = 16 * tq + i; const float G = Gl[i] + offs;
            LAS unsigned short* qp = (LAS unsigned short*)(F.lds + G1_Q + t * G1_KDP + d * 2); LAS unsigned short* kp = (LAS unsigned short*)(F.lds + G1_K + t * G1_KDP + d * 2);
            const float q = bf2f(*qp), k = bf2f(*kp);
            *qp = (unsigned short)f2bf(q * __expf(G)); *kp = (unsigned short)f2bf(k * __expf(-G));
            *(LAS unsigned short*)(F.lds + G1_KD + t * G1_KDP + d * 2) = (unsigned short)f2bf(k * __expf(glast - G)); }
        if (tq == 0) DEC[(size_t)(bh * 64 + c) * 128 + d] = __expf(glast);
        __syncthreads();
#pragma unroll
        for (int j = 0; j < 2; ++j) { const size_t o = (tok0 + t16 + 32 * j) * 512 + h * 128 + 8 * p16;
            *(v4u*)(QE + o) = *(LAS v4u*)(F.lds + G1_Q + (t16 + 32 * j) * G1_KDP + 16 * p16); *(v4u*)(KE + o) = *(LAS v4u*)(F.lds + G1_K + (t16 + 32 * j) * G1_KDP + 16 * p16); }
        const int m0 = 16 * F.wave; bf16x8 a[2];
#pragma unroll
        for (int s = 0; s < 2; ++s) { const LAS unsigned char* ap = F.lds + G1_KD + (32 * s + 8 * g + q4) * G1_KDP + (m0 + 4 * p4) * 2; a[s] = cat8(trrd(ap), trrd(ap + 4 * G1_KDP)); }
        bf16* out = KVC + (size_t)(bh * 64 + c) * 256 * 128;
#pragma unroll 4
        for (int nt = 0; nt < 16; ++nt) { f32x4 acc = {0.f, 0.f, 0.f, 0.f};
#pragma unroll
            for (int s = 0; s < 2; ++s) { const LAS unsigned char* bp = F.lds + G1_V + (32 * s + 8 * g + q4) * G1_VP + (16 * nt + 4 * p4) * 2; const bf16x8 bv = cat8(trrd(bp), trrd(bp + 4 * G1_VP));
                acc = __builtin_amdgcn_mfma_f32_16x16x32_bf16(a[s], bv, acc, 0, 0, 0); }
            { v2u w_; w_.x = pk2(acc[0], acc[1]); w_.y = pk2(acc[2], acc[3]); *(v2u*)(out + (size_t)(16 * nt + l15) * 128 + m0 + 4 * g) = w_; } }
        __syncthreads();
    }
#undef G1_LOAD
}
__device__ __forceinline__ void p4_scan(const Ctx& F) {
    const bf16* KVC = (const bf16*)(F.ws + WS_KVC); const float* DEC = (const float*)(F.ws + WS_DEC); bf16* SC = (bf16*)(F.ws + WS_SC);
    for (int e = F.bid * 512 + F.tid; e < 16 * 256 * 32; e += F.G * 512) {
        const int d4 = e & 31, v = (e >> 5) & 255, bh = e >> 13; f32x4 S = {0.f, 0.f, 0.f, 0.f};
#pragma unroll 8
        for (int c = 0; c < 64; ++c) { const size_t o = ((size_t)(bh * 64 + c) * 256 + v) * 128 + 4 * d4;
            const v2u kw = *(const v2u*)(KVC + o); const f32x4 kv = {bflo(kw.x), bfhi(kw.x), bflo(kw.y), bfhi(kw.y)}, dc = *(const f32x4*)(DEC + (size_t)(bh * 64 + c) * 128 + 4 * d4);
            v2u w; w.x = pk2(S.x, S.y); w.y = pk2(S.z, S.w); *(v2u*)(SC + o) = w;
            S = S * dc + kv; }
    }
}
constexpr int G3_QE = 0, G3_KE = 17408, G3_V = 34816, G3_GB = 68608, G3_AM = 102400, G3_AMP = 144, G3_SS = 111616;
__device__ __forceinline__ void p5_gla3(const Ctx& F, const float* gnorm_g) {
    const bf16* QB = (const bf16*)(F.ws + WS_QE); const bf16* KB = (const bf16*)(F.ws + WS_KE); const bf16* VB = (const bf16*)(F.ws + WS_VB); const bf16* GB = (const bf16*)(F.ws + WS_GB);
    const bf16* SC = (const bf16*)(F.ws + WS_SC); bf16* YB = (bf16*)(F.ws + WS_YB);
    const int lane = F.lane, l15 = lane & 15, g = lane >> 4, q4 = l15 >> 2, p4 = lane & 3, w = F.wave;
    LAS float* SS = (LAS float*)(F.lds + G3_SS);
    const int t16 = F.tid >> 4, p16 = F.tid & 15, t32 = F.tid >> 5, p32 = F.tid & 31;
    v4u rq[2], rk[2], rv[4], rg[4]; bf16x8 bS[2][4];
#define G3_LOAD(IT) do { const int bh_ = (IT) >> 6, c_ = (IT) & 63, b_ = bh_ >> 2, h_ = bh_ & 3; const size_t tk_ = (size_t)b_ * T + 64 * c_; \
        _Pragma("unroll") for (int j = 0; j < 2; ++j) { const size_t o_ = (tk_ + t16 + 32 * j) * 512 + h_ * 128 + 8 * p16; rq[j] = *(const v4u*)(QB + o_); rk[j] = *(const v4u*)(KB + o_); } \
        _Pragma("unroll") for (int j = 0; j < 4; ++j) { const size_t o_ = (tk_ + t32 + 16 * j) * 1024 + h_ * 256 + 8 * p32; rv[j] = *(const v4u*)(VB + o_); rg[j] = *(const v4u*)(GB + o_); } } while (0)
#define G3_LOADS(IT) do { _Pragma("unroll") for (int n = 0; n < 2; ++n) _Pragma("unroll") for (int s = 0; s < 4; ++s) \
        bS[n][s] = *(const bf16x8*)(SC + ((size_t)(IT) * 256 + 32 * w + 16 * n + l15) * 128 + 32 * s + 8 * g); } while (0)
    int it = F.bid;
    if (it < 1024) { G3_LOAD(it); G3_LOADS(it); }
    for (; it < 1024; it += F.G) {
        const int bh = it >> 6, c = it & 63, b = bh >> 2, h = bh & 3; const size_t tok0 = (size_t)b * T + 64 * c; const int itn = it + F.G;
#pragma unroll
        for (int j = 0; j < 2; ++j) { *(LAS v4u*)(F.lds + G3_QE + (t16 + 32 * j) * 272 + 16 * p16) = rq[j]; *(LAS v4u*)(F.lds + G3_KE + (t16 + 32 * j) * 272 + 16 * p16) = rk[j]; }
#pragma unroll
        for (int j = 0; j < 4; ++j) { *(LAS v4u*)(F.lds + G3_V + (t32 + 16 * j) * G1_VP + 16 * p32) = rv[j]; *(LAS v4u*)(F.lds + G3_GB + (t32 + 16 * j) * G1_VP + 16 * p32) = rg[j]; }
        __syncthreads();
        if (itn < 1024) G3_LOAD(itn);
        { const int mi = w >> 1, mj0 = 2 * (w & 1);
#pragma unroll
          for (int jj = 0; jj < 2; ++jj) { const int mj = mj0 + jj; f32x4 c4 = {0.f, 0.f, 0.f, 0.f};
              if (mj <= mi) {
#pragma unroll
                  for (int s = 0; s < 4; ++s) { const bf16x8 av = *(LAS bf16x8*)(F.lds + G3_QE + (16 * mi + l15) * 272 + (32 * s + 8 * g) * 2), bv = *(LAS bf16x8*)(F.lds + G3_KE + (16 * mj + l15) * 272 + (32 * s + 8 * g) * 2);
                      c4 = __builtin_amdgcn_mfma_f32_16x16x32_bf16(av, bv, c4, 0, 0, 0); } }
#pragma unroll
              for (int r = 0; r < 4; ++r) { const int i = 16 * mi + 4 * g + r, j = 16 * mj + l15; *(LAS unsigned short*)(F.lds + G3_AM + i * G3_AMP + j * 2) = (unsigned short)f2bf(j <= i ? c4[r] : 0.f); } } }
        __syncthreads();
        f32x4 acc[4][2];
#pragma unroll
        for (int m = 0; m < 4; ++m) { acc[m][0] = (f32x4){0.f, 0.f, 0.f, 0.f}; acc[m][1] = (f32x4){0.f, 0.f, 0.f, 0.f}; }
#pragma unroll
        for (int s = 0; s < 4; ++s)
#pragma unroll
            for (int m = 0; m < 4; ++m) { const bf16x8 av = *(LAS bf16x8*)(F.lds + G3_QE + (16 * m + l15) * 272 + (32 * s + 8 * g) * 2);
                acc[m][0] = __builtin_amdgcn_mfma_f32_16x16x32_bf16(av, bS[0][s], acc[m][0], 0, 0, 0); acc[m][1] = __builtin_amdgcn_mfma_f32_16x16x32_bf16(av, bS[1][s], acc[m][1], 0, 0, 0); }
        if (itn < 1024) G3_LOADS(itn);
#pragma unroll
        for (int s = 0; s < 2; ++s)
#pragma unroll
            for (int n = 0; n < 2; ++n) { const LAS unsigned char* bp = F.lds + G3_V + (32 * s + 8 * g + q4) * G1_VP + (32 * w + 16 * n + 4 * p4) * 2; const bf16x8 bv = cat8(trrd(bp), trrd(bp + 4 * G1_VP));
#pragma unroll
                for (int m = 0; m < 4; ++m) { const bf16x8 av = *(LAS bf16x8*)(F.lds + G3_AM + (16 * m + l15) * G3_AMP + (32 * s + 8 * g) * 2); acc[m][n] = __builtin_amdgcn_mfma_f32_16x16x32_bf16(av, bv, acc[m][n], 0, 0, 0); } }
#pragma unroll
        for (int m = 0; m < 4; ++m)
#pragma unroll
            for (int r = 0; r < 4; ++r) { float ss = acc[m][0][r] * acc[m][0][r] + acc[m][1][r] * acc[m][1][r];
                ss += __shfl_xor(ss, 1); ss += __shfl_xor(ss, 2); ss += __shfl_xor(ss, 4); ss += __shfl_xor(ss, 8);
                if (l15 == 0) SS[(16 * m + 4 * g + r) * 8 + w] = ss; }
        __syncthreads();
#pragma unroll
        for (int m = 0; m < 4; ++m)
#pragma unroll
            for (int r = 0; r < 4; ++r) { const int row = 16 * m + 4 * g + r; const f32x4 s0 = *(LAS f32x4*)(SS + row * 8), s1 = *(LAS f32x4*)(SS + row * 8 + 4);
                const float rstd = 1.f / sqrtf(((s0.x + s0.y) + (s0.z + s0.w) + (s1.x + s1.y) + (s1.z + s1.w)) * (1.f / 256.f) + EPS);
#pragma unroll
                for (int n = 0; n < 2; ++n) { const int v = 32 * w + 16 * n + l15; LAS unsigned short* gp = (LAS unsigned short*)(F.lds + G3_GB + row * G1_VP + v * 2);
                    const float gt = bf2f(*gp); *gp = (unsigned short)f2bf(acc[m][n][r] * rstd * gnorm_g[v] * (gt * sigmoidf_(gt))); } }
        __syncthreads();
#pragma unroll
        for (int j = 0; j < 4; ++j) *(v4u*)(YB + (tok0 + t32 + 16 * j) * 1024 + h * 256 + 8 * p32) = *(LAS v4u*)(F.lds + G3_GB + (t32 + 16 * j) * G1_VP + 16 * p32);
        __syncthreads();
    }
#undef G3_LOAD
#undef G3_LOADS
}

namespace att {
constexpr int SHM_K = 16384, SHM_V = 16384, PITCH = 1024;
constexpr float THR = 8.f;
#define KSWZ(row, colB) ((row) * 256 + ((colB) ^ (((row) & 7) << 4)))
__device__ __forceinline__ int v_st(int k, int c) { const int kk = (k & ~0xC) | ((k & 4) << 1) | ((k & 8) >> 1); return ((kk >> 3) * 4 + (c >> 5)) * 512 + ((kk & 7) * 32 + (c & 31)) * 2; }
__device__ __forceinline__ int v_rd_base(int lane) { return ((lane & 3) << 3) | (((lane >> 2) & 3) << 6) | (((lane >> 4) & 1) << 5) | (((lane >> 5) & 1) << 8); }
constexpr int v_rd_off(int d0, int ks, int half) { return d0 * 512 + ks * 4096 + half * 2048; }
__device__ __forceinline__ int crow(int r, int hi) { return (r & 3) + 8 * (r >> 2) + 4 * hi; }
__device__ __forceinline__ void mask_bits(f32x16& p0, f32x16& p1, unsigned lo, unsigned hi32) {
    const float NEG = -__builtin_inff();
#pragma unroll
    for (int r = 0; r < 16; ++r) { const int c = (r & 3) + 8 * (r >> 2);
        if (!((lo >> c) & 1u)) p0[r] = NEG;
        if (!((hi32 >> c) & 1u)) p1[r] = NEG; }
}
__device__ __forceinline__ void partialSM(f32x16& p0, f32x16& p1, float& m_reg, float& mn, float& alpha) {
    float pmax = p0[0];
#pragma unroll
    for (int r = 1; r < 16; ++r) pmax = fmaxf(pmax, p0[r]);
#pragma unroll
    for (int r = 0; r < 16; ++r) pmax = fmaxf(pmax, p1[r]);
    { auto rr = __builtin_amdgcn_permlane32_swap(__float_as_uint(pmax), __float_as_uint(pmax), false, false);
      pmax = fmaxf(__uint_as_float(rr[0]), __uint_as_float(rr[1])); }
    if (__builtin_expect(__all((pmax - m_reg) <= THR), 1)) { mn = m_reg; alpha = 1.f; }
    else { mn = fmaxf(m_reg, pmax); alpha = __builtin_amdgcn_exp2f(m_reg - mn); m_reg = mn; }
#pragma unroll
    for (int r = 0; r < 16; ++r) p0[r] = __builtin_amdgcn_exp2f(p0[r] - mn);
#pragma unroll
    for (int r = 0; r < 16; ++r) p1[r] = __builtin_amdgcn_exp2f(p1[r] - mn);
}
__device__ __forceinline__ void finishSM(f32x16& p0, f32x16& p1, float alpha, float& l_reg, bf16x8& pa0, bf16x8& pa1, bf16x8& pa2, bf16x8& pa3) {
    float ps = 0.f;
#pragma unroll
    for (int r = 0; r < 16; ++r) ps += p0[r];
#pragma unroll
    for (int r = 0; r < 16; ++r) ps += p1[r];
    { auto rr = __builtin_amdgcn_permlane32_swap(__float_as_uint(ps), __float_as_uint(ps), false, false);
      ps = __uint_as_float(rr[0]) + __uint_as_float(rr[1]); }
    l_reg = l_reg * alpha + ps;
#define PK4(P, B_, OUT) do { unsigned a0 = cvtpk(P[B_+0], P[B_+1]), a1 = cvtpk(P[B_+2], P[B_+3]);                          \
        unsigned b0 = cvtpk(P[B_+4], P[B_+5]), b1 = cvtpk(P[B_+6], P[B_+7]);                                             \
        auto r0 = __builtin_amdgcn_permlane32_swap(a0, b0, false, false); auto r1 = __builtin_amdgcn_permlane32_swap(a1, b1, false, false); \
        v4u w_ = {r0[0], r1[0], r0[1], r1[1]}; OUT = __builtin_bit_cast(bf16x8, w_); } while (0)
    PK4(p0, 0, pa0); PK4(p0, 8, pa1); PK4(p1, 0, pa2); PK4(p1, 8, pa3);
#undef PK4
}
template <int KB>
__device__ __forceinline__ void qkt(f32x16& p0, f32x16& p1, const LAS unsigned char* K_lds, int r32, int hi, const bf16x8* qr) {
    p0 = f32x16{}; p1 = f32x16{};
    const LAS unsigned char* kb[4];
#pragma unroll
    for (int dd = 0; dd < 4; ++dd) kb[dd] = K_lds + KB * SHM_K + KSWZ(r32, (dd * 16 + hi * 8) * 2);
#pragma unroll
    for (int d0 = 0; d0 < 8; ++d0) { const LAS unsigned char* a = kb[d0 & 3] + (d0 >> 2) * 128;
        const bf16x8 b0 = *(const LAS bf16x8*)a, b1 = *(const LAS bf16x8*)(a + 32 * 256);
        p0 = __builtin_amdgcn_mfma_f32_32x32x16_bf16(b0, qr[d0], p0, 0, 0, 0);
        p1 = __builtin_amdgcn_mfma_f32_32x32x16_bf16(b1, qr[d0], p1, 0, 0, 0); }
}
template <int VB>
__device__ __forceinline__ void pv_tile(f32x16* o, int vb0, bf16x8 pa0, bf16x8 pa1, bf16x8 pa2, bf16x8 pa3) {
#define TRRD(dst, off) asm volatile("ds_read_b64_tr_b16 %0, %1 offset:%2" : "=&v"(dst) : "v"(vb0), "i"(off) : "memory")
#define PV_D0(d0) do { s16x4 l0, l1, l2, l3, h0, h1, h2, h3; constexpr int b_ = VB * SHM_V + v_rd_off(d0, 0, 0); \
        TRRD(l0, b_); TRRD(h0, b_ + 2048); TRRD(l1, b_ + 4096); TRRD(h1, b_ + 6144); TRRD(l2, b_ + 8192); TRRD(h2, b_ + 10240); TRRD(l3, b_ + 12288); TRRD(h3, b_ + 14336); \
        asm volatile("s_waitcnt lgkmcnt(0)" ::: "memory"); SBAR(); \
        o[d0] = __builtin_amdgcn_mfma_f32_32x32x16_bf16(pa0, (bf16x8){l0[0], l0[1], l0[2], l0[3], h0[0], h0[1], h0[2], h0[3]}, o[d0], 0, 0, 0);   \
        o[d0] = __builtin_amdgcn_mfma_f32_32x32x16_bf16(pa1, (bf16x8){l1[0], l1[1], l1[2], l1[3], h1[0], h1[1], h1[2], h1[3]}, o[d0], 0, 0, 0);   \
        o[d0] = __builtin_amdgcn_mfma_f32_32x32x16_bf16(pa2, (bf16x8){l2[0], l2[1], l2[2], l2[3], h2[0], h2[1], h2[2], h2[3]}, o[d0], 0, 0, 0);   \
        o[d0] = __builtin_amdgcn_mfma_f32_32x32x16_bf16(pa3, (bf16x8){l3[0], l3[1], l3[2], l3[3], h3[0], h3[1], h3[2], h3[3]}, o[d0], 0, 0, 0); } while (0)
    PV_D0(0); PV_D0(1); PV_D0(2); PV_D0(3);
#undef PV_D0
#undef TRRD
}
__device__ __forceinline__ void unit(const Ctx& F, int b, int h, int qb) {
    const bf16* Q = (const bf16*)(F.ws + WS_QA); const bf16* K = (const bf16*)(F.ws + WS_KA); const bf16* V = (const bf16*)(F.ws + WS_VA); bf16* O = (bf16*)(F.ws + WS_YA);
    const u64* MASKT = (const u64*)(F.ws + WS_MASK);
    const int tid = F.tid, wid = F.wave, lane = F.lane, r32 = lane & 31, hi = lane >> 5;
    LAS unsigned char* V_lds = F.lds; LAS unsigned char* K_lds = F.lds + 2 * SHM_V;
    LAS float* wsf = (LAS float*)(F.lds + 2 * SHM_V + 2 * SHM_K) + wid * 64; LAS float* li_l = wsf; LAS float* al_l = wsf + 32;
    const size_t tb = (size_t)b * T; const int NT = 4 * (qb + 1);
    const int sr = tid >> 4, sc = (tid & 15) * 8, vst0 = v_st(sr, sc), vst1 = v_st(32 + sr, sc), kws = KSWZ(sr, sc * 2);
    const int vb0 = (int)(uintptr_t)V_lds + v_rd_base(lane);
    const unsigned kvo = (unsigned)((tb + sr) * PITCH + h * 128 + sc);
    const int qrow = qb * 256 + wid * 32 + r32;
    bf16x8 qr[8];
    { const unsigned qo = (unsigned)((tb + qrow) * PITCH + h * 128 + hi * 8);
#pragma unroll
      for (int d0 = 0; d0 < 8; ++d0) qr[d0] = *(const bf16x8*)(Q + qo + d0 * 16); }
    const unsigned mo = (unsigned)(b * 64 * T + qrow);
    float m_reg = -1e30f, l_reg = 0.f; f32x16 o[4] = {};
    bf16x8 st_k0, st_k1, st_v0, st_v1;
#define SLOAD(t) do { const unsigned r0_ = kvo + (unsigned)((t) * 64 * PITCH); st_k0 = *(const bf16x8*)(K + r0_); st_k1 = *(const bf16x8*)(K + r0_ + 32 * PITCH); st_v0 = *(const bf16x8*)(V + r0_); st_v1 = *(const bf16x8*)(V + r0_ + 32 * PITCH); } while (0)
#define SWRITE(bf) do { *(LAS bf16x8*)(K_lds + (bf) * SHM_K + kws) = st_k0; *(LAS bf16x8*)(K_lds + (bf) * SHM_K + kws + 32 * 256) = st_k1; \
                        *(LAS bf16x8*)(V_lds + (bf) * SHM_V + vst0) = st_v0; *(LAS bf16x8*)(V_lds + (bf) * SHM_V + vst1) = st_v1; } while (0)
#define STEP(t, BUF) do { \
        if ((t) + 1 < NT) SLOAD((t) + 1); \
        const u64 mwd = MASKT[mo + (unsigned)((t) * T)]; \
        f32x16 p0, p1; float mn, alpha; bf16x8 pa0, pa1, pa2, pa3; \
        SBAR(); qkt<BUF>(p0, p1, K_lds, r32, hi, qr); \
        mask_bits(p0, p1, (unsigned)mwd >> (4 * hi), (unsigned)(mwd >> 32) >> (4 * hi)); \
        partialSM(p0, p1, m_reg, mn, alpha); finishSM(p0, p1, alpha, l_reg, pa0, pa1, pa2, pa3); \
        if (__any(alpha < 1.f)) { if (hi == 0) al_l[r32] = alpha; LDS_WAIT(); \
            _Pragma("unroll") for (int d_ = 0; d_ < 4; ++d_) _Pragma("unroll") for (int r = 0; r < 16; ++r) o[d_][r] *= al_l[crow(r, hi)]; } \
        SBAR(); pv_tile<BUF>(o, vb0, pa0, pa1, pa2, pa3); \
        if ((t) + 1 < NT) { VM_WAIT(); SWRITE(1 - (BUF)); } \
        __syncthreads(); } while (0)
    SLOAD(0); VM_WAIT(); SWRITE(0); __syncthreads();
    for (int t = 0; t < NT; t += 2) { STEP(t, 0); STEP(t + 1, 1); }
#undef STEP
#undef SLOAD
#undef SWRITE
    if (hi == 0) li_l[r32] = l_reg; LDS_WAIT();
    const unsigned oo = (unsigned)((tb + qb * 256 + wid * 32) * PITCH + h * 128 + r32);
#pragma unroll
    for (int r = 0; r < 16; ++r) { const int orow = crow(r, hi); const float rl = __builtin_amdgcn_rcpf(li_l[orow]);
#pragma unroll
        for (int d0 = 0; d0 < 4; ++d0) { const float v = o[d0][r] * rl; const float vn = __shfl_xor(v, 1);
            if ((r32 & 1) == 0) *(unsigned*)(O + oo + (unsigned)(orow * PITCH + d0 * 32)) = cvtpk(v, vn); } }
    __syncthreads();
}
}
__device__ __forceinline__ void p4_attention(const Ctx& F) {
    for (int it = F.bid; it < 256; it += F.G) { const int bh = it >> 3, p = it & 7;
        att::unit(F, bh >> 3, bh & 7, 15 - p); att::unit(F, bh >> 3, bh & 7, p); }
}

struct BranchOrder : pg8::StaticOrder {
    int aoff1, boff1;
    __device__ __forceinline__ bool next(int i, pg8::Unit& u) const { if (!pg8::StaticOrder::next(i >> 1, u)) return false; u.kind = i & 1; u.aoff = (i & 1) ? aoff1 : 0; u.boff = (i & 1) ? boff1 : 0; return true; }
};
struct EpiBr {
    static constexpr bool PERM = false, AFTER_DRAIN = false;
    const bf16* GA; const bf16* GBM; float* TMP; bf16* OUT;
    __device__ __forceinline__ void operator()(const pg8::f32x4 (&acc)[2][2][4][2], const pg8::Unit& u, int wr, int wc, int fr, int fq) const {
        const int row0 = u.pm * 256 + wr * 64 + fr, col0 = u.pn * 256 + wc * 32 + 4 * fq; const bf16* G = u.kind ? GBM : GA;
#pragma unroll
        for (int ai = 0; ai < 2; ++ai)
#pragma unroll
            for (int m = 0; m < 4; ++m) { const size_t ro = (size_t)(row0 + ai * 128 + m * 16) * 1024 + col0;
#pragma unroll
                for (int bj = 0; bj < 2; ++bj)
#pragma unroll
                    for (int n = 0; n < 2; ++n) { const size_t o = ro + bj * 128 + n * 16; const v2u gw = *(const v2u*)(G + o); const pg8::f32x4 a = acc[ai][bj][m][n];
                        pg8::f32x4 r; r[0] = a[0] * sigmoidf_(bflo(gw.x)); r[1] = a[1] * sigmoidf_(bfhi(gw.x)); r[2] = a[2] * sigmoidf_(bflo(gw.y)); r[3] = a[3] * sigmoidf_(bfhi(gw.y));
                        if (u.kind == 0) *(pg8::f32x4*)(TMP + o) = r;
                        else { const pg8::f32x4 t = *(const pg8::f32x4*)(TMP + o); v2u w; w.x = cvtpk(t[0] + r[0], t[1] + r[1]); w.y = cvtpk(t[2] + r[2], t[3] + r[3]); *(v2u*)(OUT + o) = w; } } }
    }
};
struct EpiOut {
    static constexpr bool PERM = false, AFTER_DRAIN = false;
    const float* X; const float* MOD; float* X1;
    __device__ __forceinline__ void operator()(const pg8::f32x4 (&acc)[2][2][4][2], const pg8::Unit& u, int wr, int wc, int fr, int fq) const {
        const int row0 = u.pm * 256 + wr * 64 + fr, col0 = u.pn * 256 + wc * 32 + 4 * fq; const float* gt = MOD + (u.pm * 256 / T) * 6144 + 2048;
        pg8::f32x4 gv[2][2];
#pragma unroll
        for (int bj = 0; bj < 2; ++bj)
#pragma unroll
            for (int n = 0; n < 2; ++n) gv[bj][n] = *(const pg8::f32x4*)(gt + col0 + bj * 128 + n * 16);
#pragma unroll
        for (int ai = 0; ai < 2; ++ai)
#pragma unroll
            for (int m = 0; m < 4; ++m) { const size_t ro = (size_t)(row0 + ai * 128 + m * 16) * 1024 + col0;
#pragma unroll
                for (int bj = 0; bj < 2; ++bj)
#pragma unroll
                    for (int n = 0; n < 2; ++n) { const size_t o = ro + bj * 128 + n * 16; *(pg8::f32x4*)(X1 + o) = *(const pg8::f32x4*)(X + o) + gv[bj][n] * acc[ai][bj][m][n]; } }
    }
};
constexpr int RW_PITCH = 36, R_CNT = 1024 * RW_PITCH * 4  , R_BASE = R_CNT + 128, R_LE = R_CNT + 256, R_LR = R_LE + 1024;
static_assert(R_LR + 1024 <= LDSCTL_OFF, "router LDS map");
__device__ __forceinline__ float wave_max(float v) {
#pragma unroll
    for (int o = 1; o < 64; o <<= 1) v = fmaxf(v, __shfl_xor(v, o));
    return v;
}
__device__ __forceinline__ void p8_router(const Ctx& F, const float* g2, const float* router_w, const float* router_b, int cnt_off = 0) {
    const float* X1 = (const float*)(F.ws + WS_X1); const float* mod = (const float*)(F.ws + WS_MOD); bf16* H2 = (bf16*)(F.ws + WS_H2);
    int* TOKE = (int*)(F.ws + WS_TOKE); int* TOKR = (int*)(F.ws + WS_TOKR); float* TOKW = (float*)(F.ws + WS_TOKW); unsigned* gcnt = (unsigned*)(F.ws + WS_CTL) + CW_ECNT + cnt_off;
    LAS float* rw = (LAS float*)F.lds; LAS unsigned* lcnt = (LAS unsigned*)(F.lds + R_CNT); LAS unsigned* lbase = (LAS unsigned*)(F.lds + R_BASE);
    LAS int* le = (LAS int*)(F.lds + R_LE); LAS int* lrk = (LAS int*)(F.lds + R_LR);
    const int lane = F.lane;
    for (int i = F.tid; i < 8192; i += 512) { const int k = i >> 3, c4 = i & 7; *(LAS f32x4*)(rw + k * RW_PITCH + 4 * c4) = *(const f32x4*)(router_w + k * 32 + 4 * c4); }
    if (F.tid < 32) lcnt[F.tid] = 0u;
    __syncthreads();
    const float rb = router_b[(lane >> 1) & 31];
    for (int it = F.bid; it < NTOK / 64; it += F.G) {
        const int b = (it * 64) / T; const float* mb = mod + b * 6144;
        float ga[16], sh[16];
#pragma unroll
        for (int jj = 0; jj < 16; ++jj) { const int k = lane + 64 * jj; ga[jj] = g2[k] * (1.f + mb[4096 + k]); sh[jj] = mb[3072 + k]; }
        float hn[16];
        { const float* xr0 = X1 + (size_t)(it * 64 + F.wave * 8) * D;
#pragma unroll
          for (int jj = 0; jj < 16; ++jj) hn[jj] = xr0[lane + 64 * jj]; }
        for (int tt = 0; tt < 8; ++tt) { const int lt = F.wave * 8 + tt, m = it * 64 + lt;
            float hv[16]; float ss = 0.f;
#pragma unroll
            for (int jj = 0; jj < 16; ++jj) { hv[jj] = hn[jj]; ss = fmaf(hv[jj], hv[jj], ss); }
            if (tt < 7) { const float* xr = X1 + (size_t)(m + 1) * D;
#pragma unroll
                for (int jj = 0; jj < 16; ++jj) hn[jj] = xr[lane + 64 * jj]; }
            const float rstd = 1.f / sqrtf(wave_sum(ss) * (1.f / D) + EPS);
            float pe[32];
#pragma unroll
            for (int e = 0; e < 32; ++e) pe[e] = 0.f;
#pragma unroll
            for (int jj = 0; jj < 16; ++jj) { const int k = lane + 64 * jj; const float h = hv[jj] * rstd * ga[jj] + sh[jj]; H2[(size_t)m * D + k] = (bf16)f2bf(h);
#pragma unroll
                for (int c4 = 0; c4 < 8; ++c4) { const f32x4 w = *(LAS f32x4*)(rw + k * RW_PITCH + 4 * c4);
                    pe[4 * c4] = fmaf(h, w.x, pe[4 * c4]); pe[4 * c4 + 1] = fmaf(h, w.y, pe[4 * c4 + 1]); pe[4 * c4 + 2] = fmaf(h, w.z, pe[4 * c4 + 2]); pe[4 * c4 + 3] = fmaf(h, w.w, pe[4 * c4 + 3]); } }
#define RSTEP(NH, BIT) _Pragma("unroll") for (int e = 0; e < NH; ++e) { const bool up = (lane & BIT) != 0; const float send = up ? pe[e] : pe[e + NH]; const float keep = up ? pe[e + NH] : pe[e]; pe[e] = keep + __shfl_xor(send, BIT); }
            RSTEP(16, 32) RSTEP(8, 16) RSTEP(4, 8) RSTEP(2, 4) RSTEP(1, 2)
#undef RSTEP
            float lg = pe[0] + __shfl_xor(pe[0], 1) + rb;
            int e0, e1, e2, e3; float v0, v1, v2, v3;
#define TOP1(EK, VK) { const float mx = wave_max(lg); const u64 bm = __ballot(lg == mx); const int L = __ffsll((long long)bm) - 1; EK = (L >> 1) & 31; VK = mx; if (((lane >> 1) & 31) == EK) lg = -__builtin_inff(); }
            TOP1(e0, v0) TOP1(e1, v1) TOP1(e2, v2) TOP1(e3, v3)
#undef TOP1
            const float x1_ = __expf(v1 - v0), x2_ = __expf(v2 - v0), x3_ = __expf(v3 - v0), inv = 1.f / (1.f + x1_ + x2_ + x3_);
            if (lane < 4) { const int ek = lane == 0 ? e0 : (lane == 1 ? e1 : (lane == 2 ? e2 : e3)); const float wk = (lane == 0 ? 1.f : (lane == 1 ? x1_ : (lane == 2 ? x2_ : x3_))) * inv;
                const unsigned rk = __hip_atomic_fetch_add(lcnt + ek, 1u, __ATOMIC_RELAXED, __HIP_MEMORY_SCOPE_WORKGROUP);
                TOKE[m * 4 + lane] = ek; TOKW[m * 4 + lane] = wk; le[lt * 4 + lane] = ek; lrk[lt * 4 + lane] = (int)rk; }
        }
        __syncthreads();
        if (F.tid < 32) { lbase[F.tid] = __hip_atomic_fetch_add(gcnt + 64 * F.tid, lcnt[F.tid], __ATOMIC_RELAXED, __HIP_MEMORY_SCOPE_AGENT); lcnt[F.tid] = 0u; }
        __syncthreads();
        if (F.tid < 256) TOKR[it * 256 + F.tid] = lrk[F.tid] + (int)lbase[le[F.tid]];
        __syncthreads();
    }
}
__device__ __forceinline__ void p9_scatter(const Ctx& F) {
    const unsigned* gcnt = (const unsigned*)(F.ws + WS_CTL) + CW_ECNT; int* TILEE = (int*)(F.ws + WS_TILEE);
    const int* TOKE = (const int*)(F.ws + WS_TOKE); const int* TOKR = (const int*)(F.ws + WS_TOKR); int* TOKP = (int*)(F.ws + WS_TOKP);
    const bf16* H2 = (const bf16*)(F.ws + WS_H2); bf16* XS = (bf16*)(F.ws + WS_XS);
    LAS int* poff = (LAS int*)F.lds;
    if (F.tid == 0) { int acc = 0, nt = 0;
        for (int e = 0; e < NEXP; ++e) { const int cnt = (int)__hip_atomic_load(gcnt + 64 * e, __ATOMIC_RELAXED, __HIP_MEMORY_SCOPE_AGENT); poff[e] = acc; const int tiles = (cnt + 255) >> 8;
            if (F.bid == 0) for (int i = 0; i < tiles; ++i) TILEE[nt + i] = e;
            nt += tiles; acc += tiles * 256; }
        if (F.bid == 0) TILEE[NT_MAX] = nt; }
    __syncthreads();
    for (int m0 = 8 * F.gw; m0 < NTOK; m0 += 8 * F.NGW) {
        int mypos = 0;
        if (F.lane < 32) { mypos = poff[TOKE[m0 * 4 + F.lane]] + TOKR[m0 * 4 + F.lane]; TOKP[m0 * 4 + F.lane] = mypos; }
#pragma unroll
        for (int q = 0; q < 8; q += 2) {
            const v4u a0 = *(const v4u*)(H2 + (size_t)(m0 + q) * D + 16 * F.lane), a1 = *(const v4u*)(H2 + (size_t)(m0 + q) * D + 16 * F.lane + 8);
            const v4u b0 = *(const v4u*)(H2 + (size_t)(m0 + q + 1) * D + 16 * F.lane), b1 = *(const v4u*)(H2 + (size_t)(m0 + q + 1) * D + 16 * F.lane + 8);
#pragma unroll
            for (int k = 0; k < 4; ++k) { const int pa = __shfl(mypos, q * 4 + k), pb = __shfl(mypos, q * 4 + 4 + k);
                *(v4u*)(XS + (size_t)pa * D + 16 * F.lane) = a0; *(v4u*)(XS + (size_t)pa * D + 16 * F.lane + 8) = a1;
                *(v4u*)(XS + (size_t)pb * D + 16 * F.lane) = b0; *(v4u*)(XS + (size_t)pb * D + 16 * F.lane + 8) = b1; }
        }
    }
}
struct MoeOrder {
    const int* tile_e; int ntiles, nN, G, c, wsz;
    __device__ __forceinline__ bool next(int i, pg8::Unit& u) const { const long L = (long)i * G + c; if (L >= (long)ntiles * nN) return false;
        u.pm = (int)(L / nN); u.pn = (int)(L % nN); u.e = tile_e[u.pm]; u.boff = u.e * wsz; u.aoff = 0; u.kind = 0; return true; }
    __device__ __forceinline__ void a_ready(const pg8::Unit&) const {}
    __device__ __forceinline__ void done(const pg8::Unit&) const {}
};
struct EpiSwiglu {
    static constexpr bool PERM = true, AFTER_DRAIN = false;
    const float* bgu; bf16* ACT;
    __device__ __forceinline__ void operator()(const pg8::f32x4 (&acc)[2][2][4][2], const pg8::Unit& u, int wr, int wc, int fr, int fq) const {
        const int row0 = u.pm * 256 + wr * 64 + fr, oc = u.pn * 128 + wc * 32 + 8 * fq; const float* bp = bgu + (size_t)u.e * 2048 + oc;
        const pg8::f32x4 bg0 = *(const pg8::f32x4*)bp, bg1 = *(const pg8::f32x4*)(bp + 4), bu0 = *(const pg8::f32x4*)(bp + 1024), bu1 = *(const pg8::f32x4*)(bp + 1028);
#pragma unroll
        for (int ai = 0; ai < 2; ++ai)
#pragma unroll
            for (int m = 0; m < 4; ++m) { float r[8];
#pragma unroll
                for (int n = 0; n < 2; ++n)
#pragma unroll
                    for (int j = 0; j < 4; ++j) { const float gte = fminf(acc[ai][0][m][n][j] + (n ? bg1[j] : bg0[j]), 7.f), up = fminf(fmaxf(acc[ai][1][m][n][j] + (n ? bu1[j] : bu0[j]), -7.f), 7.f);
                        r[4 * n + j] = (up + 1.f) * (gte * sigmoidf_(1.702f * gte)); }
                v4u w; w.x = cvtpk(r[0], r[1]); w.y = cvtpk(r[2], r[3]); w.z = cvtpk(r[4], r[5]); w.w = cvtpk(r[6], r[7]);
                *(v4u*)(ACT + (size_t)(row0 + ai * 128 + m * 16) * 1024 + oc) = w; }
    }
};
struct EpiDown {
    static constexpr bool PERM = true, AFTER_DRAIN = false;
    const float* bd; bf16* YS;
    __device__ __forceinline__ void operator()(const pg8::f32x4 (&acc)[2][2][4][2], const pg8::Unit& u, int wr, int wc, int fr, int fq) const {
        const int row0 = u.pm * 256 + wr * 64 + fr, col0 = u.pn * 256 + wc * 32 + 8 * fq; const float* bp = bd + (size_t)u.e * 1024 + col0;
        pg8::f32x4 bv[2][2];
#pragma unroll
        for (int bj = 0; bj < 2; ++bj)
#pragma unroll
            for (int n = 0; n < 2; ++n) bv[bj][n] = *(const pg8::f32x4*)(bp + bj * 128 + 4 * n);
#pragma unroll
        for (int ai = 0; ai < 2; ++ai)
#pragma unroll
            for (int m = 0; m < 4; ++m) { bf16* rowp = YS + (size_t)(row0 + ai * 128 + m * 16) * 1024 + col0;
#pragma unroll
                for (int bj = 0; bj < 2; ++bj) { const pg8::f32x4 v0 = acc[ai][bj][m][0] + bv[bj][0], v1 = acc[ai][bj][m][1] + bv[bj][1];
                    v4u w; w.x = cvtpk(v0[0], v0[1]); w.y = cvtpk(v0[2], v0[3]); w.z = cvtpk(v1[0], v1[1]); w.w = cvtpk(v1[2], v1[3]);
                    *(v4u*)(rowp + bj * 128) = w; } }
    }
};
__device__ __forceinline__ void p12_combine(const Ctx& F, const float* final_g, float* out) {
    const float* X1 = (const float*)(F.ws + WS_X1); const float* mod = (const float*)(F.ws + WS_MOD); const bf16* YS = (const bf16*)(F.ws + WS_YS);
    const int* TOKP = (const int*)(F.ws + WS_TOKP); const float* TOKW = (const float*)(F.ws + WS_TOKW);
    for (int m0 = 8 * F.gw; m0 < NTOK; m0 += 8 * F.NGW) {
        const int b = m0 / T; const float* gt = mod + b * 6144 + 5120;
        int mypos = 0; float myw = 0.f;
        if (F.lane < 32) { mypos = TOKP[m0 * 4 + F.lane]; myw = TOKW[m0 * 4 + F.lane]; }
        f32x4 gv[4], fg[4];
#pragma unroll
        for (int j = 0; j < 4; ++j) { const int c = 4 * F.lane + 256 * j; gv[j] = *(const f32x4*)(gt + c); fg[j] = *(const f32x4*)(final_g + c); }
#pragma unroll 2
        for (int q = 0; q < 8; ++q) { const int m = m0 + q;
            v2u y[4][4]; f32x4 xv[4];
#pragma unroll
            for (int k = 0; k < 4; ++k) { const int pos = __shfl(mypos, q * 4 + k);
#pragma unroll
                for (int j = 0; j < 4; ++j) y[k][j] = *(const v2u*)(YS + (size_t)pos * D + 4 * F.lane + 256 * j); }
#pragma unroll
            for (int j = 0; j < 4; ++j) xv[j] = *(const f32x4*)(X1 + (size_t)m * D + 4 * F.lane + 256 * j);
            f32x4 a[4];
#pragma unroll
            for (int j = 0; j < 4; ++j) a[j] = (f32x4){0.f, 0.f, 0.f, 0.f};
#pragma unroll
            for (int k = 0; k < 4; ++k) { const float w = __shfl(myw, q * 4 + k);
#pragma unroll
                for (int j = 0; j < 4; ++j) { a[j][0] = fmaf(w, bflo(y[k][j].x), a[j][0]); a[j][1] = fmaf(w, bfhi(y[k][j].x), a[j][1]); a[j][2] = fmaf(w, bflo(y[k][j].y), a[j][2]); a[j][3] = fmaf(w, bfhi(y[k][j].y), a[j][3]); } }
            float ss = 0.f;
#pragma unroll
            for (int j = 0; j < 4; ++j) { a[j] = xv[j] + gv[j] * a[j]; ss += (a[j].x * a[j].x + a[j].y * a[j].y) + (a[j].z * a[j].z + a[j].w * a[j].w); }
            const float rstd = 1.f / sqrtf(wave_sum(ss) * (1.f / D) + EPS);
#pragma unroll
            for (int j = 0; j < 4; ++j) *(f32x4*)(out + (size_t)m * D + 4 * F.lane + 256 * j) = a[j] * rstd * fg[j];
        }
    }
}

constexpr int NPH = 13;
constexpr int MOE_ITEMS = NEXP * 16 * 32 + NEXP * 16 * 16;
#ifndef MOE_P0_ITEMS
#define MOE_P0_ITEMS 12288
#endif
#ifndef DUP_MASK
#define DUP_MASK 0
#endif
#define DUP(k) (((DUP_MASK) >> (k)) & 1)
struct Args { const float* in[20]; float* out; unsigned char* ws; int ph_lo, ph_hi; };
__global__ void __launch_bounds__(NWAVES * 64, 2) mk_fwd(Args args) {
    extern __shared__ __attribute__((aligned(16))) unsigned char lds_raw[];
    LAS unsigned char* const lds_ = (LAS unsigned char*)lds_raw;
#define MKCTX() Ctx F; { int t_ = threadIdx.x; asm volatile("" : "+v"(t_)); F.lds = lds_; F.ws = args.ws; F.tid = t_; F.lane = t_ & 63; F.wave = __builtin_amdgcn_readfirstlane(t_ >> 6); \
        F.bid = blockIdx.x; F.G = gridDim.x; F.gw = F.bid * NWAVES + F.wave; F.NGW = F.G * NWAVES; }
    const float* x = args.in[0]; const float* c_in = args.in[1]; const float* w_ada = args.in[2]; const float* b_ada = args.in[3]; const float* norm1_g = args.in[4];
    const float* w_in = args.in[5]; const float* w_gate_lr = args.in[6]; const float* b_gate = args.in[7]; const float* gla_norm_g = args.in[8];
    const float* w_br_a = args.in[9]; const float* w_br_b = args.in[10]; const float* w_out = args.in[11]; const float* norm2_g = args.in[12];
    const float* router_w = args.in[13]; const float* router_b = args.in[14]; const float* w_gu = args.in[15]; const float* b_gu = args.in[16];
    const float* w_dn = args.in[17]; const float* b_dn = args.in[18]; const float* final_g = args.in[19];
    unsigned char* ws = args.ws;
    for (int u = threadIdx.x; u < (LDS_BYTES - LDSCTL_OFF) / 4; u += NWAVES * 64) ((LAS unsigned*)(lds_ + LDSCTL_OFF))[u] = 0u;
    __syncthreads();
    const int lo = args.ph_lo, hi = args.ph_hi;
    const bool multi = (hi - lo) > 1;
    XcdBarrier bar; bar.bar = (unsigned*)(ws + WS_CTL) + CW_BAR; bar.x = 0; bar.st = (volatile LAS unsigned*)(lds_ + LDSCTL_OFF + 32);
    if (multi) bar = xcd_barrier_post((unsigned*)(ws + WS_CTL) + CW_BAR, (volatile LAS unsigned*)(lds_ + LDSCTL_OFF + 32));
#define IN(k) (lo <= (k) && (k) < hi)
#ifdef TPROBE
#define STAMP(k) do { if (blockIdx.x == 0 && threadIdx.x == 0) ((volatile LAS unsigned long long*)(lds_ + LDSCTL_OFF + 256))[(k)] = __builtin_amdgcn_s_memrealtime(); } while (0)
#else
#define STAMP(k) do { } while (0)
#endif
    STAMP(0);
#define SEAM(k) do { if (IN(k) && IN((k) + 1)) xcd_barrier(bar); STAMP((k) + 1); } while (0)

    const bool side = (gridDim.x == 256);
    if (IN(0)) { MKCTX(); p0_prologue(F, c_in, w_ada, b_ada, w_in, w_br_a, w_br_b, w_out, w_gu, w_dn, side ? MOE_P0_ITEMS : MOE_ITEMS); }
    SEAM(0);
    if (IN(1)) { MKCTX(); p1_xn(F, x, norm1_g); if (DUP(1)) p1_xn(F, x, norm1_g); }
    SEAM(1);
    if (IN(2)) { MKCTX(); constexpr int NCONV = 32; const int GG = side ? 256 - NCONV : F.G;
        if (F.bid < GG) { pg8::Gemm g{(const bf16*)(ws + WS_XN), (const bf16*)(ws + WS_WINT), NTOK, NPROJ, D}; pg8::StaticOrder S; S.init(NTOK, NPROJ, GG, F.bid);
            EpiProj E{ws}; pg8::gemm_phase<EpiProj, pg8::StaticOrder, true, true>(F.lds, g, S, E); }
        else moe_convert(F, w_gu, w_dn, (F.bid - GG) * NWAVES + F.wave, NCONV * NWAVES, MOE_P0_ITEMS, MOE_ITEMS); }
    SEAM(2);
    if (IN(3)) { { MKCTX(); p3_indexer(F); if (DUP(3)) p3_indexer(F); } { MKCTX(); p3_gla1(F, w_gate_lr, b_gate); if (DUP(14)) p3_gla1(F, w_gate_lr, b_gate); } }
    SEAM(3);
    if (IN(4)) { { MKCTX(); p4_attention(F); if (DUP(4)) p4_attention(F); } { MKCTX(); p4_scan(F); if (DUP(13)) p4_scan(F); } }
    SEAM(4);
    if (IN(5)) { MKCTX(); p5_gla3(F, gla_norm_g); if (DUP(5)) p5_gla3(F, gla_norm_g); }
    SEAM(5);
    if (IN(6)) { MKCTX();
        pg8::Gemm g{(const bf16*)(ws + WS_YA), (const bf16*)(ws + WS_WAT), NTOK, D, D}; BranchOrder S; S.init(NTOK, D, F.G, F.bid); S.aoff1 = (int)((WS_YB - WS_YA) / 2); S.boff1 = (int)((WS_WBT - WS_WAT) / 2);
        EpiBr E{(const bf16*)(ws + WS_GA), (const bf16*)(ws + WS_GBM), (float*)(ws + WS_TMPA), (bf16*)(ws + WS_MERGED)};
        pg8::gemm_phase<EpiBr, BranchOrder, true, true>(F.lds, g, S, E); if (DUP(6)) pg8::gemm_phase<EpiBr, BranchOrder, true, true>(F.lds, g, S, E);
    }
    SEAM(6);
    if (IN(7)) { MKCTX(); pg8::Gemm g{(const bf16*)(ws + WS_MERGED), (const bf16*)(ws + WS_WOT), NTOK, D, D}; pg8::StaticOrder S; S.init(NTOK, D, F.G, F.bid);
        EpiOut E{x, (const float*)(ws + WS_MOD), (float*)(ws + WS_X1)}; pg8::gemm_phase<EpiOut, pg8::StaticOrder, true, true>(F.lds, g, S, E); if (DUP(7)) pg8::gemm_phase<EpiOut, pg8::StaticOrder, true, true>(F.lds, g, S, E); }
    SEAM(7);
    if (IN(8)) { MKCTX(); p8_router(F, norm2_g, router_w, router_b); if (DUP(8)) { __syncthreads(); p8_router(F, norm2_g, router_w, router_b, 4096); } }
    SEAM(8);
    if (IN(9)) { MKCTX(); p9_scatter(F); if (DUP(9)) { __syncthreads(); p9_scatter(F); } }
    SEAM(9);
    if (IN(10)) { MKCTX(); const int* tile_e = (const int*)(ws + WS_TILEE); const int ntiles = tile_e[NT_MAX];
        pg8::Gemm g{(const bf16*)(ws + WS_XS), (const bf16*)(ws + WS_WGUT), PMAX, 2048, D}; MoeOrder S{tile_e, ntiles, 8, F.G, F.bid, 2048 * D};
        EpiSwiglu E{b_gu, (bf16*)(ws + WS_ACT)}; pg8::gemm_phase<EpiSwiglu, MoeOrder, true, true>(F.lds, g, S, E); if (DUP(10)) pg8::gemm_phase<EpiSwiglu, MoeOrder, true, true>(F.lds, g, S, E); }
    SEAM(10);
    if (IN(11)) { MKCTX(); const int* tile_e = (const int*)(ws + WS_TILEE); const int ntiles = tile_e[NT_MAX];
        pg8::Gemm g{(const bf16*)(ws + WS_ACT), (const bf16*)(ws + WS_WDT), PMAX, D, DFF}; MoeOrder S{tile_e, ntiles, 4, F.G, F.bid, D * DFF};
        EpiDown E{b_dn, (bf16*)(ws + WS_YS)}; pg8::gemm_phase<EpiDown, MoeOrder, true, true>(F.lds, g, S, E); if (DUP(11)) pg8::gemm_phase<EpiDown, MoeOrder, true, true>(F.lds, g, S, E); }
    SEAM(11);
    if (DUP(15) && multi) { xcd_barrier(bar); xcd_barrier(bar); xcd_barrier(bar); xcd_barrier(bar); xcd_barrier(bar); xcd_barrier(bar); xcd_barrier(bar); xcd_barrier(bar); xcd_barrier(bar); xcd_barrier(bar); }
    if (IN(12)) { MKCTX(); p12_combine(F, final_g, args.out); if (DUP(12)) p12_combine(F, final_g, args.out); }
#ifdef TPROBE
    STAMP(13);
    if (blockIdx.x == 0 && threadIdx.x == 0) { volatile LAS unsigned long long* st_ = (volatile LAS unsigned long long*)(lds_ + LDSCTL_OFF + 256);
        const unsigned long long dt = st_[TPROBE + 1] - st_[TPROBE], t0 = __builtin_amdgcn_s_memrealtime();
        while (__builtin_amdgcn_s_memrealtime() - t0 < dt) __builtin_amdgcn_s_sleep(8); }
#endif
#undef IN
#undef SEAM
}

#ifndef MK_N_LAUNCHES
#define MK_N_LAUNCHES 1
#endif
extern "C" void kernel_launch(void* const* d_in, const int* in_sizes, int n_in, void* d_out, int out_size, void* d_ws, size_t ws_size, hipStream_t stream) {
    static int grid = 0;
    if (grid == 0) {
        if (n_in != 20 || out_size != NTOK * D || ws_size < WS_END) { fprintf(stderr, "kernel_launch: unexpected shapes (n_in %d out %d ws %zu)\n", n_in, out_size, ws_size); grid = -1; return; }
        int dev = 0, cus = 0, per_cu = 0;
        if (hipGetDevice(&dev) != hipSuccess || hipDeviceGetAttribute(&cus, hipDeviceAttributeMultiprocessorCount, dev) != hipSuccess) { grid = -1; return; }
        if (hipFuncSetAttribute((const void*)mk_fwd, hipFuncAttributeMaxDynamicSharedMemorySize, LDS_BYTES) != hipSuccess) { fprintf(stderr, "kernel_launch: hipFuncSetAttribute failed\n"); grid = -1; return; }
        if (hipOccupancyMaxActiveBlocksPerMultiprocessor(&per_cu, (const void*)mk_fwd, NWAVES * 64, LDS_BYTES) != hipSuccess || per_cu < 1) { fprintf(stderr, "kernel_launch: occupancy query says %d\n", per_cu); }
        (void)hipGetLastError();
        grid = cus;
    }
    if (grid < 0) return;
    if (hipMemsetAsync((char*)d_ws + WS_CTL, 0, CTL_ZERO_BYTES, stream) != hipSuccess) return;
    Args a{};
    for (int i = 0; i < 20; ++i) a.in[i] = (const float*)d_in[i];
    a.out = (float*)d_out; a.ws = (unsigned char*)d_ws;
#if MK_N_LAUNCHES == 1
    a.ph_lo = 0; a.ph_hi = NPH;
    hipLaunchKernelGGL(mk_fwd, dim3(grid), dim3(NWAVES * 64), LDS_BYTES, stream, a);
#else
    for (int p = 0; p < NPH; ++p) { a.ph_lo = p; a.ph_hi = p + 1; hipLaunchKernelGGL(mk_fwd, dim3(grid), dim3(NWAVES * 64), LDS_BYTES, stream, a); }
#endif
}
```

```cpp
#include <hip/hip_runtime.h>
#include <cstdio>
#include <cstdint>
namespace pg8 {
#define PG8_LAS __attribute__((address_space(3)))
typedef unsigned short bf16_t;
typedef short bf16x8 __attribute__((ext_vector_type(8)));
typedef float f32x4 __attribute__((ext_vector_type(4)));
typedef unsigned u32x4 __attribute__((ext_vector_type(4)));
typedef unsigned u32x2 __attribute__((ext_vector_type(2)));
constexpr int BM = 256, BK = 64, HALF = 128, HTB = HALF * BK * 2  , STAGE_BYTES = 8 * HTB, NXCD = 8, WGM = 8;

__host__ __device__ __forceinline__ int lds_byte(int r, int c) { const int st = (r >> 4) * 2 + (c >> 5), rr = r & 15, cc = c & 31, ob = rr * 64 + cc * 2; return st * 1024 + (ob ^ (((ob >> 9) & 1) << 5)); }
__host__ __device__ __forceinline__ void stage_rc(int b, int& R, int& C) { const int st = b / 1024, sb = b % 1024, swz = sb ^ (((sb >> 9) & 1) << 5); R = (st >> 1) * 16 + swz / 64; C = (st & 1) * 32 + (swz % 64) / 2; }
__host__ __device__ __forceinline__ int perm32(int rho) { const int n = rho >> 4, i = rho & 15; return 8 * (i >> 2) + 4 * n + (i & 3); }

struct Unit { int pm, pn, e, boff, aoff, kind, r0, cnt; };
struct Gemm { const bf16_t* A; const bf16_t* Bt; int M, N, K; };

struct StaticOrder {
    int nM, nN, nwg, G, c;
    __host__ __device__ void init(int M, int N, int G_, int c_) { nM = M / BM; nN = N / BM; nwg = nM * nN; G = G_; c = c_; }
    __host__ __device__ bool next(int i, Unit& u) const {
        const long L = (long)i * G + c; if (L >= nwg) return false;
        int wgid = (int)L; { const int q = nwg / NXCD, r = nwg % NXCD, xcd = wgid % NXCD, off = wgid / NXCD; wgid = (xcd < r ? xcd * (q + 1) : r * (q + 1) + (xcd - r) * q) + off; }
        const int nig = WGM * nN, gid = wgid / nig, fm = gid * WGM, gsz = (nM - fm) < WGM ? (nM - fm) : WGM;
        u.pm = fm + ((wgid % nig) % gsz); u.pn = (wgid % nig) / gsz; u.e = 0; u.boff = 0; u.aoff = 0; u.kind = 0; u.r0 = 0; u.cnt = 0; return true;
    }
    __device__ __forceinline__ void a_ready(const Unit&) const {}
    __device__ __forceinline__ void done(const Unit&) const {}
};
typedef float f32x2_t __attribute__((ext_vector_type(2)));
typedef __bf16 bf16x2_t __attribute__((ext_vector_type(2)));
__device__ __forceinline__ unsigned cvt_pk_bf16(float lo, float hi) { const f32x2_t v = {lo, hi}; const bf16x2_t b = __builtin_convertvector(v, bf16x2_t); return __builtin_bit_cast(unsigned, b); }

template <class Epi, class Sched, bool ALIGN_EPI = false, bool SP2 = false, bool GATHER = false>
__device__ __forceinline__ void gemm_phase(PG8_LAS unsigned char* lds, const Gemm g, const Sched& S, const Epi& E) {
    const int tid = threadIdx.x, wid = __builtin_amdgcn_readfirstlane(tid >> 6), lane = tid & 63, wr = wid >> 2, wc = wid & 3, fr = lane & 15, fq = lane >> 4;
    const int K = g.K, nt = K / BK;
    unsigned voffA[2], voffB[2], colA[2]; int rowA[2];
#pragma unroll
    for (int i = 0; i < 2; ++i) { int R, C; stage_rc(tid * 16 + i * 8192, R, C); const int Rb = Epi::PERM ? ((R & ~31) + perm32(R & 31)) : R;
        voffA[i] = (unsigned)(R * K + C) * 2u; voffB[i] = (unsigned)(Rb * K + C) * 2u; rowA[i] = R; colA[i] = (unsigned)C * 2u; }
    unsigned vA0[2] = {0u, 0u}, vA1[2] = {0u, 0u}, vN0[2] = {0u, 0u}, vN1[2] = {0u, 0u}, tN0[2] = {0u, 0u}, tN1[2] = {0u, 0u};
#define PG8_GROWS(U, O0, O1) do { _Pragma("unroll") for (int i_ = 0; i_ < 2; ++i_) { const int ra_ = (U).r0 + rowA[i_], rb_ = ra_ + HALF; \
        const int ta_ = ra_ < (U).cnt ? S.ptok[(size_t)(U).e * S.ptok_stride + ra_] : 0, tb_ = rb_ < (U).cnt ? S.ptok[(size_t)(U).e * S.ptok_stride + rb_] : 0; \
        O0[i_] = (unsigned)ta_ * (unsigned)(K * 2) + colA[i_]; O1[i_] = (unsigned)tb_ * (unsigned)(K * 2) + colA[i_]; } } while (0)
    const size_t kstep = (size_t)(BK * 2);
    const size_t hstep = (size_t)HALF * K * 2;
    const size_t tstep = 2 * hstep;
    const unsigned ldsw = (unsigned)wid * 1024u;
    const int aoff = lds_byte(wr * 64 + fr, fq * 8), boff = lds_byte(wc * 32 + fr, fq * 8);
#define PG8_SA(b, h) (((b) * 2 + (h)) * HTB)
#define PG8_SB(b, h) ((4 + (b) * 2 + (h)) * HTB)
#define PG8_STAGE(bufoff, gbase, voff) do { _Pragma("unroll") for (int _i = 0; _i < 2; ++_i) \
        __builtin_amdgcn_global_load_lds((const unsigned*)((const char*)(gbase) + (voff)[_i]), (PG8_LAS unsigned*)(lds + (bufoff) + ldsw + _i * 8192), 16, 0, 0); } while (0)
#define PG8_STAGE_A(bufoff, gbase, H, NX) do { if constexpr (GATHER) { if (NX) { if (H) PG8_STAGE(bufoff, gbase, tN1); else PG8_STAGE(bufoff, gbase, tN0); } else { if (H) PG8_STAGE(bufoff, gbase, vA1); else PG8_STAGE(bufoff, gbase, vA0); } } \
        else { PG8_STAGE(bufoff, (gbase) + (H) * hstep, voffA); } } while (0)
#define PG8_LDA(dst, b, h) do { _Pragma("unroll") for (int m = 0; m < 4; ++m) _Pragma("unroll") for (int k = 0; k < 2; ++k) dst[m][k] = *(const PG8_LAS bf16x8*)(lds + PG8_SA(b, h) + aoff + m * 2048 + k * 1024); } while (0)
#define PG8_LDB(dst, b, h) do { _Pragma("unroll") for (int n = 0; n < 2; ++n) _Pragma("unroll") for (int k = 0; k < 2; ++k) dst[n][k] = *(const PG8_LAS bf16x8*)(lds + PG8_SB(b, h) + boff + n * 2048 + k * 1024); } while (0)
#define PG8_MMA(ai, bj, At, Bt) do { __builtin_amdgcn_s_setprio(1); _Pragma("unroll") for (int m = 0; m < 4; ++m) _Pragma("unroll") for (int n = 0; n < 2; ++n) _Pragma("unroll") for (int k = 0; k < 2; ++k) \
        acc[ai][bj][m][n] = __builtin_amdgcn_mfma_f32_16x16x32_bf16(Bt[n][k], At[m][k], acc[ai][bj][m][n], 0, 0, 0); __builtin_amdgcn_s_setprio(0); } while (0)
#define PG8_WAIT_V(n) asm volatile("s_waitcnt vmcnt(" #n ")" ::: "memory")
#define PG8_WAIT_L(n) asm volatile("s_waitcnt lgkmcnt(" #n ")" ::: "memory")
#define PG8_BAR __builtin_amdgcn_s_barrier()
#define PG8_SCHED __builtin_amdgcn_sched_barrier(0)
    Unit cur, nxt; int ui = 0;
    if (!S.next(0, cur)) return;
    f32x4 acc[2][2][4][2];
#pragma unroll
    for (int a = 0; a < 2; ++a)
#pragma unroll
        for (int b = 0; b < 2; ++b)
#pragma unroll
            for (int m = 0; m < 4; ++m)
#pragma unroll
                for (int n = 0; n < 2; ++n) acc[a][b][m][n] = (f32x4){0.f, 0.f, 0.f, 0.f};
    bf16x8 At[4][2], B0[2][2], B1[2][2];
    const char* cA = GATHER ? (const char*)g.A : (const char*)g.A + (size_t)cur.aoff * 2 + (size_t)cur.pm * tstep;
    if constexpr (GATHER) PG8_GROWS(cur, vA0, vA1); const char* cB = (const char*)g.Bt + (size_t)cur.boff * 2 + (size_t)cur.pn * tstep;
    S.a_ready(cur);
    if constexpr (SP2) {
        PG8_STAGE(PG8_SB(0, 0), cB, voffB); PG8_STAGE(PG8_SB(0, 1), cB + hstep, voffB); PG8_STAGE_A(PG8_SA(0, 0), cA, 0, 0); PG8_STAGE_A(PG8_SA(0, 1), cA, 1, 0);
        if (wr == 1) PG8_BAR;
        PG8_WAIT_V(2); PG8_BAR;
        PG8_STAGE(PG8_SB(1, 0), cB + kstep, voffB); PG8_STAGE_A(PG8_SA(1, 0), cA + kstep, 0, 0); PG8_STAGE(PG8_SB(1, 1), cB + hstep + kstep, voffB);
        PG8_WAIT_V(6); PG8_BAR;
    } else {
        PG8_STAGE(PG8_SB(0, 0), cB, voffB); PG8_STAGE_A(PG8_SA(0, 0), cA, 0, 0); PG8_STAGE(PG8_SB(0, 1), cB + hstep, voffB); PG8_STAGE_A(PG8_SA(0, 1), cA, 1, 0);
        if (wr == 1) PG8_BAR;
        PG8_WAIT_V(4); PG8_BAR;
        PG8_STAGE(PG8_SB(1, 0), cB + kstep, voffB); PG8_STAGE_A(PG8_SA(1, 0), cA + kstep, 0, 0); PG8_STAGE(PG8_SB(1, 1), cB + hstep + kstep, voffB);
        PG8_WAIT_V(6); PG8_BAR;
    }
    for (;;) {
        const bool has_next = S.next(ui + 1, nxt);
        const char* nA = GATHER ? (const char*)g.A : (has_next ? (const char*)g.A + (size_t)nxt.aoff * 2 + (size_t)nxt.pm * tstep : cA);
        if constexpr (GATHER) { if (has_next) PG8_GROWS(nxt, vN0, vN1); else { vN0[0] = vA0[0]; vN0[1] = vA0[1]; vN1[0] = vA1[0]; vN1[1] = vA1[1]; } } const char* nB = has_next ? (const char*)g.Bt + (size_t)nxt.boff * 2 + (size_t)nxt.pn * tstep : cB;
        for (int t = 0; t < nt; t += 2) {
            const bool last = (t == nt - 2);
            if constexpr (GATHER) { tN0[0] = last ? vN0[0] : vA0[0]; tN0[1] = last ? vN0[1] : vA0[1]; tN1[0] = last ? vN1[0] : vA1[0]; tN1[1] = last ? vN1[1] : vA1[1]; }
            const char* a1 = cA + (size_t)(t + 1) * kstep;
            const char* a2 = last ? nA : cA + (size_t)(t + 2) * kstep; const char* b2 = last ? nB : cB + (size_t)(t + 2) * kstep;
            const char* a3 = a2 + kstep; const char* b3 = b2 + kstep;
            if (last && has_next) S.a_ready(nxt);
            if constexpr (SP2) {
            PG8_LDB(B0, 0, 0); PG8_LDB(B1, 0, 1); PG8_SCHED; PG8_LDA(At, 0, 0); PG8_STAGE_A(PG8_SA(1, 1), a1, 1, 0);
            PG8_WAIT_V(8); PG8_WAIT_L(0); PG8_BAR; PG8_MMA(0, 0, At, B0); PG8_MMA(0, 1, At, B1); PG8_BAR; PG8_SCHED;
            PG8_LDA(At, 0, 1); PG8_STAGE(PG8_SB(0, 0), b2, voffB); PG8_STAGE(PG8_SB(0, 1), b2 + hstep, voffB); PG8_STAGE_A(PG8_SA(0, 0), a2, 0, 1);
            PG8_WAIT_V(8); PG8_WAIT_L(0); PG8_BAR; PG8_MMA(1, 0, At, B0); PG8_MMA(1, 1, At, B1); PG8_BAR; PG8_SCHED;
            PG8_LDB(B0, 1, 0); PG8_LDB(B1, 1, 1); PG8_SCHED; PG8_LDA(At, 1, 0); PG8_STAGE_A(PG8_SA(0, 1), a2, 1, 1);
            PG8_WAIT_V(8); PG8_WAIT_L(0); PG8_BAR; PG8_MMA(0, 0, At, B0); PG8_MMA(0, 1, At, B1); PG8_BAR; PG8_SCHED;
            PG8_LDA(At, 1, 1); PG8_STAGE(PG8_SB(1, 0), b3, voffB); PG8_STAGE(PG8_SB(1, 1), b3 + hstep, voffB); PG8_STAGE_A(PG8_SA(1, 0), a3, 0, 1);
            PG8_WAIT_V(8); PG8_WAIT_L(0); PG8_BAR; PG8_MMA(1, 0, At, B0); PG8_MMA(1, 1, At, B1); PG8_BAR; PG8_SCHED;
            } else {
            PG8_LDB(B0, 0, 0); PG8_SCHED; PG8_LDA(At, 0, 0); PG8_STAGE_A(PG8_SA(1, 1), a1, 1, 0);
            PG8_WAIT_L(8); PG8_BAR; PG8_WAIT_L(0); PG8_MMA(0, 0, At, B0); PG8_BAR; PG8_SCHED;
            PG8_LDB(B1, 0, 1); PG8_STAGE(PG8_SB(0, 0), b2, voffB);
            PG8_BAR; PG8_WAIT_L(0); PG8_MMA(0, 1, At, B1); PG8_BAR;
            PG8_LDA(At, 0, 1); PG8_STAGE_A(PG8_SA(0, 0), a2, 0, 1);
            PG8_BAR; PG8_WAIT_L(0); PG8_MMA(1, 0, At, B0); PG8_BAR; PG8_SCHED;
            PG8_STAGE(PG8_SB(0, 1), b2 + hstep, voffB);
            PG8_WAIT_V(6); PG8_BAR; PG8_MMA(1, 1, At, B1); PG8_BAR;
            PG8_LDB(B0, 1, 0); PG8_SCHED; PG8_LDA(At, 1, 0); PG8_STAGE_A(PG8_SA(0, 1), a2, 1, 1);
            PG8_WAIT_L(8); PG8_BAR; PG8_WAIT_L(0); PG8_MMA(0, 0, At, B0); PG8_BAR; PG8_SCHED;
            PG8_LDB(B1, 1, 1); PG8_STAGE(PG8_SB(1, 0), b3, voffB);
            PG8_BAR; PG8_WAIT_L(0); PG8_MMA(0, 1, At, B1); PG8_BAR;
            PG8_LDA(At, 1, 1); PG8_STAGE_A(PG8_SA(1, 0), a3, 0, 1);
            PG8_BAR; PG8_WAIT_L(0); PG8_MMA(1, 0, At, B0); PG8_BAR; PG8_SCHED;
            PG8_STAGE(PG8_SB(1, 1), b3 + hstep, voffB);
            PG8_WAIT_V(6); PG8_BAR; PG8_MMA(1, 1, At, B1); PG8_BAR;
            }
        }
        if constexpr (ALIGN_EPI) { if (wr == 0) PG8_BAR; }
        if constexpr (!Epi::AFTER_DRAIN) { E(acc, cur, wr, wc, fr, fq); S.done(cur); }
        if (!has_next) break;
#pragma unroll
        for (int a = 0; a < 2; ++a)
#pragma unroll
            for (int b = 0; b < 2; ++b)
#pragma unroll
                for (int m = 0; m < 4; ++m)
#pragma unroll
                    for (int n = 0; n < 2; ++n) acc[a][b][m][n] = (f32x4){0.f, 0.f, 0.f, 0.f};
        cur = nxt; cA = nA; cB = nB; ++ui;
        if constexpr (GATHER) { vA0[0] = vN0[0]; vA0[1] = vN0[1]; vA1[0] = vN1[0]; vA1[1] = vN1[1]; }
        if constexpr (ALIGN_EPI) { if (wr == 1) PG8_BAR; }
    }
    PG8_WAIT_V(0);
    if constexpr (!ALIGN_EPI) { if (wr == 0) PG8_BAR; }
    PG8_BAR;
    if constexpr (Epi::AFTER_DRAIN) { E.fused(acc, cur, wr, wc, fr, fq, lds, wid, lane); S.done(cur); }
#undef PG8_SA
#undef PG8_STAGE_A
#undef PG8_GROWS
#undef PG8_SB
#undef PG8_STAGE
#undef PG8_LDA
#undef PG8_LDB
#undef PG8_MMA
#undef PG8_WAIT_V
#undef PG8_WAIT_L
#undef PG8_BAR
#undef PG8_SCHED
}
}

constexpr int NB = 4, T = 4096, D = 1024, NTOK = NB * T;
constexpr int NEXP = 32, TOPK = 4, DFF = 1024;
constexpr int INW = 8792, NPROJ = 8960;
constexpr int NT_MAX = NTOK * TOPK / 256 + NEXP;
constexpr int PMAX = NT_MAX * 256;
constexpr float EPS = 1e-6f;
constexpr float QA_SCALE = 0.08838834764831845f * 1.4426950408889634f;
constexpr float QB_SCALE = 0.08838834764831845f;
constexpr int NWAVES = 8;

constexpr size_t MiB = 1u << 20;
constexpr size_t WS_CTL = 0, CTL_ZERO_BYTES = 1 * MiB;
constexpr size_t WS_MOD = 1 * MiB;
constexpr size_t WS_TOKE = 2 * MiB, WS_TOKR = WS_TOKE + 256 * 1024, WS_TOKW = WS_TOKR + 256 * 1024, WS_TOKP = WS_TOKW + 256 * 1024;
constexpr size_t WS_TILEE = 3 * MiB;
constexpr size_t WS_DEC = 3 * MiB + 256 * 1024;
constexpr size_t WS_WINT = 4 * MiB, WS_WAT = 22 * MiB, WS_WBT = 24 * MiB, WS_WOT = 26 * MiB, WS_WGUT = 28 * MiB, WS_WDT = 156 * MiB;
constexpr size_t WS_XN = 220 * MiB;
constexpr size_t WS_QA = 252 * MiB, WS_KA = 284 * MiB, WS_VA = 316 * MiB;
constexpr size_t WS_QI = 348 * MiB, WS_QB = 364 * MiB, WS_KB = 380 * MiB;
constexpr size_t WS_VB = 396 * MiB, WS_GB = 428 * MiB, WS_GA = 460 * MiB, WS_GBM = 492 * MiB;
constexpr size_t WS_KI = 524 * MiB;
constexpr size_t WS_SMALL = 526 * MiB;
constexpr size_t WS_MASK = 528 * MiB;
constexpr size_t WS_KVC = 536 * MiB;
constexpr size_t WS_SC = 664 * MiB;
constexpr size_t WS_YA = 728 * MiB, WS_YB = 760 * MiB;
constexpr size_t WS_X1 = 792 * MiB;
constexpr size_t WS_YS = 856 * MiB;
constexpr size_t WS_PTOK = 1000 * MiB;
constexpr size_t WS_END = 1002 * MiB;
constexpr size_t WS_QE = WS_XN, WS_KE = WS_XN + 16 * MiB;
constexpr size_t WS_MERGED = WS_XN, WS_TMPA = WS_QA  , WS_H2 = WS_QA, WS_XS = WS_VA  , WS_ACT = WS_KVC;
static_assert(WS_ACT + (size_t)PMAX * 1024 * 2 <= WS_YA && WS_YS + (size_t)PMAX * 1024 * 2 <= WS_PTOK, "overlays");
constexpr int CW_BAR = 4096;
constexpr int CW_ECNT = 8192;

constexpr int LDS_BYTES = 155648;
constexpr int MOE_TAB_OFF = 135168;
constexpr int LDSCTL_OFF = 154624;

#define GAS __attribute__((address_space(1)))
#define LAS __attribute__((address_space(3)))
typedef unsigned short bf16;
typedef unsigned v4u __attribute__((ext_vector_type(4)));
typedef unsigned v2u __attribute__((ext_vector_type(2)));
typedef float f32x4 __attribute__((ext_vector_type(4)));
typedef float f32x16 __attribute__((ext_vector_type(16)));
typedef short bf16x8 __attribute__((ext_vector_type(8)));
typedef short s16x4 __attribute__((ext_vector_type(4)));
typedef GAS unsigned gu32;
typedef unsigned long long u64;
#define LDS_WAIT() asm volatile("s_waitcnt lgkmcnt(0)" ::: "memory")
#define VM_WAIT() asm volatile("s_waitcnt vmcnt(0)" ::: "memory")
#define SBAR() __builtin_amdgcn_sched_barrier(0)
typedef float f32x2_t __attribute__((ext_vector_type(2)));
typedef __bf16 bf16x2_t __attribute__((ext_vector_type(2)));
__device__ __forceinline__ unsigned pk2(float lo, float hi) { const f32x2_t v = {lo, hi}; const bf16x2_t b = __builtin_convertvector(v, bf16x2_t); return __builtin_bit_cast(unsigned, b); }
__device__ __forceinline__ unsigned f2bf(float f) { return pk2(f, f) & 0xffffu; }
__device__ __forceinline__ float bf2f(unsigned short h) { return __builtin_bit_cast(float, (unsigned)h << 16); }
__device__ __forceinline__ float bflo(unsigned w) { return __builtin_bit_cast(float, w << 16); }
__device__ __forceinline__ float bfhi(unsigned w) { return __builtin_bit_cast(float, w & 0xffff0000u); }
__device__ __forceinline__ unsigned cvtpk(float lo, float hi) { return pk2(lo, hi); }
__device__ __forceinline__ float wave_sum(float v) {
#pragma unroll
    for (int o = 1; o < 64; o <<= 1) v += __shfl_xor(v, o);
    return v;
}
__device__ __forceinline__ float sigmoidf_(float x) { return 1.f / (1.f + __expf(-x)); }

#define XB_TMO      128
#define XB_XCNT(j)  (256  + 64 * (j))
#define XB_XSUB(j)  (1280 + 64 * (j))
#define XB_XGEN(j)  (2304 + 64 * (j))
#define XB_TOP      3328
#define XB_TOPGEN   3392
#define XCD_BAR_WORDS 3456
#define XB_SPIN_CAP (1u << 18)

__device__ __forceinline__ unsigned xb_ld(unsigned* p)              { return __hip_atomic_load(p, __ATOMIC_RELAXED, __HIP_MEMORY_SCOPE_AGENT); }
__device__ __forceinline__ unsigned xb_add(unsigned* p, unsigned v) { return __hip_atomic_fetch_add(p, v, __ATOMIC_RELAXED, __HIP_MEMORY_SCOPE_AGENT); }
__device__ __forceinline__ unsigned xb_xcc_id() { return (unsigned)__builtin_amdgcn_s_getreg((3 << 11) | 20) & 0xFu; }
#define XB_SPIN(cond, bar) do { unsigned _sp = 0; while (cond) { __builtin_amdgcn_s_sleep(1); \
    if ((++_sp & 255u) == 0u) { if (xb_ld(&(bar)[XB_TMO])) break; if (_sp > XB_SPIN_CAP) { atomicAdd(&(bar)[XB_TMO], 1u); break; } } } } while (0)

struct XcdBarrier {
    unsigned* bar; unsigned x;
    volatile LAS unsigned* st;
};

__device__ __forceinline__ XcdBarrier xcd_barrier_post(unsigned* bar, volatile LAS unsigned* st) {
    XcdBarrier b; b.bar = bar; b.x = xb_xcc_id(); b.st = st;
    if (threadIdx.x == 0) (void)xb_add(&bar[XB_XCNT(b.x)], 1u);
    return b;
}
__device__ __forceinline__ void xcd_barrier_complete(unsigned* bar, unsigned x, unsigned& nloc, unsigned& nx) {
    const unsigned G = gridDim.x * gridDim.y * gridDim.z;
    unsigned sum, cnt, mine, sp = 0u;
    for (;;) {
        sum = 0u; cnt = 0u; mine = 0u;
#pragma unroll
        for (unsigned j = 0; j < 16; ++j) { const unsigned c = xb_ld(&bar[XB_XCNT(j)]); sum += c; cnt += (c > 0u) ? 1u : 0u; mine = (j == x) ? c : mine; }
        if (sum == G) break;
        __builtin_amdgcn_s_sleep(1);
        if ((++sp & 255u) == 0u) { if (xb_ld(&bar[XB_TMO])) break; if (sp > XB_SPIN_CAP) { atomicAdd(&bar[XB_TMO], 1u); break; } }
    }
    nloc = mine > 0u ? mine : 1u; nx = cnt > 0u ? cnt : 1u;
}

__device__ __forceinline__ void xcd_barrier(const XcdBarrier& b) {
    asm volatile("s_waitcnt vmcnt(0)" ::: "memory");
    __syncthreads();
    if (threadIdx.x == 0) {
        unsigned* bar = b.bar;
        __builtin_amdgcn_s_waitcnt(0);
        unsigned nloc = b.st[0], nx = b.st[1];
        if (nloc == 0u) { xcd_barrier_complete(bar, b.x, nloc, nx); b.st[0] = nloc; b.st[1] = nx; }
        const unsigned old = xb_add(&bar[XB_XSUB(b.x)], 1u);
        const unsigned gen = old / nloc;
        if (old + 1u == (gen + 1u) * nloc) {
            __builtin_amdgcn_fence(__ATOMIC_RELEASE, "agent");
            asm volatile("s_waitcnt vmcnt(0)" ::: "memory");
            const unsigned og = xb_add(&bar[XB_TOP], 1u);
            const unsigned tg = og / nx;
            if (og + 1u == (tg + 1u) * nx) xb_add(&bar[XB_TOPGEN], 1u);
            else XB_SPIN(xb_ld(&bar[XB_TOPGEN]) == tg, bar);
            __builtin_amdgcn_fence(__ATOMIC_ACQUIRE, "agent");
            xb_add(&bar[XB_XGEN(b.x)], 1u);
            asm volatile("s_waitcnt vmcnt(0)" ::: "memory");
        } else {
            XB_SPIN(xb_ld(&bar[XB_XGEN(b.x)]) == gen, bar);
            __builtin_amdgcn_fence(__ATOMIC_ACQUIRE, "agent");
            asm volatile("s_waitcnt vmcnt(0)" ::: "memory");
        }
    }
    __syncthreads();
}

struct Ctx {
    LAS unsigned char* lds;
    unsigned char* ws;
    int tid, lane, wave;
    int bid, G;
    int gw, NGW;
};

__device__ __forceinline__ int win_src_col(int n) {
    if (n < 3584) return n;
    if (n < 6656) return n - 3584 + 3656;
    if (n < 8704) return n - 6656 + 6744;
    if (n < 8768) return n - 8704 + 3584;
    if (n < 8776) return n - 8768 + 3648;
    if (n < 8792) return n - 8776 + 6728;
    return -1;
}
__device__ __forceinline__ void tr_item(const float* Wcol, size_t ldw, int K, bf16* WT0, LAS float* scr, int lane) {
#pragma unroll 8
    for (int i = 0; i < 32; ++i) { const int kk = 2 * i + (lane >> 5); scr[kk * 33 + (lane & 31)] = Wcol ? Wcol[(size_t)kk * ldw] : 0.f; }
    LDS_WAIT(); asm volatile("" ::: "memory");
    const int c = lane & 7;
#pragma unroll
    for (int j = 0; j < 4; ++j) { const int n = (lane >> 3) + 8 * j; const LAS float* s = scr + (8 * c) * 33 + n;
        v4u o; o.x = pk2(s[0 * 33], s[1 * 33]); o.y = pk2(s[2 * 33], s[3 * 33]); o.z = pk2(s[4 * 33], s[5 * 33]); o.w = pk2(s[6 * 33], s[7 * 33]);
        *(GAS v4u*)(WT0 + (size_t)n * K + 8 * c) = o; }
    LDS_WAIT(); asm volatile("" ::: "memory");
}
constexpr int TR_PITCH = 65, TR_SCR_BYTES = 64 * TR_PITCH * 4  , P0_SIL_OFF = 8 * TR_SCR_BYTES  ;
static_assert(P0_SIL_OFF + 16384 <= LDSCTL_OFF, "prologue LDS map");
__device__ __forceinline__ void tr_item64(const float* W0, size_t ldw, int K, bf16* WT0, LAS float* scr, int lane) {
    const int r4 = lane >> 4, c4 = lane & 15;
    f32x4 v[16];
#pragma unroll
    for (int i = 0; i < 16; ++i) v[i] = *(const f32x4*)(W0 + (size_t)(4 * i + r4) * ldw + 4 * c4);
#pragma unroll
    for (int i = 0; i < 16; ++i) { LAS float* p = scr + (4 * i + r4) * TR_PITCH + 4 * c4; p[0] = v[i].x; p[1] = v[i].y; p[2] = v[i].z; p[3] = v[i].w; }
    LDS_WAIT(); asm volatile("" ::: "memory");
    const int c = lane & 7, nl = lane >> 3;
#pragma unroll
    for (int j = 0; j < 8; ++j) { const int n = nl + 8 * j; const LAS float* s = scr + (8 * c) * TR_PITCH + n;
        v4u o; o.x = pk2(s[0 * TR_PITCH], s[1 * TR_PITCH]); o.y = pk2(s[2 * TR_PITCH], s[3 * TR_PITCH]); o.z = pk2(s[4 * TR_PITCH], s[5 * TR_PITCH]); o.w = pk2(s[6 * TR_PITCH], s[7 * TR_PITCH]);
        *(GAS v4u*)(WT0 + (size_t)n * K + 8 * c) = o; }
    LDS_WAIT(); asm volatile("" ::: "memory");
}
__device__ __forceinline__ void moe_item_ptrs(int r, const float* w_gu, const float* w_dn, unsigned char* ws, const float*& W0, int& ldw, int& K, bf16*& WT0) {
    constexpr int J_GU = NEXP * 16 * 32;
    if (r < J_GU) { const int e = r / 512; r -= e * 512; const int kb = r / 32, n0 = 64 * (r % 32), pn = n0 >> 8, i0 = n0 & 255, sc0 = i0 < 128 ? 128 * pn + i0 : 1024 + 128 * pn + (i0 - 128);
        W0 = w_gu + (size_t)e * D * 2048 + (size_t)(64 * kb) * 2048 + sc0; ldw = 2048; K = D; WT0 = (bf16*)(ws + WS_WGUT) + (size_t)e * 2048 * D + (size_t)n0 * D + 64 * kb; }
    else { r -= J_GU; const int e = r / 256; r -= e * 256; const int kb = r / 16, nb = r % 16;
        W0 = w_dn + (size_t)e * DFF * D + (size_t)(64 * kb) * D + 64 * nb; ldw = D; K = DFF; WT0 = (bf16*)(ws + WS_WDT) + (size_t)e * D * DFF + (size_t)(64 * nb) * DFF + 64 * kb; }
}
__device__ __forceinline__ void tr_store64(const f32x4 (&v)[16], int K, bf16* WT0, LAS float* scr, int lane) {
    const int r4 = lane >> 4, c4 = lane & 15;
#pragma unroll
    for (int i = 0; i < 16; ++i) { LAS float* p = scr + (4 * i + r4) * TR_PITCH + 4 * c4; p[0] = v[i].x; p[1] = v[i].y; p[2] = v[i].z; p[3] = v[i].w; }
    LDS_WAIT(); asm volatile("" ::: "memory");
    const int c = lane & 7, nl = lane >> 3;
#pragma unroll
    for (int j = 0; j < 8; ++j) { const int n = nl + 8 * j; const LAS float* s = scr + (8 * c) * TR_PITCH + n;
        v4u o; o.x = pk2(s[0 * TR_PITCH], s[1 * TR_PITCH]); o.y = pk2(s[2 * TR_PITCH], s[3 * TR_PITCH]); o.z = pk2(s[4 * TR_PITCH], s[5 * TR_PITCH]); o.w = pk2(s[6 * TR_PITCH], s[7 * TR_PITCH]);
        *(GAS v4u*)(WT0 + (size_t)n * K + 8 * c) = o; }
    LDS_WAIT(); asm volatile("" ::: "memory");
}
__device__ __forceinline__ void tr_scatter64(const f32x4 (&v)[16], LAS float* scr, int lane) {
    const int r4 = lane >> 4, c4 = lane & 15;
#pragma unroll
    for (int i = 0; i < 16; ++i) { LAS float* p = scr + (4 * i + r4) * TR_PITCH + 4 * c4; p[0] = v[i].x; p[1] = v[i].y; p[2] = v[i].z; p[3] = v[i].w; }
}
__device__ __forceinline__ void tr_gather64(int K, bf16* WT0, LAS float* scr, int lane) {
    LDS_WAIT(); asm volatile("" ::: "memory");
    const int c = lane & 7, nl = lane >> 3;
#pragma unroll
    for (int j = 0; j < 8; ++j) { const int n = nl + 8 * j; const LAS float* s = scr + (8 * c) * TR_PITCH + n;
        v4u o; o.x = pk2(s[0 * TR_PITCH], s[1 * TR_PITCH]); o.y = pk2(s[2 * TR_PITCH], s[3 * TR_PITCH]); o.z = pk2(s[4 * TR_PITCH], s[5 * TR_PITCH]); o.w = pk2(s[6 * TR_PITCH], s[7 * TR_PITCH]);
        *(GAS v4u*)(WT0 + (size_t)n * K + 8 * c) = o; }
    LDS_WAIT(); asm volatile("" ::: "memory");
}
__device__ __forceinline__ void moe_convert(const Ctx& F, const float* w_gu, const float* w_dn, int wi, int nw, int j_lo, int j_hi) {
    LAS float* scr = (LAS float*)(F.lds + F.wave * TR_SCR_BYTES);
    const int r4 = F.lane >> 4, c4 = F.lane & 15;
    const float* Wa; int lda, Ka; bf16* Ta; const float* Wb; int ldb, Kb; bf16* Tb;
    f32x4 va[16], vb[16];
#define MC_LOAD(V, W_, LD_) do { _Pragma("unroll") for (int i = 0; i < 16; ++i) V[i] = *(const f32x4*)(W_ + (size_t)(4 * i + r4) * LD_ + 4 * c4); } while (0)
    int ia = j_lo + wi, ib = ia + nw;
    if (ia < j_hi) { moe_item_ptrs(ia, w_gu, w_dn, F.ws, Wa, lda, Ka, Ta); MC_LOAD(va, Wa, lda); }
    if (ib < j_hi) { moe_item_ptrs(ib, w_gu, w_dn, F.ws, Wb, ldb, Kb, Tb); MC_LOAD(vb, Wb, ldb); }
    while (ia < j_hi) {
        tr_scatter64(va, scr, F.lane);
        { bf16* T_ = Ta; const int K_ = Ka; ia += 2 * nw; if (ia < j_hi) { moe_item_ptrs(ia, w_gu, w_dn, F.ws, Wa, lda, Ka, Ta); MC_LOAD(va, Wa, lda); } tr_gather64(K_, T_, scr, F.lane); }
        if (ib < j_hi) { tr_scatter64(vb, scr, F.lane);
            bf16* T_ = Tb; const int K_ = Kb; ib += 2 * nw; if (ib < j_hi) { moe_item_ptrs(ib, w_gu, w_dn, F.ws, Wb, ldb, Kb, Tb); MC_LOAD(vb, Wb, ldb); } tr_gather64(K_, T_, scr, F.lane); }
    }
#undef MC_LOAD
}
__device__ __forceinline__ void p0_prologue(const Ctx& F, const float* c_in, const float* w_ada, const float* b_ada, const float* w_in, const float* w_a, const float* w_b, const float* w_o,
                                            const float* w_gu, const float* w_dn, int moe_p0_items) {
    LAS float* scr = (LAS float*)(F.lds + F.wave * TR_SCR_BYTES);
    LAS float* sil = (LAS float*)(F.lds + P0_SIL_OFF);
    for (int i = F.tid; i < 4096; i += 512) { const float v = c_in[i]; sil[i] = v / (1.f + __expf(-v)); }
    __syncthreads();
    for (int it = F.NGW - 1 - F.gw; it < 384; it += F.NGW) {
        const int c4 = F.lane & 3, rg = F.lane >> 2, col = 16 * it + 4 * c4;
        f32x4 a0 = {0.f, 0.f, 0.f, 0.f}, a1 = a0, a2 = a0, a3 = a0;
        const float* wp = w_ada + (size_t)rg * 6144 + col;
#pragma unroll 16
        for (int i = 0; i < 64; ++i) { const int k = 16 * i + rg; const f32x4 w = *(const f32x4*)(wp + (size_t)i * 16 * 6144);
            a0 += w * sil[k]; a1 += w * sil[1024 + k]; a2 += w * sil[2048 + k]; a3 += w * sil[3072 + k]; }
#pragma unroll
        for (int o = 4; o < 64; o <<= 1) {
#pragma unroll
            for (int j = 0; j < 4; ++j) { a0[j] += __shfl_xor(a0[j], o); a1[j] += __shfl_xor(a1[j], o); a2[j] += __shfl_xor(a2[j], o); a3[j] += __shfl_xor(a3[j], o); } }
        if (F.lane < 4) { float* mod = (float*)(F.ws + WS_MOD); const f32x4 bb = *(const f32x4*)(b_ada + col);
            *(f32x4*)(mod + col) = a0 + bb; *(f32x4*)(mod + 6144 + col) = a1 + bb; *(f32x4*)(mod + 2 * 6144 + col) = a2 + bb; *(f32x4*)(mod + 3 * 6144 + col) = a3 + bb; }
    }
    constexpr int J_IN = 16 * 137, J_SQ = 16 * 16, NJ = J_IN + 3 * J_SQ;
    for (int it = F.gw; it < NJ; it += F.NGW) {
        int r = it; const float* W0; size_t ldw; int K; bf16* WT0;
        if (r < J_IN) { const int kb = r / 137, n0 = 64 * (r % 137); W0 = w_in + (size_t)(64 * kb) * INW + win_src_col(n0); ldw = INW; K = D; WT0 = (bf16*)(F.ws + WS_WINT) + (size_t)n0 * D + 64 * kb; }
        else { r -= J_IN; const int which = r / J_SQ; r -= which * J_SQ; const int kb = r / 16, nb = r % 16;
            W0 = (which == 0 ? w_a : (which == 1 ? w_b : w_o)) + (size_t)(64 * kb) * D + 64 * nb; ldw = D; K = D;
            WT0 = (bf16*)(F.ws + (which == 0 ? WS_WAT : (which == 1 ? WS_WBT : WS_WOT))) + (size_t)(64 * nb) * D + 64 * kb; }
        tr_item64(W0, ldw, K, WT0, scr, F.lane);
    }
    for (int it = F.gw; it < 16 * 6; it += F.NGW) { const int kb = it / 6, nb = 274 + it % 6; const int sc = win_src_col(32 * nb + (F.lane & 31));
        tr_item(sc >= 0 ? w_in + (size_t)(64 * kb) * INW + sc : nullptr, INW, D, (bf16*)(F.ws + WS_WINT) + (size_t)(32 * nb) * D + 64 * kb, scr, F.lane); }
    moe_convert(F, w_gu, w_dn, F.gw, F.NGW, 0, moe_p0_items);
}
__device__ __forceinline__ void p1_xn(const Ctx& F, const float* x, const float* g1) {
    const float* mod = (const float*)(F.ws + WS_MOD);
    bf16* XN = (bf16*)(F.ws + WS_XN);
    for (int r0 = 8 * F.gw; r0 < NTOK; r0 += 8 * F.NGW) {
        const int b = r0 / T; const float* mb = mod + b * 6144;
        f32x4 ga[4], sh[4];
#pragma unroll
        for (int j = 0; j < 4; ++j) { const int c = 4 * F.lane + 256 * j; const f32x4 g = *(const f32x4*)(g1 + c), s = *(const f32x4*)(mb + 1024 + c); ga[j] = g * (s + 1.0f); sh[j] = *(const f32x4*)(mb + c); }
        for (int rr = 0; rr < 8; rr += 4) {
            f32x4 v[4][4];
#pragma unroll
            for (int q = 0; q < 4; ++q) { const GAS f32x4* xr = (const GAS f32x4*)(x + (size_t)(r0 + rr + q) * D) + F.lane;
#pragma unroll
                for (int j = 0; j < 4; ++j) v[q][j] = xr[64 * j]; }
#pragma unroll
            for (int q = 0; q < 4; ++q) { float s = 0.f;
#pragma unroll
                for (int j = 0; j < 4; ++j) s += (v[q][j].x * v[q][j].x + v[q][j].y * v[q][j].y) + (v[q][j].z * v[q][j].z + v[q][j].w * v[q][j].w);
                const float rstd = 1.f / sqrtf(wave_sum(s) * (1.f / D) + EPS);
                GAS u64* o8 = (GAS u64*)(XN + (size_t)(r0 + rr + q) * D) + F.lane;
#pragma unroll
                for (int j = 0; j < 4; ++j) { const f32x4 h = v[q][j] * rstd * ga[j] + sh[j]; o8[64 * j] = (u64)pk2(h.x, h.y) | ((u64)pk2(h.z, h.w) << 32); } }
        }
    }
}
struct EpiProj {
    static constexpr bool PERM = true, AFTER_DRAIN = false;
    unsigned char* ws;
    __device__ __forceinline__ void operator()(const pg8::f32x4 (&acc)[2][2][4][2], const pg8::Unit& u, int wr, int wc, int fr, int fq) const {
        const int pn = u.pn, row0 = u.pm * 256 + wr * 64 + fr;
        if (pn < 34) {
            size_t off; int ld, ct; float sc = 1.f;
            if (pn < 12) { const int t = pn >> 2; off = WS_QA + (size_t)t * 32 * MiB; ld = 1024; ct = (pn & 3) * 256; if (t == 0) sc = QA_SCALE; }
            else if (pn < 18) { const int t = (pn - 12) >> 1; off = WS_QI + (size_t)t * 16 * MiB; ld = 512; ct = ((pn - 12) & 1) * 256; sc = t == 0 ? 0.125f : (t == 1 ? QB_SCALE : 1.f); }
            else { const int t = (pn - 18) >> 2; off = WS_VB + (size_t)t * 32 * MiB; ld = 1024; ct = ((pn - 18) & 3) * 256; }
            bf16* base = (bf16*)(ws + off); const int col0 = ct + wc * 32 + 8 * fq;
#pragma unroll
            for (int ai = 0; ai < 2; ++ai)
#pragma unroll
                for (int m = 0; m < 4; ++m) { bf16* rowp = base + (size_t)(row0 + ai * 128 + m * 16) * ld + col0;
#pragma unroll
                    for (int bj = 0; bj < 2; ++bj) { const pg8::f32x4 v0 = acc[ai][bj][m][0] * sc, v1 = acc[ai][bj][m][1] * sc;
                        v4u w; w.x = cvtpk(v0[0], v0[1]); w.y = cvtpk(v0[2], v0[3]); w.z = cvtpk(v1[0], v1[1]); w.w = cvtpk(v1[2], v1[3]);
                        *(v4u*)(rowp + bj * 128) = w; } }
        } else {
            if (wc < 2) { bf16* KI = (bf16*)(ws + WS_KI);
#pragma unroll
                for (int ai = 0; ai < 2; ++ai)
#pragma unroll
                    for (int m = 0; m < 4; ++m) { const pg8::f32x4 v0 = acc[ai][0][m][0], v1 = acc[ai][0][m][1];
                        v4u w; w.x = cvtpk(v0[0], v0[1]); w.y = cvtpk(v0[2], v0[3]); w.z = cvtpk(v1[0], v1[1]); w.w = cvtpk(v1[2], v1[3]);
                        *(v4u*)(KI + (size_t)(row0 + ai * 128 + m * 16) * 64 + wc * 32 + 8 * fq) = w; } }
            else if (wc == 2) { float* SM = (float*)(ws + WS_SMALL);
#pragma unroll
                for (int ai = 0; ai < 2; ++ai)
#pragma unroll
                    for (int m = 0; m < 4; ++m) { float* p = SM + (size_t)(row0 + ai * 128 + m * 16) * 32 + 8 * fq;
                        *(f32x4*)p = acc[ai][0][m][0]; *(f32x4*)(p + 4) = acc[ai][0][m][1]; } }
        }
    }
};

constexpr int IDX_ROWB = 8192 + 16, IDX_HIST_OFF = 16 * IDX_ROWB  ;
static_assert(IDX_HIST_OFF + 16 * 1024 <= LDSCTL_OFF, "indexer LDS map");
__device__ __forceinline__ unsigned quant16(float f) {
    const float a = fminf(fabsf(f), 127.f);
    const unsigned code = (__builtin_bit_cast(unsigned, a + 0.00390625f) - 0x3B800000u) >> 12;
    return (f >= 0.f) ? (0x8000u | code) : (0x7FFFu - code);
}
#define WSYNC() do { asm volatile("s_waitcnt lgkmcnt(0)" ::: "memory"); __builtin_amdgcn_wave_barrier(); } while (0)
__device__ __forceinline__ void radix_scan(LAS unsigned* hist, int lane, unsigned need, unsigned& bin, unsigned& cgt) {
    const v4u hv = *(LAS v4u*)(hist + 4 * lane); const unsigned s = hv.x + hv.y + hv.z + hv.w;
    unsigned suf = s;
#pragma unroll
    for (int o = 1; o < 64; o <<= 1) { const unsigned t = __shfl_down(suf, o); if (lane + o < 64) suf += t; }
    const u64 bal = __ballot(suf >= need); const int L = bal ? 63 - __builtin_clzll(bal) : 0;
    const unsigned above = suf - s, c3 = above + hv.w, c2 = c3 + hv.z, c1 = c2 + hv.y;
    unsigned bsel, cg;
    if (c3 >= need) { bsel = 3; cg = above; } else if (c2 >= need) { bsel = 2; cg = c3; } else if (c1 >= need) { bsel = 1; cg = c2; } else { bsel = 0; cg = c1; }
    bin = __shfl(4 * lane + bsel, L); cgt = __shfl(cg, L);
}
__device__ __forceinline__ void p3_indexer(const Ctx& F) {
    const bf16* QI = (const bf16*)(F.ws + WS_QI); const bf16* KI = (const bf16*)(F.ws + WS_KI); const float* SM = (const float*)(F.ws + WS_SMALL);
    u64* MASKT = (u64*)(F.ws + WS_MASK);
    const int lane = F.lane, l15 = lane & 15, g = lane >> 4;
    for (int it = F.bid; it < 1024; it += F.G) {
        int lz = 0; asm volatile("" : "+v"(lz));
        LAS unsigned char* L = F.lds + lz;
        LAS unsigned* histq = (LAS unsigned*)(L + IDX_HIST_OFF);
        const int r = it >> 8, cc = it & 255, b = r, u = (r & 1) ? 255 - cc : cc;
        const int q0 = 16 * u, nvis = ((q0 >> 6) + 1) * 64, ntile = nvis >> 6; const size_t tb = (size_t)b * T;
        if (nvis <= 256) {
            for (int idx = F.tid; idx < 1024; idx += 512) *(LAS u64*)(histq + (idx >> 6) * 256 + 2 * (idx & 63)) = ((idx & 63) < ntile) ? ~0ull : 0ull;
        } else {
            for (int idx = F.tid; idx < 1024; idx += 512) *(LAS v4u*)(histq + 4 * idx) = (v4u){0u, 0u, 0u, 0u};
            bf16x8 bq[8][2]; float wq[8];
            { const bf16* qp = QI + (tb + q0 + l15) * 512 + 8 * g; const float* wp = SM + (tb + q0 + l15) * 32;
#pragma unroll
              for (int h = 0; h < 8; ++h) { bq[h][0] = *(const bf16x8*)(qp + h * 64); bq[h][1] = *(const bf16x8*)(qp + h * 64 + 32); wq[h] = wp[h] * 0.35355339059327373f; } }
            __syncthreads();
            LAS unsigned* hq = histq + l15 * 256;
            const int ntl = nvis >> 4;
            for (int j0 = F.wave; j0 < ntl; j0 += 32) {
                bf16x8 ka[4][2];
#pragma unroll
                for (int u4 = 0; u4 < 4; ++u4) { const int j = (j0 + 8 * u4 < ntl) ? j0 + 8 * u4 : j0; const bf16* kp = KI + (tb + 16 * j + l15) * 64 + 8 * g;
                    ka[u4][0] = *(const bf16x8*)kp; ka[u4][1] = *(const bf16x8*)(kp + 32); }
#pragma unroll
                for (int u4 = 0; u4 < 4; ++u4) { const int j = j0 + 8 * u4;
                    if (j < ntl) { const int key0 = 16 * j;
                        float s0 = 0.f, s1 = 0.f, s2 = 0.f, s3 = 0.f;
#pragma unroll
                        for (int h = 0; h < 8; ++h) { f32x4 c = {0.f, 0.f, 0.f, 0.f};
                            c = __builtin_amdgcn_mfma_f32_16x16x32_bf16(ka[u4][0], bq[h][0], c, 0, 0, 0); c = __builtin_amdgcn_mfma_f32_16x16x32_bf16(ka[u4][1], bq[h][1], c, 0, 0, 0);
                            s0 = fmaf(wq[h], fmaxf(c[0], 0.f), s0); s1 = fmaf(wq[h], fmaxf(c[1], 0.f), s1); s2 = fmaf(wq[h], fmaxf(c[2], 0.f), s2); s3 = fmaf(wq[h], fmaxf(c[3], 0.f), s3); }
                        const unsigned c0 = quant16(s0), c1 = quant16(s1), c2 = quant16(s2), c3 = quant16(s3);
                        v2u w; w.x = c0 | (c1 << 16); w.y = c2 | (c3 << 16);
                        *(LAS v2u*)(L + l15 * IDX_ROWB + (key0 + 4 * g) * 2) = w;
                        __hip_atomic_fetch_add(hq + (c0 >> 8), 1u, __ATOMIC_RELAXED, __HIP_MEMORY_SCOPE_WORKGROUP); __hip_atomic_fetch_add(hq + (c1 >> 8), 1u, __ATOMIC_RELAXED, __HIP_MEMORY_SCOPE_WORKGROUP);
                        __hip_atomic_fetch_add(hq + (c2 >> 8), 1u, __ATOMIC_RELAXED, __HIP_MEMORY_SCOPE_WORKGROUP); __hip_atomic_fetch_add(hq + (c3 >> 8), 1u, __ATOMIC_RELAXED, __HIP_MEMORY_SCOPE_WORKGROUP); } }
            }
            __syncthreads();
            const int nblk = (ntile + 7) >> 3;
            for (int qq = 0; qq < 2; ++qq) {
                const int q = 2 * F.wave + qq; LAS unsigned char* rowp = L + q * IDX_ROWB; LAS unsigned* hist = histq + q * 256;
                unsigned b1, cgt1; radix_scan(hist, lane, 256u, b1, cgt1); WSYNC();
                const unsigned r1 = 256u - cgt1;
                *(LAS v4u*)(hist + 4 * lane) = (v4u){0u, 0u, 0u, 0u}; WSYNC();
                for (int i = 0; i < nblk; ++i) {
                    const v4u v = *(LAS v4u*)(rowp + (i * 512 + 8 * lane) * 2); const int kbase = i * 512 + 8 * lane;
#define LVL2(W, KO) { if (kbase + (KO) < nvis) { if ((((W) >> 8) & 255u) == b1) __hip_atomic_fetch_add(hist + ((W) & 255u), 1u, __ATOMIC_RELAXED, __HIP_MEMORY_SCOPE_WORKGROUP); \
                                                   if (((W) >> 24) == b1) __hip_atomic_fetch_add(hist + (((W) >> 16) & 255u), 1u, __ATOMIC_RELAXED, __HIP_MEMORY_SCOPE_WORKGROUP); } }
                    LVL2(v.x, 0) LVL2(v.y, 2) LVL2(v.z, 4) LVL2(v.w, 6)
#undef LVL2
                }
                WSYNC();
                unsigned b2, cgt2; radix_scan(hist, lane, r1, b2, cgt2); WSYNC();
                const unsigned thr = (b1 << 8) | b2, rr = r1 - cgt2;
                unsigned eqrun = 0u; u64 mword = 0ull;
                for (int i = 0; i < nblk; ++i) {
                    unsigned code[8];
#pragma unroll
                    for (int j = 0; j < 8; ++j) code[j] = *(LAS unsigned short*)(rowp + ((8 * i + j) * 64 + lane) * 2);
#pragma unroll
                    for (int j = 0; j < 8; ++j) { const int t = 8 * i + j;
                        if (t < ntile) { u64 m = __ballot(code[j] > thr); const u64 em = __ballot(code[j] == thr);
                            if (em) { const unsigned pre = __builtin_amdgcn_mbcnt_hi((unsigned)(em >> 32), __builtin_amdgcn_mbcnt_lo((unsigned)em, 0u));
                                m |= __ballot(code[j] == thr && (eqrun + pre) < rr); eqrun += (unsigned)__popcll(em); }
                            if (lane == t) mword = m; } }
                }
                WSYNC(); *(LAS u64*)(hist + 2 * lane) = mword;
            }
        }
        __syncthreads();
        for (int idx = F.tid; idx < 1024; idx += 512) { const int t = idx >> 4, q = idx & 15; MASKT[((size_t)b * 64 + t) * T + q0 + q] = *(LAS u64*)(histq + q * 256 + 2 * t); }
        __syncthreads();
    }
}

typedef short v4i16_t __attribute__((ext_vector_type(4)));
__device__ __forceinline__ s16x4 trrd(const LAS unsigned char* p) { return __builtin_bit_cast(s16x4, __builtin_amdgcn_ds_read_tr16_b64_v4i16((LAS v4i16_t*)p)); }
__device__ __forceinline__ bf16x8 cat8(s16x4 lo, s16x4 hi) { return (bf16x8){lo[0], lo[1], lo[2], lo[3], hi[0], hi[1], hi[2], hi[3]}; }
constexpr int G1_LR = 0, G1_TOT = 4096, G1_KD = 8192, G1_KDP = 272, G1_V = G1_KD + 64 * G1_KDP  , G1_VP = 528, G1_Q = G1_V + 64 * G1_VP  , G1_K = G1_Q + 64 * G1_KDP  ;
__device__ __forceinline__ void p3_gla1(const Ctx& F, const float* w_gate_lr, const float* b_gate) {
    const bf16* QB = (const bf16*)(F.ws + WS_QB); const bf16* KB = (const bf16*)(F.ws + WS_KB); bf16* QE = (bf16*)(F.ws + WS_QE); bf16* KE = (bf16*)(F.ws + WS_KE);
    const bf16* VB = (const bf16*)(F.ws + WS_VB); const float* SM = (const float*)(F.ws + WS_SMALL);
    bf16* KVC = (bf16*)(F.ws + WS_KVC); float* DEC = (float*)(F.ws + WS_DEC);
    const int d = F.tid & 127, tq = F.tid >> 7, lane = F.lane, l15 = lane & 15, g = lane >> 4, q4 = l15 >> 2, p4 = lane & 3;
    LAS float* lrs = (LAS float*)(F.lds + G1_LR); LAS float* tot = (LAS float*)(F.lds + G1_TOT);
    const int t16 = F.tid >> 4, p16 = F.tid & 15, t32 = F.tid >> 5, p32 = F.tid & 31;
    float rl0, rl1; v4u rq[2], rk[2], rv[4];
#define G1_LOAD(IT) do { const int bh_ = (IT) >> 6, c_ = (IT) & 63, b_ = bh_ >> 2, h_ = bh_ & 3; const size_t tk_ = (size_t)b_ * T + 64 * c_; \
        rl0 = SM[(tk_ + (F.tid >> 4)) * 32 + 8 + (F.tid & 15)]; rl1 = SM[(tk_ + 32 + (F.tid >> 4)) * 32 + 8 + (F.tid & 15)]; \
        _Pragma("unroll") for (int j = 0; j < 2; ++j) { const size_t o_ = (tk_ + t16 + 32 * j) * 512 + h_ * 128 + 8 * p16; rq[j] = *(const v4u*)(QB + o_); rk[j] = *(const v4u*)(KB + o_); } \
        _Pragma("unroll") for (int j = 0; j < 4; ++j) rv[j] = *(const v4u*)(VB + (tk_ + t32 + 16 * j) * 1024 + h_ * 256 + 8 * p32); } while (0)
    int it = F.bid;
    if (it < 1024) G1_LOAD(it);
    for (; it < 1024; it += F.G) {
        const int bh = it >> 6, c = it & 63, b = bh >> 2, h = bh & 3; const size_t tok0 = (size_t)b * T + 64 * c;
        lrs[F.tid] = rl0; lrs[512 + F.tid] = rl1;
#pragma unroll
        for (int j = 0; j < 2; ++j) { *(LAS v4u*)(F.lds + G1_Q + (t16 + 32 * j) * G1_KDP + 16 * p16) = rq[j]; *(LAS v4u*)(F.lds + G1_K + (t16 + 32 * j) * G1_KDP + 16 * p16) = rk[j]; }
#pragma unroll
        for (int j = 0; j < 4; ++j) *(LAS v4u*)(F.lds + G1_V + (t32 + 16 * j) * G1_VP + 16 * p32) = rv[j];
        float wg[16];
#pragma unroll
        for (int r = 0; r < 16; ++r) wg[r] = w_gate_lr[r * 512 + h * 128 + d];
        const float bg = b_gate[h * 128 + d];
        __syncthreads();
        { const int itn = it + F.G; if (itn < 1024) G1_LOAD(itn); }
        float Gl[16]; float run = 0.f;
#pragma unroll
        for (int i = 0; i < 16; ++i) { const int t = 16 * tq + i; float z = bg;
#pragma unroll
            for (int r4 = 0; r4 < 4; ++r4) { const f32x4 l = *(LAS f32x4*)(lrs + t * 16 + 4 * r4); z = fmaf(l.x, wg[4 * r4], z); z = fmaf(l.y, wg[4 * r4 + 1], z); z = fmaf(l.z, wg[4 * r4 + 2], z); z = fmaf(l.w, wg[4 * r4 + 3], z); }
            const float la = (fminf(z, 0.f) - log1pf(__expf(-fabsf(z)))) * 0.0625f; run += la; Gl[i] = run; }
        tot[tq * 128 + d] = run;
        __syncthreads();
        float offs = 0.f, glast = 0.f;
#pragma unroll
        for (int qd = 0; qd < 4; ++qd) { const float v = tot[qd * 128 + d]; if (qd < tq) offs += v; glast += v; }
#pragma unroll
        for (int i = 0; i < 16; ++i) { const int t = 16 * tq + i; const float G = Gl[i] + offs;
            LAS unsigned short* qp = (LAS unsigned short*)(F.lds + G1_Q + t * G1_KDP + d * 2); LAS unsigned short* kp = (LAS unsigned short*)(F.lds + G1_K + t * G1_KDP + d * 2);
            const float q = bf2f(*qp), k = bf2f(*kp);
            *qp = (unsigned short)f2bf(q * __expf(G)); *kp = (unsigned short)f2bf(k * __expf(-G));
            *(LAS unsigned short*)(F.lds + G1_KD + t * G1_KDP + d * 2) = (unsigned short)f2bf(k * __expf(glast - G)); }
        if (tq == 0) DEC[(size_t)(bh * 64 + c) * 128 + d] = __expf(glast);
        __syncthreads();
#pragma unroll
        for (int j = 0; j < 2; ++j) { const size_t o = (tok0 + t16 + 32 * j) * 512 + h * 128 + 8 * p16;
            *(v4u*)(QE + o) = *(LAS v4u*)(F.lds + G1_Q + (t16 + 32 * j) * G1_KDP + 16 * p16); *(v4u*)(KE + o) = *(LAS v4u*)(F.lds + G1_K + (t16 + 32 * j) * G1_KDP + 16 * p16); }
        const int m0 = 16 * F.wave; bf16x8 a[2];
#pragma unroll
        for (int s = 0; s < 2; ++s) { const LAS unsigned char* ap = F.lds + G1_KD + (32 * s + 8 * g + q4) * G1_KDP + (m0 + 4 * p4) * 2; a[s] = cat8(trrd(ap), trrd(ap + 4 * G1_KDP)); }
        bf16* out = KVC + (size_t)(bh * 64 + c) * 256 * 128;
#pragma unroll 4
        for (int nt = 0; nt < 16; ++nt) { f32x4 acc = {0.f, 0.f, 0.f, 0.f};
#pragma unroll
            for (int s = 0; s < 2; ++s) { const LAS unsigned char* bp = F.lds + G1_V + (32 * s + 8 * g + q4) * G1_VP + (16 * nt + 4 * p4) * 2; const bf16x8 bv = cat8(trrd(bp), trrd(bp + 4 * G1_VP));
                acc = __builtin_amdgcn_mfma_f32_16x16x32_bf16(a[s], bv, acc, 0, 0, 0); }
            { v2u w_; w_.x = pk2(acc[0], acc[1]); w_.y = pk2(acc[2], acc[3]); *(v2u*)(out + (size_t)(16 * nt + l15) * 128 + m0 + 4 * g) = w_; } }
        __syncthreads();
    }
#undef G1_LOAD
}
__device__ __forceinline__ void p4_scan(const Ctx& F) {
    const bf16* KVC = (const bf16*)(F.ws + WS_KVC); const float* DEC = (const float*)(F.ws + WS_DEC); bf16* SC = (bf16*)(F.ws + WS_SC);
    for (int e = F.bid * 512 + F.tid; e < 16 * 256 * 32; e += F.G * 512) {
        const int d4 = e & 31, v = (e >> 5) & 255, bh = e >> 13; f32x4 S = {0.f, 0.f, 0.f, 0.f};
#pragma unroll 8
        for (int c = 0; c < 64; ++c) { const size_t o = ((size_t)(bh * 64 + c) * 256 + v) * 128 + 4 * d4;
            const v2u kw = *(const v2u*)(KVC + o); const f32x4 kv = {bflo(kw.x), bfhi(kw.x), bflo(kw.y), bfhi(kw.y)}, dc = *(const f32x4*)(DEC + (size_t)(bh * 64 + c) * 128 + 4 * d4);
            v2u w; w.x = pk2(S.x, S.y); w.y = pk2(S.z, S.w); *(v2u*)(SC + o) = w;
            S = S * dc + kv; }
    }
}
constexpr int G3_QE = 0, G3_KE = 17408, G3_V = 34816, G3_GB = 68608, G3_AM = 102400, G3_AMP = 144, G3_SS = 111616;
__device__ __forceinline__ void p5_gla3(const Ctx& F, const float* gnorm_g) {
    const bf16* QB = (const bf16*)(F.ws + WS_QE); const bf16* KB = (const bf16*)(F.ws + WS_KE); const bf16* VB = (const bf16*)(F.ws + WS_VB); const bf16* GB = (const bf16*)(F.ws + WS_GB);
    const bf16* SC = (const bf16*)(F.ws + WS_SC); bf16* YB = (bf16*)(F.ws + WS_YB);
    const int lane = F.lane, l15 = lane & 15, g = lane >> 4, q4 = l15 >> 2, p4 = lane & 3, w = F.wave;
    LAS float* SS = (LAS float*)(F.lds + G3_SS);
    const int t16 = F.tid >> 4, p16 = F.tid & 15, t32 = F.tid >> 5, p32 = F.tid & 31;
    v4u rq[2], rk[2], rv[4], rg[4]; bf16x8 bS[2][4];
#define G3_LOAD(IT) do { const int bh_ = (IT) >> 6, c_ = (IT) & 63, b_ = bh_ >> 2, h_ = bh_ & 3; const size_t tk_ = (size_t)b_ * T + 64 * c_; \
        _Pragma("unroll") for (int j = 0; j < 2; ++j) { const size_t o_ = (tk_ + t16 + 32 * j) * 512 + h_ * 128 + 8 * p16; rq[j] = *(const v4u*)(QB + o_); rk[j] = *(const v4u*)(KB + o_); } \
        _Pragma("unroll") for (int j = 0; j < 4; ++j) { const size_t o_ = (tk_ + t32 + 16 * j) * 1024 + h_ * 256 + 8 * p32; rv[j] = *(const v4u*)(VB + o_); rg[j] = *(const v4u*)(GB + o_); } } while (0)
#define G3_LOADS(IT) do { _Pragma("unroll") for (int n = 0; n < 2; ++n) _Pragma("unroll") for (int s = 0; s < 4; ++s) \
        bS[n][s] = *(const bf16x8*)(SC + ((size_t)(IT) * 256 + 32 * w + 16 * n + l15) * 128 + 32 * s + 8 * g); } while (0)
    int it = F.bid;
    if (it < 1024) { G3_LOAD(it); G3_LOADS(it); }
    for (; it < 1024; it += F.G) {
        const int bh = it >> 6, c = it & 63, b = bh >> 2, h = bh & 3; const size_t tok0 = (size_t)b * T + 64 * c; const int itn = it + F.G;
#pragma unroll
        for (int j = 0; j < 2; ++j) { *(LAS v4u*)(F.lds + G3_QE + (t16 + 32 * j) * 272 + 16 * p16) = rq[j]; *(LAS v4u*)(F.lds + G3_KE + (t16 + 32 * j) * 272 + 16 * p16) = rk[j]; }
#pragma unroll
        for (int j = 0; j < 4; ++j) { *(LAS v4u*)(F.lds + G3_V + (t32 + 16 * j) * G1_VP + 16 * p32) = rv[j]; *(LAS v4u*)(F.lds + G3_GB + (t32 + 16 * j) * G1_VP + 16 * p32) = rg[j]; }
        __syncthreads();
        if (itn < 1024) G3_LOAD(itn);
        { const int mi = w >> 1, mj0 = 2 * (w & 1);
#pragma unroll
          for (int jj = 0; jj < 2; ++jj) { const int mj = mj0 + jj; f32x4 c4 = {0.f, 0.f, 0.f, 0.f};
              if (mj <= mi) {
#pragma unroll
                  for (int s = 0; s < 4; ++s) { const bf16x8 av = *(LAS bf16x8*)(F.lds + G3_QE + (16 * mi + l15) * 272 + (32 * s + 8 * g) * 2), bv = *(LAS bf16x8*)(F.lds + G3_KE + (16 * mj + l15) * 272 + (32 * s + 8 * g) * 2);
                      c4 = __builtin_amdgcn_mfma_f32_16x16x32_bf16(av, bv, c4, 0, 0, 0); } }
#pragma unroll
              for (int r = 0; r < 4; ++r) { const int i = 16 * mi + 4 * g + r, j = 16 * mj + l15; *(LAS unsigned short*)(F.lds + G3_AM + i * G3_AMP + j * 2) = (unsigned short)f2bf(j <= i ? c4[r] : 0.f); } } }
        __syncthreads();
        f32x4 acc[4][2];
#pragma unroll
        for (int m = 0; m < 4; ++m) { acc[m][0] = (f32x4){0.f, 0.f, 0.f, 0.f}; acc[m][1] = (f32x4){0.f, 0.f, 0.f, 0.f}; }
#pragma unroll
        for (int s = 0; s < 4; ++s)
#pragma unroll
            for (int m = 0; m < 4; ++m) { const bf16x8 av = *(LAS bf16x8*)(F.lds + G3_QE + (16 * m + l15) * 272 + (32 * s + 8 * g) * 2);
                acc[m][0] = __builtin_amdgcn_mfma_f32_16x16x32_bf16(av, bS[0][s], acc[m][0], 0, 0, 0); acc[m][1] = __builtin_amdgcn_mfma_f32_16x16x32_bf16(av, bS[1][s], acc[m][1], 0, 0, 0); }
        if (itn < 1024) G3_LOADS(itn);
#pragma unroll
        for (int s = 0; s < 2; ++s)
#pragma unroll
            for (int n = 0; n < 2; ++n) { const LAS unsigned char* bp = F.lds + G3_V + (32 * s + 8 * g + q4) * G1_VP + (32 * w + 16 * n + 4 * p4) * 2; const bf16x8 bv = cat8(trrd(bp), trrd(bp + 4 * G1_VP));
#pragma unroll
                for (int m = 0; m < 4; ++m) { const bf16x8 av = *(LAS bf16x8*)(F.lds + G3_AM + (16 * m + l15) * G3_AMP + (32 * s + 8 * g) * 2); acc[m][n] = __builtin_amdgcn_mfma_f32_16x16x32_bf16(av, bv, acc[m][n], 0, 0, 0); } }
#pragma unroll
        for (int m = 0; m < 4; ++m)
#pragma unroll
            for (int r = 0; r < 4; ++r) { float ss = acc[m][0][r] * acc[m][0][r] + acc[m][1][r] * acc[m][1][r];
                ss += __shfl_xor(ss, 1); ss += __shfl_xor(ss, 2); ss += __shfl_xor(ss, 4); ss += __shfl_xor(ss, 8);
                if (l15 == 0) SS[(16 * m + 4 * g + r) * 8 + w] = ss; }
        __syncthreads();
#pragma unroll
        for (int m = 0; m < 4; ++m)
#pragma unroll
            for (int r = 0; r < 4; ++r) { const int row = 16 * m + 4 * g + r; const f32x4 s0 = *(LAS f32x4*)(SS + row * 8), s1 = *(LAS f32x4*)(SS + row * 8 + 4);
                const float rstd = 1.f / sqrtf(((s0.x + s0.y) + (s0.z + s0.w) + (s1.x + s1.y) + (s1.z + s1.w)) * (1.f / 256.f) + EPS);
#pragma unroll
                for (int n = 0; n < 2; ++n) { const int v = 32 * w + 16 * n + l15; LAS unsigned short* gp = (LAS unsigned short*)(F.lds + G3_GB + row * G1_VP + v * 2);
                    const float gt = bf2f(*gp); *gp = (unsigned short)f2bf(acc[m][n][r] * rstd * gnorm_g[v] * (gt * sigmoidf_(gt))); } }
        __syncthreads();
#pragma unroll
        for (int j = 0; j < 4; ++j) *(v4u*)(YB + (tok0 + t32 + 16 * j) * 1024 + h * 256 + 8 * p32) = *(LAS v4u*)(F.lds + G3_GB + (t32 + 16 * j) * G1_VP + 16 * p32);
        __syncthreads();
    }
#undef G3_LOAD
#undef G3_LOADS
}

namespace att {
constexpr int SHM_K = 16384, SHM_V = 16384, PITCH = 1024;
constexpr float THR = 8.f;
#define KSWZ(row, colB) ((row) * 256 + ((colB) ^ (((row) & 7) << 4)))
__device__ __forceinline__ int v_st(int k, int c) { const int kk = (k & ~0xC) | ((k & 4) << 1) | ((k & 8) >> 1); return ((kk >> 3) * 4 + (c >> 5)) * 512 + ((kk & 7) * 32 + (c & 31)) * 2; }
__device__ __forceinline__ int v_rd_base(int lane) { return ((lane & 3) << 3) | (((lane >> 2) & 3) << 6) | (((lane >> 4) & 1) << 5) | (((lane >> 5) & 1) << 8); }
constexpr int v_rd_off(int d0, int ks, int half) { return d0 * 512 + ks * 4096 + half * 2048; }
__device__ __forceinline__ int crow(int r, int hi) { return (r & 3) + 8 * (r >> 2) + 4 * hi; }
__device__ __forceinline__ void mask_bits(f32x16& p0, f32x16& p1, unsigned lo, unsigned hi32) {
    const float NEG = -__builtin_inff();
#pragma unroll
    for (int r = 0; r < 16; ++r) { const int c = (r & 3) + 8 * (r >> 2);
        if (!((lo >> c) & 1u)) p0[r] = NEG;
        if (!((hi32 >> c) & 1u)) p1[r] = NEG; }
}
__device__ __forceinline__ void partialSM(f32x16& p0, f32x16& p1, float& m_reg, float& mn, float& alpha) {
    float pmax = p0[0];
#pragma unroll
    for (int r = 1; r < 16; ++r) pmax = fmaxf(pmax, p0[r]);
#pragma unroll
    for (int r = 0; r < 16; ++r) pmax = fmaxf(pmax, p1[r]);
    { auto rr = __builtin_amdgcn_permlane32_swap(__float_as_uint(pmax), __float_as_uint(pmax), false, false);
      pmax = fmaxf(__uint_as_float(rr[0]), __uint_as_float(rr[1])); }
    if (__builtin_expect(__all((pmax - m_reg) <= THR), 1)) { mn = m_reg; alpha = 1.f; }
    else { mn = fmaxf(m_reg, pmax); alpha = __builtin_amdgcn_exp2f(m_reg - mn); m_reg = mn; }
#pragma unroll
    for (int r = 0; r < 16; ++r) p0[r] = __builtin_amdgcn_exp2f(p0[r] - mn);
#pragma unroll
    for (int r = 0; r < 16; ++r) p1[r] = __builtin_amdgcn_exp2f(p1[r] - mn);
}
__device__ __forceinline__ void finishSM(f32x16& p0, f32x16& p1, float alpha, float& l_reg, bf16x8& pa0, bf16x8& pa1, bf16x8& pa2, bf16x8& pa3) {
    float ps = 0.f;
#pragma unroll
    for (int r = 0; r < 16; ++r) ps += p0[r];
#pragma unroll
    for (int r = 0; r < 16; ++r) ps += p1[r];
    { auto rr = __builtin_amdgcn_permlane32_swap(__float_as_uint(ps), __float_as_uint(ps), false, false);
      ps = __uint_as_float(rr[0]) + __uint_as_float(rr[1]); }
    l_reg = l_reg * alpha + ps;
#define PK4(P, B_, OUT) do { unsigned a0 = cvtpk(P[B_+0], P[B_+1]), a1 = cvtpk(P[B_+2], P[B_+3]);                          \
        unsigned b0 = cvtpk(P[B_+4], P[B_+5]), b1 = cvtpk(P[B_+6], P[B_+7]);                                             \
        auto r0 = __builtin_amdgcn_permlane32_swap(a0, b0, false, false); auto r1 = __builtin_amdgcn_permlane32_swap(a1, b1, false, false); \
        v4u w_ = {r0[0], r1[0], r0[1], r1[1]}; OUT = __builtin_bit_cast(bf16x8, w_); } while (0)
    PK4(p0, 0, pa0); PK4(p0, 8, pa1); PK4(p1, 0, pa2); PK4(p1, 8, pa3);
#undef PK4
}
template <int KB>
__device__ __forceinline__ void qkt(f32x16& p0, f32x16& p1, const LAS unsigned char* K_lds, int r32, int hi, const bf16x8* qr) {
    p0 = f32x16{}; p1 = f32x16{};
    const LAS unsigned char* kb[4];
#pragma unroll
    for (int dd = 0; dd < 4; ++dd) kb[dd] = K_lds + KB * SHM_K + KSWZ(r32, (dd * 16 + hi * 8) * 2);
#pragma unroll
    for (int d0 = 0; d0 < 8; ++d0) { const LAS unsigned char* a = kb[d0 & 3] + (d0 >> 2) * 128;
        const bf16x8 b0 = *(const LAS bf16x8*)a, b1 = *(const LAS bf16x8*)(a + 32 * 256);
        p0 = __builtin_amdgcn_mfma_f32_32x32x16_bf16(b0, qr[d0], p0, 0, 0, 0);
        p1 = __builtin_amdgcn_mfma_f32_32x32x16_bf16(b1, qr[d0], p1, 0, 0, 0); }
}
template <int VB>
__device__ __forceinline__ void pv_tile(f32x16* o, int vb0, bf16x8 pa0, bf16x8 pa1, bf16x8 pa2, bf16x8 pa3) {
#define TRRD(dst, off) asm volatile("ds_read_b64_tr_b16 %0, %1 offset:%2" : "=&v"(dst) : "v"(vb0), "i"(off) : "memory")
#define PV_D0(d0) do { s16x4 l0, l1, l2, l3, h0, h1, h2, h3; constexpr int b_ = VB * SHM_V + v_rd_off(d0, 0, 0); \
        TRRD(l0, b_); TRRD(h0, b_ + 2048); TRRD(l1, b_ + 4096); TRRD(h1, b_ + 6144); TRRD(l2, b_ + 8192); TRRD(h2, b_ + 10240); TRRD(l3, b_ + 12288); TRRD(h3, b_ + 14336); \
        asm volatile("s_waitcnt lgkmcnt(0)" ::: "memory"); SBAR(); \
        o[d0] = __builtin_amdgcn_mfma_f32_32x32x16_bf16(pa0, (bf16x8){l0[0], l0[1], l0[2], l0[3], h0[0], h0[1], h0[2], h0[3]}, o[d0], 0, 0, 0);   \
        o[d0] = __builtin_amdgcn_mfma_f32_32x32x16_bf16(pa1, (bf16x8){l1[0], l1[1], l1[2], l1[3], h1[0], h1[1], h1[2], h1[3]}, o[d0], 0, 0, 0);   \
        o[d0] = __builtin_amdgcn_mfma_f32_32x32x16_bf16(pa2, (bf16x8){l2[0], l2[1], l2[2], l2[3], h2[0], h2[1], h2[2], h2[3]}, o[d0], 0, 0, 0);   \
        o[d0] = __builtin_amdgcn_mfma_f32_32x32x16_bf16(pa3, (bf16x8){l3[0], l3[1], l3[2], l3[3], h3[0], h3[1], h3[2], h3[3]}, o[d0], 0, 0, 0); } while (0)
    PV_D0(0); PV_D0(1); PV_D0(2); PV_D0(3);
#undef PV_D0
#undef TRRD
}
__device__ __forceinline__ void unit(const Ctx& F, int b, int h, int qb) {
    const bf16* Q = (const bf16*)(F.ws + WS_QA); const bf16* K = (const bf16*)(F.ws + WS_KA); const bf16* V = (const bf16*)(F.ws + WS_VA); bf16* O = (bf16*)(F.ws + WS_YA);
    const u64* MASKT = (const u64*)(F.ws + WS_MASK);
    const int tid = F.tid, wid = F.wave, lane = F.lane, r32 = lane & 31, hi = lane >> 5;
    LAS unsigned char* V_lds = F.lds; LAS unsigned char* K_lds = F.lds + 2 * SHM_V;
    LAS float* wsf = (LAS float*)(F.lds + 2 * SHM_V + 2 * SHM_K) + wid * 64; LAS float* li_l = wsf; LAS float* al_l = wsf + 32;
    const size_t tb = (size_t)b * T; const int NT = 4 * (qb + 1);
    const int sr = tid >> 4, sc = (tid & 15) * 8, vst0 = v_st(sr, sc), vst1 = v_st(32 + sr, sc), kws = KSWZ(sr, sc * 2);
    const int vb0 = (int)(uintptr_t)V_lds + v_rd_base(lane);
    const unsigned kvo = (unsigned)((tb + sr) * PITCH + h * 128 + sc);
    const int qrow = qb * 256 + wid * 32 + r32;
    bf16x8 qr[8];
    { const unsigned qo = (unsigned)((tb + qrow) * PITCH + h * 128 + hi * 8);
#pragma unroll
      for (int d0 = 0; d0 < 8; ++d0) qr[d0] = *(const bf16x8*)(Q + qo + d0 * 16); }
    const unsigned mo = (unsigned)(b * 64 * T + qrow);
    float m_reg = -1e30f, l_reg = 0.f; f32x16 o[4] = {};
    bf16x8 st_k0, st_k1, st_v0, st_v1;
#define SLOAD(t) do { const unsigned r0_ = kvo + (unsigned)((t) * 64 * PITCH); st_k0 = *(const bf16x8*)(K + r0_); st_k1 = *(const bf16x8*)(K + r0_ + 32 * PITCH); st_v0 = *(const bf16x8*)(V + r0_); st_v1 = *(const bf16x8*)(V + r0_ + 32 * PITCH); } while (0)
#define SWRITE(bf) do { *(LAS bf16x8*)(K_lds + (bf) * SHM_K + kws) = st_k0; *(LAS bf16x8*)(K_lds + (bf) * SHM_K + kws + 32 * 256) = st_k1; \
                        *(LAS bf16x8*)(V_lds + (bf) * SHM_V + vst0) = st_v0; *(LAS bf16x8*)(V_lds + (bf) * SHM_V + vst1) = st_v1; } while (0)
#define STEP(t, BUF) do { \
        if ((t) + 1 < NT) SLOAD((t) + 1); \
        const u64 mwd = MASKT[mo + (unsigned)((t) * T)]; \
        f32x16 p0, p1; float mn, alpha; bf16x8 pa0, pa1, pa2, pa3; \
        SBAR(); qkt<BUF>(p0, p1, K_lds, r32, hi, qr); \
        mask_bits(p0, p1, (unsigned)mwd >> (4 * hi), (unsigned)(mwd >> 32) >> (4 * hi)); \
        partialSM(p0, p1, m_reg, mn, alpha); finishSM(p0, p1, alpha, l_reg, pa0, pa1, pa2, pa3); \
        if (__any(alpha < 1.f)) { if (hi == 0) al_l[r32] = alpha; LDS_WAIT(); \
            _Pragma("unroll") for (int d_ = 0; d_ < 4; ++d_) _Pragma("unroll") for (int r = 0; r < 16; ++r) o[d_][r] *= al_l[crow(r, hi)]; } \
        SBAR(); pv_tile<BUF>(o, vb0, pa0, pa1, pa2, pa3); \
        if ((t) + 1 < NT) { VM_WAIT(); SWRITE(1 - (BUF)); } \
        __syncthreads(); } while (0)
    SLOAD(0); VM_WAIT(); SWRITE(0); __syncthreads();
    for (int t = 0; t < NT; t += 2) { STEP(t, 0); STEP(t + 1, 1); }
#undef STEP
#undef SLOAD
#undef SWRITE
    if (hi == 0) li_l[r32] = l_reg; LDS_WAIT();
    const unsigned oo = (unsigned)((tb + qb * 256 + wid * 32) * PITCH + h * 128 + r32);
#pragma unroll
    for (int r = 0; r < 16; ++r) { const int orow = crow(r, hi); const float rl = __builtin_amdgcn_rcpf(li_l[orow]);
#pragma unroll
        for (int d0 = 0; d0 < 4; ++d0) { const float v = o[d0][r] * rl; const float vn = __shfl_xor(v, 1);
            if ((r32 & 1) == 0) *(unsigned*)(O + oo + (unsigned)(orow * PITCH + d0 * 32)) = cvtpk(v, vn); } }
    __syncthreads();
}
}
__device__ __forceinline__ void p4_attention(const Ctx& F) {
    for (int it = F.bid; it < 256; it += F.G) { const int x = it & 7, j = it >> 3, bh = 4 * x + (j >> 3), p = j & 7;
        att::unit(F, bh >> 3, bh & 7, 15 - p); att::unit(F, bh >> 3, bh & 7, p); }
}

struct BranchOrder : pg8::StaticOrder {
    int aoff1, boff1;
    __device__ __forceinline__ bool next(int i, pg8::Unit& u) const { if (!pg8::StaticOrder::next(i >> 1, u)) return false; u.kind = i & 1; u.aoff = (i & 1) ? aoff1 : 0; u.boff = (i & 1) ? boff1 : 0; return true; }
};
struct EpiBr {
    static constexpr bool PERM = false, AFTER_DRAIN = false;
    const bf16* GA; const bf16* GBM; float* TMP; bf16* OUT;
    __device__ __forceinline__ void operator()(const pg8::f32x4 (&acc)[2][2][4][2], const pg8::Unit& u, int wr, int wc, int fr, int fq) const {
        const int row0 = u.pm * 256 + wr * 64 + fr, col0 = u.pn * 256 + wc * 32 + 4 * fq; const bf16* G = u.kind ? GBM : GA;
#pragma unroll
        for (int ai = 0; ai < 2; ++ai)
#pragma unroll
            for (int m = 0; m < 4; ++m) { const size_t ro = (size_t)(row0 + ai * 128 + m * 16) * 1024 + col0;
#pragma unroll
                for (int bj = 0; bj < 2; ++bj)
#pragma unroll
                    for (int n = 0; n < 2; ++n) { const size_t o = ro + bj * 128 + n * 16; const v2u gw = *(const v2u*)(G + o); const pg8::f32x4 a = acc[ai][bj][m][n];
                        pg8::f32x4 r; r[0] = a[0] * sigmoidf_(bflo(gw.x)); r[1] = a[1] * sigmoidf_(bfhi(gw.x)); r[2] = a[2] * sigmoidf_(bflo(gw.y)); r[3] = a[3] * sigmoidf_(bfhi(gw.y));
                        if (u.kind == 0) *(pg8::f32x4*)(TMP + o) = r;
                        else { const pg8::f32x4 t = *(const pg8::f32x4*)(TMP + o); v2u w; w.x = cvtpk(t[0] + r[0], t[1] + r[1]); w.y = cvtpk(t[2] + r[2], t[3] + r[3]); *(v2u*)(OUT + o) = w; } } }
    }
};
struct EpiOut {
    static constexpr bool PERM = false, AFTER_DRAIN = false;
    const float* X; const float* MOD; float* X1;
    __device__ __forceinline__ void operator()(const pg8::f32x4 (&acc)[2][2][4][2], const pg8::Unit& u, int wr, int wc, int fr, int fq) const {
        const int row0 = u.pm * 256 + wr * 64 + fr, col0 = u.pn * 256 + wc * 32 + 4 * fq; const float* gt = MOD + (u.pm * 256 / T) * 6144 + 2048;
        pg8::f32x4 gv[2][2];
#pragma unroll
        for (int bj = 0; bj < 2; ++bj)
#pragma unroll
            for (int n = 0; n < 2; ++n) gv[bj][n] = *(const pg8::f32x4*)(gt + col0 + bj * 128 + n * 16);
#pragma unroll
        for (int ai = 0; ai < 2; ++ai)
#pragma unroll
            for (int m = 0; m < 4; ++m) { const size_t ro = (size_t)(row0 + ai * 128 + m * 16) * 1024 + col0;
#pragma unroll
                for (int bj = 0; bj < 2; ++bj)
#pragma unroll
                    for (int n = 0; n < 2; ++n) { const size_t o = ro + bj * 128 + n * 16; *(pg8::f32x4*)(X1 + o) = *(const pg8::f32x4*)(X + o) + gv[bj][n] * acc[ai][bj][m][n]; } }
    }
};
constexpr int RW_PITCH = 36, R_CNT = 1024 * RW_PITCH * 4  , R_BASE = R_CNT + 128, R_LE = R_CNT + 256, R_LR = R_LE + 1024;
static_assert(R_LR + 1024 <= LDSCTL_OFF, "router LDS map");
__device__ __forceinline__ float wave_max(float v) {
#pragma unroll
    for (int o = 1; o < 64; o <<= 1) v = fmaxf(v, __shfl_xor(v, o));
    return v;
}
__device__ __forceinline__ void p8_router(const Ctx& F, const float* g2, const float* router_w, const float* router_b, int cnt_off = 0) {
    const float* X1 = (const float*)(F.ws + WS_X1); const float* mod = (const float*)(F.ws + WS_MOD); bf16* H2 = (bf16*)(F.ws + WS_H2);
    int* TOKE = (int*)(F.ws + WS_TOKE); int* TOKR = (int*)(F.ws + WS_TOKR); float* TOKW = (float*)(F.ws + WS_TOKW); int* PTOK = (int*)(F.ws + WS_PTOK); unsigned* gcnt = (unsigned*)(F.ws + WS_CTL) + CW_ECNT + cnt_off;
    LAS float* rw = (LAS float*)F.lds; LAS unsigned* lcnt = (LAS unsigned*)(F.lds + R_CNT); LAS unsigned* lbase = (LAS unsigned*)(F.lds + R_BASE);
    LAS int* le = (LAS int*)(F.lds + R_LE); LAS int* lrk = (LAS int*)(F.lds + R_LR);
    const int lane = F.lane;
    for (int i = F.tid; i < 8192; i += 512) { const int k = i >> 3, c4 = i & 7; *(LAS f32x4*)(rw + k * RW_PITCH + 4 * c4) = *(const f32x4*)(router_w + k * 32 + 4 * c4); }
    if (F.tid < 32) lcnt[F.tid] = 0u;
    __syncthreads();
    const float rb = router_b[(lane >> 1) & 31];
    for (int it = F.bid; it < NTOK / 64; it += F.G) {
        const int b = (it * 64) / T; const float* mb = mod + b * 6144;
        float ga[16], sh[16];
#pragma unroll
        for (int jj = 0; jj < 16; ++jj) { const int k = lane + 64 * jj; ga[jj] = g2[k] * (1.f + mb[4096 + k]); sh[jj] = mb[3072 + k]; }
        float hn[16];
        { const float* xr0 = X1 + (size_t)(it * 64 + F.wave * 8) * D;
#pragma unroll
          for (int jj = 0; jj < 16; ++jj) hn[jj] = xr0[lane + 64 * jj]; }
        for (int tt = 0; tt < 8; ++tt) { const int lt = F.wave * 8 + tt, m = it * 64 + lt;
            float hv[16]; float ss = 0.f;
#pragma unroll
            for (int jj = 0; jj < 16; ++jj) { hv[jj] = hn[jj]; ss = fmaf(hv[jj], hv[jj], ss); }
            if (tt < 7) { const float* xr = X1 + (size_t)(m + 1) * D;
#pragma unroll
                for (int jj = 0; jj < 16; ++jj) hn[jj] = xr[lane + 64 * jj]; }
            const float rstd = 1.f / sqrtf(wave_sum(ss) * (1.f / D) + EPS);
            float pe[32];
#pragma unroll
            for (int e = 0; e < 32; ++e) pe[e] = 0.f;
#pragma unroll
            for (int jj = 0; jj < 16; ++jj) { const int k = lane + 64 * jj; const float h = hv[jj] * rstd * ga[jj] + sh[jj]; H2[(size_t)m * D + k] = (bf16)f2bf(h);
#pragma unroll
                for (int c4 = 0; c4 < 8; ++c4) { const f32x4 w = *(LAS f32x4*)(rw + k * RW_PITCH + 4 * c4);
                    pe[4 * c4] = fmaf(h, w.x, pe[4 * c4]); pe[4 * c4 + 1] = fmaf(h, w.y, pe[4 * c4 + 1]); pe[4 * c4 + 2] = fmaf(h, w.z, pe[4 * c4 + 2]); pe[4 * c4 + 3] = fmaf(h, w.w, pe[4 * c4 + 3]); } }
#define RSTEP(NH, BIT) _Pragma("unroll") for (int e = 0; e < NH; ++e) { const bool up = (lane & BIT) != 0; const float send = up ? pe[e] : pe[e + NH]; const float keep = up ? pe[e + NH] : pe[e]; pe[e] = keep + __shfl_xor(send, BIT); }
            RSTEP(16, 32) RSTEP(8, 16) RSTEP(4, 8) RSTEP(2, 4) RSTEP(1, 2)
#undef RSTEP
            float lg = pe[0] + __shfl_xor(pe[0], 1) + rb;
            int e0, e1, e2, e3; float v0, v1, v2, v3;
#define TOP1(EK, VK) { const float mx = wave_max(lg); const u64 bm = __ballot(lg == mx); const int L = __ffsll((long long)bm) - 1; EK = (L >> 1) & 31; VK = mx; if (((lane >> 1) & 31) == EK) lg = -__builtin_inff(); }
            TOP1(e0, v0) TOP1(e1, v1) TOP1(e2, v2) TOP1(e3, v3)
#undef TOP1
            const float x1_ = __expf(v1 - v0), x2_ = __expf(v2 - v0), x3_ = __expf(v3 - v0), inv = 1.f / (1.f + x1_ + x2_ + x3_);
            if (lane < 4) { const int ek = lane == 0 ? e0 : (lane == 1 ? e1 : (lane == 2 ? e2 : e3)); const float wk = (lane == 0 ? 1.f : (lane == 1 ? x1_ : (lane == 2 ? x2_ : x3_))) * inv;
                const unsigned rk = __hip_atomic_fetch_add(lcnt + ek, 1u, __ATOMIC_RELAXED, __HIP_MEMORY_SCOPE_WORKGROUP);
                TOKE[m * 4 + lane] = ek; TOKW[m * 4 + lane] = wk; le[lt * 4 + lane] = ek; lrk[lt * 4 + lane] = (int)rk; }
        }
        __syncthreads();
        if (F.tid < 32) { lbase[F.tid] = __hip_atomic_fetch_add(gcnt + 64 * F.tid, lcnt[F.tid], __ATOMIC_RELAXED, __HIP_MEMORY_SCOPE_AGENT); lcnt[F.tid] = 0u; }
        __syncthreads();
        if (F.tid < 256) { const int e_ = le[F.tid], r_ = lrk[F.tid] + (int)lbase[e_]; TOKR[it * 256 + F.tid] = r_; PTOK[(size_t)e_ * NTOK + r_] = it * 64 + (F.tid >> 2); }
        __syncthreads();
    }
}
__device__ __forceinline__ void moe_tables(const Ctx& F) {
    LAS int* tab = (LAS int*)(F.lds + MOE_TAB_OFF); const unsigned* gcnt = (const unsigned*)(F.ws + WS_CTL) + CW_ECNT;
    if (F.tid < 64) { const int e = F.lane & 31; const int cnt = (int)__hip_atomic_load(gcnt + 64 * e, __ATOMIC_RELAXED, __HIP_MEMORY_SCOPE_AGENT); const int tiles = (cnt + 255) >> 8;
        int inc = tiles;
#pragma unroll
        for (int o = 1; o < 32; o <<= 1) { const int t = __shfl_up(inc, o); if ((F.lane & 31) >= o) inc += t; }
        if (F.lane < 32) { tab[e] = cnt; tab[32 + e] = inc - tiles; if (e == 31) tab[64] = inc; } }
    __syncthreads();
    const int nt = tab[64];
    for (int t = F.tid; t < nt; t += 512) { int e = 0;
#pragma unroll
        for (int s = 16; s > 0; s >>= 1) if (tab[32 + e + s] <= t) e += s;
        tab[128 + t] = e; }
    __syncthreads();
}
struct MoeOrder {
    const LAS int* tab; const int* ptok; int ptok_stride; int nN, G, c, wsz;
    __device__ __forceinline__ bool next(int i, pg8::Unit& u) const { const long L = (long)i * G + c; if (L >= (long)tab[64] * nN) return false;
        u.pm = (int)(L / nN); u.pn = (int)(L % nN); u.e = tab[128 + u.pm]; u.boff = u.e * wsz; u.aoff = 0; u.kind = 0; u.r0 = (u.pm - tab[32 + u.e]) * 256; u.cnt = tab[u.e]; return true; }
    __device__ __forceinline__ void a_ready(const pg8::Unit&) const {}
    __device__ __forceinline__ void done(const pg8::Unit&) const {}
};
struct EpiSwiglu {
    static constexpr bool PERM = true, AFTER_DRAIN = false;
    const float* bgu; bf16* ACT;
    __device__ __forceinline__ void operator()(const pg8::f32x4 (&acc)[2][2][4][2], const pg8::Unit& u, int wr, int wc, int fr, int fq) const {
        const int row0 = u.pm * 256 + wr * 64 + fr, oc = u.pn * 128 + wc * 32 + 8 * fq; const float* bp = bgu + (size_t)u.e * 2048 + oc;
        const pg8::f32x4 bg0 = *(const pg8::f32x4*)bp, bg1 = *(const pg8::f32x4*)(bp + 4), bu0 = *(const pg8::f32x4*)(bp + 1024), bu1 = *(const pg8::f32x4*)(bp + 1028);
#pragma unroll
        for (int ai = 0; ai < 2; ++ai)
#pragma unroll
            for (int m = 0; m < 4; ++m) { float r[8];
#pragma unroll
                for (int n = 0; n < 2; ++n)
#pragma unroll
                    for (int j = 0; j < 4; ++j) { const float gte = fminf(acc[ai][0][m][n][j] + (n ? bg1[j] : bg0[j]), 7.f), up = fminf(fmaxf(acc[ai][1][m][n][j] + (n ? bu1[j] : bu0[j]), -7.f), 7.f);
                        r[4 * n + j] = (up + 1.f) * (gte * sigmoidf_(1.702f * gte)); }
                v4u w; w.x = cvtpk(r[0], r[1]); w.y = cvtpk(r[2], r[3]); w.z = cvtpk(r[4], r[5]); w.w = cvtpk(r[6], r[7]);
                *(v4u*)(ACT + (size_t)(row0 + ai * 128 + m * 16) * 1024 + oc) = w; }
    }
};
struct EpiDown {
    static constexpr bool PERM = true, AFTER_DRAIN = false;
    const float* bd; bf16* YS;
    __device__ __forceinline__ void operator()(const pg8::f32x4 (&acc)[2][2][4][2], const pg8::Unit& u, int wr, int wc, int fr, int fq) const {
        const int row0 = u.pm * 256 + wr * 64 + fr, col0 = u.pn * 256 + wc * 32 + 8 * fq; const float* bp = bd + (size_t)u.e * 1024 + col0;
        pg8::f32x4 bv[2][2];
#pragma unroll
        for (int bj = 0; bj < 2; ++bj)
#pragma unroll
            for (int n = 0; n < 2; ++n) bv[bj][n] = *(const pg8::f32x4*)(bp + bj * 128 + 4 * n);
#pragma unroll
        for (int ai = 0; ai < 2; ++ai)
#pragma unroll
            for (int m = 0; m < 4; ++m) { bf16* rowp = YS + (size_t)(row0 + ai * 128 + m * 16) * 1024 + col0;
#pragma unroll
                for (int bj = 0; bj < 2; ++bj) { const pg8::f32x4 v0 = acc[ai][bj][m][0] + bv[bj][0], v1 = acc[ai][bj][m][1] + bv[bj][1];
                    v4u w; w.x = cvtpk(v0[0], v0[1]); w.y = cvtpk(v0[2], v0[3]); w.z = cvtpk(v1[0], v1[1]); w.w = cvtpk(v1[2], v1[3]);
                    *(v4u*)(rowp + bj * 128) = w; } }
    }
};
__device__ __forceinline__ void p12_combine(const Ctx& F, const float* final_g, float* out) {
    const float* X1 = (const float*)(F.ws + WS_X1); const float* mod = (const float*)(F.ws + WS_MOD); const bf16* YS = (const bf16*)(F.ws + WS_YS);
    const int* TOKE = (const int*)(F.ws + WS_TOKE); const int* TOKR = (const int*)(F.ws + WS_TOKR); const float* TOKW = (const float*)(F.ws + WS_TOKW); const LAS int* tab = (const LAS int*)(F.lds + MOE_TAB_OFF);
    for (int m0 = 8 * F.gw; m0 < NTOK; m0 += 8 * F.NGW) {
        const int b = m0 / T; const float* gt = mod + b * 6144 + 5120;
        int mypos = 0; float myw = 0.f;
        if (F.lane < 32) { mypos = 256 * tab[32 + TOKE[m0 * 4 + F.lane]] + TOKR[m0 * 4 + F.lane]; myw = TOKW[m0 * 4 + F.lane]; }
        f32x4 gv[4], fg[4];
#pragma unroll
        for (int j = 0; j < 4; ++j) { const int c = 4 * F.lane + 256 * j; gv[j] = *(const f32x4*)(gt + c); fg[j] = *(const f32x4*)(final_g + c); }
#pragma unroll 2
        for (int q = 0; q < 8; ++q) { const int m = m0 + q;
            v2u y[4][4]; f32x4 xv[4];
#pragma unroll
            for (int k = 0; k < 4; ++k) { const int pos = __shfl(mypos, q * 4 + k);
#pragma unroll
                for (int j = 0; j < 4; ++j) y[k][j] = *(const v2u*)(YS + (size_t)pos * D + 4 * F.lane + 256 * j); }
#pragma unroll
            for (int j = 0; j < 4; ++j) xv[j] = *(const f32x4*)(X1 + (size_t)m * D + 4 * F.lane + 256 * j);
            f32x4 a[4];
#pragma unroll
            for (int j = 0; j < 4; ++j) a[j] = (f32x4){0.f, 0.f, 0.f, 0.f};
#pragma unroll
            for (int k = 0; k < 4; ++k) { const float w = __shfl(myw, q * 4 + k);
#pragma unroll
                for (int j = 0; j < 4; ++j) { a[j][0] = fmaf(w, bflo(y[k][j].x), a[j][0]); a[j][1] = fmaf(w, bfhi(y[k][j].x), a[j][1]); a[j][2] = fmaf(w, bflo(y[k][j].y), a[j][2]); a[j][3] = fmaf(w, bfhi(y[k][j].y), a[j][3]); } }
            float ss = 0.f;
#pragma unroll
            for (int j = 0; j < 4; ++j) { a[j] = xv[j] + gv[j] * a[j]; ss += (a[j].x * a[j].x + a[j].y * a[j].y) + (a[j].z * a[j].z + a[j].w * a[j].w); }
            const float rstd = 1.f / sqrtf(wave_sum(ss) * (1.f / D) + EPS);
#pragma unroll
            for (int j = 0; j < 4; ++j) *(f32x4*)(out + (size_t)m * D + 4 * F.lane + 256 * j) = a[j] * rstd * fg[j];
        }
    }
}

constexpr int NPH = 12;
constexpr int MOE_ITEMS = NEXP * 16 * 32 + NEXP * 16 * 16;
#ifndef MOE_P0_ITEMS
#define MOE_P0_ITEMS 12288
#endif
#ifndef DUP_MASK
#define DUP_MASK 0
#endif
#define DUP(k) (((DUP_MASK) >> (k)) & 1)
struct Args { const float* in[20]; float* out; unsigned char* ws; int ph_lo, ph_hi; };
__global__ void __launch_bounds__(NWAVES * 64, 2) mk_fwd(Args args) {
    extern __shared__ __attribute__((aligned(16))) unsigned char lds_raw[];
    LAS unsigned char* const lds_ = (LAS unsigned char*)lds_raw;
#define MKCTX() Ctx F; { int t_ = threadIdx.x; asm volatile("" : "+v"(t_)); F.lds = lds_; F.ws = args.ws; F.tid = t_; F.lane = t_ & 63; F.wave = __builtin_amdgcn_readfirstlane(t_ >> 6); \
        F.bid = blockIdx.x; F.G = gridDim.x; F.gw = F.bid * NWAVES + F.wave; F.NGW = F.G * NWAVES; }
    const float* x = args.in[0]; const float* c_in = args.in[1]; const float* w_ada = args.in[2]; const float* b_ada = args.in[3]; const float* norm1_g = args.in[4];
    const float* w_in = args.in[5]; const float* w_gate_lr = args.in[6]; const float* b_gate = args.in[7]; const float* gla_norm_g = args.in[8];
    const float* w_br_a = args.in[9]; const float* w_br_b = args.in[10]; const float* w_out = args.in[11]; const float* norm2_g = args.in[12];
    const float* router_w = args.in[13]; const float* router_b = args.in[14]; const float* w_gu = args.in[15]; const float* b_gu = args.in[16];
    const float* w_dn = args.in[17]; const float* b_dn = args.in[18]; const float* final_g = args.in[19];
    unsigned char* ws = args.ws;
    for (int u = threadIdx.x; u < (LDS_BYTES - LDSCTL_OFF) / 4; u += NWAVES * 64) ((LAS unsigned*)(lds_ + LDSCTL_OFF))[u] = 0u;
    __syncthreads();
    const int lo = args.ph_lo, hi = args.ph_hi;
    const bool multi = (hi - lo) > 1;
    XcdBarrier bar; bar.bar = (unsigned*)(ws + WS_CTL) + CW_BAR; bar.x = 0; bar.st = (volatile LAS unsigned*)(lds_ + LDSCTL_OFF + 32);
    if (multi) bar = xcd_barrier_post((unsigned*)(ws + WS_CTL) + CW_BAR, (volatile LAS unsigned*)(lds_ + LDSCTL_OFF + 32));
#define IN(k) (lo <= (k) && (k) < hi)
#ifdef TPROBE
#define STAMP(k) do { if (blockIdx.x == 0 && threadIdx.x == 0) ((volatile LAS unsigned long long*)(lds_ + LDSCTL_OFF + 256))[(k)] = __builtin_amdgcn_s_memrealtime(); } while (0)
#else
#define STAMP(k) do { } while (0)
#endif
    STAMP(0);
#define SEAM(k) do { if (IN(k) && IN((k) + 1)) xcd_barrier(bar); STAMP((k) + 1); } while (0)

    const bool side = (gridDim.x == 256);
    if (IN(0)) { MKCTX(); p0_prologue(F, c_in, w_ada, b_ada, w_in, w_br_a, w_br_b, w_out, w_gu, w_dn, side ? MOE_P0_ITEMS : MOE_ITEMS); }
    SEAM(0);
    if (IN(1)) { MKCTX(); p1_xn(F, x, norm1_g); if (DUP(1)) p1_xn(F, x, norm1_g); }
    SEAM(1);
    if (IN(2)) { MKCTX(); constexpr int NCONV = 32; const int GG = side ? 256 - NCONV : F.G;
        if (F.bid < GG) { pg8::Gemm g{(const bf16*)(ws + WS_XN), (const bf16*)(ws + WS_WINT), NTOK, NPROJ, D}; pg8::StaticOrder S; S.init(NTOK, NPROJ, GG, F.bid);
            EpiProj E{ws}; pg8::gemm_phase<EpiProj, pg8::StaticOrder, true, true>(F.lds, g, S, E); }
        else moe_convert(F, w_gu, w_dn, (F.bid - GG) * NWAVES + F.wave, NCONV * NWAVES, MOE_P0_ITEMS, MOE_ITEMS); }
    SEAM(2);
    if (IN(3)) { { MKCTX(); p3_indexer(F); if (DUP(3)) p3_indexer(F); } { MKCTX(); p3_gla1(F, w_gate_lr, b_gate); if (DUP(14)) p3_gla1(F, w_gate_lr, b_gate); } }
    SEAM(3);
    if (IN(4)) { { MKCTX(); p4_attention(F); if (DUP(4)) p4_attention(F); } { MKCTX(); p4_scan(F); if (DUP(13)) p4_scan(F); } }
    SEAM(4);
    if (IN(5)) { MKCTX(); p5_gla3(F, gla_norm_g); if (DUP(5)) p5_gla3(F, gla_norm_g); }
    SEAM(5);
    if (IN(6)) { MKCTX();
        pg8::Gemm g{(const bf16*)(ws + WS_YA), (const bf16*)(ws + WS_WAT), NTOK, D, D}; BranchOrder S; S.init(NTOK, D, F.G, F.bid); S.aoff1 = (int)((WS_YB - WS_YA) / 2); S.boff1 = (int)((WS_WBT - WS_WAT) / 2);
        EpiBr E{(const bf16*)(ws + WS_GA), (const bf16*)(ws + WS_GBM), (float*)(ws + WS_TMPA), (bf16*)(ws + WS_MERGED)};
        pg8::gemm_phase<EpiBr, BranchOrder, true, true>(F.lds, g, S, E); if (DUP(6)) pg8::gemm_phase<EpiBr, BranchOrder, true, true>(F.lds, g, S, E);
    }
    SEAM(6);
    if (IN(7)) { MKCTX(); pg8::Gemm g{(const bf16*)(ws + WS_MERGED), (const bf16*)(ws + WS_WOT), NTOK, D, D}; pg8::StaticOrder S; S.init(NTOK, D, F.G, F.bid);
        EpiOut E{x, (const float*)(ws + WS_MOD), (float*)(ws + WS_X1)}; pg8::gemm_phase<EpiOut, pg8::StaticOrder, true, true>(F.lds, g, S, E); if (DUP(7)) pg8::gemm_phase<EpiOut, pg8::StaticOrder, true, true>(F.lds, g, S, E); }
    SEAM(7);
    if (IN(8)) { MKCTX(); p8_router(F, norm2_g, router_w, router_b); if (DUP(8)) { __syncthreads(); p8_router(F, norm2_g, router_w, router_b, 4096); } }
    SEAM(8);
    if (IN(9)) { MKCTX(); moe_tables(F);
        pg8::Gemm g{(const bf16*)(ws + WS_H2), (const bf16*)(ws + WS_WGUT), PMAX, 2048, D}; MoeOrder S{(const LAS int*)(F.lds + MOE_TAB_OFF), (const int*)(ws + WS_PTOK), NTOK, 8, F.G, F.bid, 2048 * D};
        EpiSwiglu E{b_gu, (bf16*)(ws + WS_ACT)}; pg8::gemm_phase<EpiSwiglu, MoeOrder, true, true, true>(F.lds, g, S, E); }
    SEAM(9);
    if (IN(10)) { MKCTX(); moe_tables(F);
        pg8::Gemm g{(const bf16*)(ws + WS_ACT), (const bf16*)(ws + WS_WDT), PMAX, D, DFF}; MoeOrder S{(const LAS int*)(F.lds + MOE_TAB_OFF), nullptr, 0, 4, F.G, F.bid, D * DFF};
        EpiDown E{b_dn, (bf16*)(ws + WS_YS)}; pg8::gemm_phase<EpiDown, MoeOrder, true, true>(F.lds, g, S, E); }
    SEAM(10);
    if (IN(11)) { MKCTX(); moe_tables(F); p12_combine(F, final_g, args.out); }
#ifdef TPROBE
    STAMP(12);
    if (blockIdx.x == 0 && threadIdx.x == 0) { volatile LAS unsigned long long* st_ = (volatile LAS unsigned long long*)(lds_ + LDSCTL_OFF + 256);
        const unsigned long long dt = st_[TPROBE + 1] - st_[TPROBE], t0 = __builtin_amdgcn_s_memrealtime();
        while (__builtin_amdgcn_s_memrealtime() - t0 < dt) __builtin_amdgcn_s_sleep(8); }
#endif
#undef IN
#undef SEAM
}

#ifndef MK_N_LAUNCHES
#define MK_N_LAUNCHES 1
#endif
extern "C" void kernel_launch(void* const* d_in, const int* in_sizes, int n_in, void* d_out, int out_size, void* d_ws, size_t ws_size, hipStream_t stream) {
    static int grid = 0;
    if (grid == 0) {
        if (n_in != 20 || out_size != NTOK * D || ws_size < WS_END) { fprintf(stderr, "kernel_launch: unexpected shapes (n_in %d out %d ws %zu)\n", n_in, out_size, ws_size); grid = -1; return; }
        int dev = 0, cus = 0, per_cu = 0;
        if (hipGetDevice(&dev) != hipSuccess || hipDeviceGetAttribute(&cus, hipDeviceAttributeMultiprocessorCount, dev) != hipSuccess) { grid = -1; return; }
        if (hipFuncSetAttribute((const void*)mk_fwd, hipFuncAttributeMaxDynamicSharedMemorySize, LDS_BYTES) != hipSuccess) { fprintf(stderr, "kernel_launch: hipFuncSetAttribute failed\n"); grid = -1; return; }
        if (hipOccupancyMaxActiveBlocksPerMultiprocessor(&per_cu, (const void*)mk_fwd, NWAVES * 64, LDS_BYTES) != hipSuccess || per_cu < 1) { fprintf(stderr, "kernel_launch: occupancy query says %d\n", per_cu); }
        (void)hipGetLastError();
        grid = cus;
    }
    if (grid < 0) return;
    if (hipMemsetAsync((char*)d_ws + WS_CTL, 0, CTL_ZERO_BYTES, stream) != hipSuccess) return;
    Args a{};
    for (int i = 0; i < 20; ++i) a.in[i] = (const float*)d_in[i];
    a.out = (float*)d_out; a.ws = (unsigned char*)d_ws;
#if MK_N_LAUNCHES == 1
    a.ph_lo = 0; a.ph_hi = NPH;
    hipLaunchKernelGGL(mk_fwd, dim3(grid), dim3(NWAVES * 64), LDS_BYTES, stream, a);
#else
    for (int p = 0; p < NPH; ++p) { a.ph_lo = p; a.ph_hi = p + 1; hipLaunchKernelGGL(mk_fwd, dim3(grid), dim3(NWAVES * 64), LDS_BYTES, stream, a); }
#endif
}
```
